# Optimizing an MI355X kernel written in HIP

```python
import jax, jax.numpy as jnp
from jax import lax
import numpy as np

D_MODEL = 1024
BATCH = 8
SEQ = 4096
DEPTH = 2

GRID_W = 64
NA_HEADS = 4
NA_HEAD_DIM = 64
NA_WIN_ROWS = 8
NA_WIN_COLS = 16
MLA_HEADS = 8
MLA_Q_RANK = 384
MLA_KV_RANK = 256
MLA_NOPE_DIM = 64
MLA_ROPE_DIM = 32
MLA_V_DIM = 64
MLA_Q_BLOCK = 128
SWA_HEADS = 4
SWA_KV_HEADS = 2
SWA_HEAD_DIM = 64
SWA_WINDOW = 128
SWA_BLOCK = 128
N_EXPERTS = 16
EXPERT_FF = 512
EC_CAPACITY_FACTOR = 2
PLE_DIM = 256

ROPE_THETA = 10000.0
NORM_EPS = 1e-6
NEG_INF = -1e30

NA_WIDTH = NA_HEADS * NA_HEAD_DIM
MLA_WIDTH = MLA_HEADS * MLA_V_DIM
SWA_WIDTH = SWA_HEADS * SWA_HEAD_DIM
SWA_KV_WIDTH = SWA_KV_HEADS * SWA_HEAD_DIM
MIX_WIDTH = NA_WIDTH + MLA_WIDTH + SWA_WIDTH
IN_SIZES = (NA_WIDTH, NA_WIDTH, NA_WIDTH, MLA_Q_RANK, MLA_KV_RANK, MLA_ROPE_DIM,
            SWA_WIDTH, SWA_KV_WIDTH, SWA_KV_WIDTH)
IN_WIDTH = sum(IN_SIZES)

kernel_name = 'hybrid_na_mla_swa_ec_encoder'


def rms_norm(x, g):
    xf = x.astype(jnp.float32)
    y = xf * lax.rsqrt(jnp.mean(xf * xf, axis=-1, keepdims=True) + NORM_EPS)
    return (y * g.astype(jnp.float32)).astype(x.dtype)


def rope_tables(pos, dim):
    inv = 1.0 / (ROPE_THETA ** (jnp.arange(0, dim, 2, dtype=jnp.float32) / dim))
    ang = pos.astype(jnp.float32)[:, None] * inv[None, :]
    return jnp.cos(ang), jnp.sin(ang)


def apply_rope(x, cos, sin):
    d2 = x.shape[-1] // 2
    x1 = x[..., :d2].astype(jnp.float32)
    x2 = x[..., d2:].astype(jnp.float32)
    c = cos[None, :, None, :]
    s = sin[None, :, None, :]
    return jnp.concatenate([x1 * c - x2 * s, x2 * c + x1 * s], axis=-1).astype(x.dtype)


def neighbourhood_attention(q, k, v, rpb):
    B, S, H, hd = q.shape
    rows = S // GRID_W
    wr = min(NA_WIN_ROWS, rows)
    wc = NA_WIN_COLS
    r = jnp.arange(rows)
    c = jnp.arange(GRID_W)
    r0 = jnp.clip(r - wr // 2, 0, rows - wr)
    c0 = jnp.clip(c - wc // 2, 0, GRID_W - wc)
    key_rows = r0[:, None] + jnp.arange(wr)[None, :]
    qg = q.reshape(B, rows, GRID_W, H, hd)
    kg = k.reshape(B, rows, GRID_W, H, hd)[:, key_rows]
    vg = v.reshape(B, rows, GRID_W, H, hd)[:, key_rows]
    s = jnp.einsum('brchd,briwhd->bhrciw', qg, kg,
                   preferred_element_type=jnp.float32) * (hd ** -0.5)
    kc = jnp.arange(GRID_W)
    col_ok = (kc[None, :] >= c0[:, None]) & (kc[None, :] < c0[:, None] + wc)
    dr = key_rows - r[:, None]
    dc = jnp.clip(kc[None, :] - c[:, None], -(wc - 1), wc - 1)
    bias = rpb[:, dr[:, None, :, None] + NA_WIN_ROWS - 1,
               dc[None, :, None, :] + NA_WIN_COLS - 1]
    s = s + bias.astype(jnp.float32)[None]
    s = jnp.where(col_ok[:, None, :], s, NEG_INF)
    p = jax.nn.softmax(s.reshape(B, H, rows, GRID_W, wr * GRID_W), axis=-1).reshape(s.shape)
    o = jnp.einsum('bhrciw,briwhd->brchd', p.astype(v.dtype), vg)
    return o.reshape(B, S, H * hd)


def latent_attention(c_q, c_kv, k_rope, q_norm, w_q_up, kv_norm, w_kv_up, cos, sin):
    B, S, _ = c_q.shape
    H = MLA_HEADS
    q = (rms_norm(c_q, q_norm) @ w_q_up).reshape(B, S, H, MLA_NOPE_DIM + MLA_ROPE_DIM)
    q_nope = q[..., :MLA_NOPE_DIM]
    q_rope = apply_rope(q[..., MLA_NOPE_DIM:], cos, sin)
    kv = (rms_norm(c_kv, kv_norm) @ w_kv_up).reshape(B, S, H, MLA_NOPE_DIM + MLA_V_DIM)
    k_nope = kv[..., :MLA_NOPE_DIM]
    v = kv[..., MLA_NOPE_DIM:]
    k_r = apply_rope(k_rope[:, :, None, :], cos, sin)[:, :, 0]
    scale = (MLA_NOPE_DIM + MLA_ROPE_DIM) ** -0.5
    nb = S // MLA_Q_BLOCK

    def to_blocks(t):
        return jnp.moveaxis(t.reshape(B, nb, MLA_Q_BLOCK, *t.shape[2:]), 1, 0)

    def block_attn(args):
        qn, qr = args
        s = (jnp.einsum('bqhd,bkhd->bhqk', qn, k_nope, preferred_element_type=jnp.float32)
             + jnp.einsum('bqhr,bkr->bhqk', qr, k_r, preferred_element_type=jnp.float32)) * scale
        p = jax.nn.softmax(s, axis=-1)
        return jnp.einsum('bhqk,bkhd->bqhd', p.astype(v.dtype), v)

    o = lax.map(block_attn, (to_blocks(q_nope), to_blocks(q_rope)))
    return jnp.moveaxis(o, 0, 1).reshape(B, S, H * MLA_V_DIM)


def window_gqa_sink(q, k, v, sink, cos, sin):
    B, S, H, hd = q.shape
    KVH = k.shape[2]
    G = H // KVH
    L = SWA_BLOCK
    nb = S // L
    q = apply_rope(q, cos, sin)
    k = apply_rope(k, cos, sin)
    pad = ((0, 0), (L, L), (0, 0), (0, 0))
    kp = jnp.pad(k, pad).reshape(B, nb + 2, L, KVH, hd)
    vp = jnp.pad(v, pad).reshape(B, nb + 2, L, KVH, hd)
    kb = jnp.concatenate([kp[:, :-2], kp[:, 1:-1], kp[:, 2:]], axis=2)
    vb = jnp.concatenate([vp[:, :-2], vp[:, 1:-1], vp[:, 2:]], axis=2)
    qb = q.reshape(B, nb, L, KVH, G, hd)
    s = jnp.einsum('bnqkgd,bnjkd->bkgnqj', qb, kb,
                   preferred_element_type=jnp.float32) * (hd ** -0.5)
    qi = jnp.arange(L)[:, None]
    kj = jnp.arange(3 * L)[None, :]
    rel = kj - L - qi
    kpos = (jnp.arange(nb)[:, None, None] - 1) * L + kj[None]
    valid = (jnp.abs(rel)[None] <= SWA_WINDOW) & (kpos >= 0) & (kpos < S)
    s = jnp.where(valid, s, NEG_INF)
    sink_l = sink.astype(jnp.float32).reshape(KVH, G)[None, :, :, None, None, None]
    m = jnp.maximum(jnp.max(s, axis=-1, keepdims=True), sink_l)
    e = jnp.exp(s - m)
    p = e / (jnp.sum(e, axis=-1, keepdims=True) + jnp.exp(sink_l - m))
    o = jnp.einsum('bkgnqj,bnjkd->bnqkgd', p.astype(v.dtype), vb)
    return o.reshape(B, S, H * hd)


def expert_choice_ffn(h, w_router, w_gate, w_up, w_down):
    B, S, D = h.shape
    cap = EC_CAPACITY_FACTOR * S // N_EXPERTS
    logits = jnp.einsum('bsd,de->bse', h, w_router, preferred_element_type=jnp.float32)
    aff = jax.nn.softmax(logits, axis=-1)
    g, idx = lax.top_k(jnp.swapaxes(aff, 1, 2), cap)
    xs = jax.vmap(lambda hb, ib: hb[ib])(h, idx)
    a = jnp.einsum('becd,edf->becf', xs, w_gate)
    u = jnp.einsum('becd,edf->becf', xs, w_up)
    y = jnp.einsum('becf,efd->becd', jax.nn.silu(a) * u, w_down)
    y = y * g[..., None].astype(y.dtype)
    return jax.vmap(lambda ib, yb: jnp.zeros((S, D), yb.dtype)
                    .at[ib.reshape(-1)].add(yb.reshape(-1, D)))(idx, y)


def setup_inputs(seed: int = 0) -> dict:
    key = jax.random.key(seed)
    ks = jax.random.split(key, 24)
    f32 = jnp.float32

    def nrm(k, shape, scale):
        return jax.random.normal(k, shape, f32) * scale

    def gain(k, shape):
        return 1.0 + 0.05 * jax.random.normal(k, shape, f32)

    return {
        'x': nrm(ks[0], (BATCH, SEQ, D_MODEL), 1.0),
        'p': nrm(ks[1], (DEPTH, BATCH, SEQ, PLE_DIM), 1.0),
        'attn_norm': gain(ks[2], (DEPTH, D_MODEL)),
        'w_in': nrm(ks[3], (DEPTH, D_MODEL, IN_WIDTH), D_MODEL ** -0.5),
        'na_rpb': nrm(ks[4], (DEPTH, NA_HEADS, 2 * NA_WIN_ROWS - 1, 2 * NA_WIN_COLS - 1), 0.1),
        'mla_q_norm': gain(ks[5], (DEPTH, MLA_Q_RANK)),
        'mla_w_q_up': nrm(ks[6], (DEPTH, MLA_Q_RANK, MLA_HEADS * (MLA_NOPE_DIM + MLA_ROPE_DIM)), MLA_Q_RANK ** -0.5),
        'mla_kv_norm': gain(ks[7], (DEPTH, MLA_KV_RANK)),
        'mla_w_kv_up': nrm(ks[8], (DEPTH, MLA_KV_RANK, MLA_HEADS * (MLA_NOPE_DIM + MLA_V_DIM)), MLA_KV_RANK ** -0.5),
        'swa_sink': nrm(ks[9], (DEPTH, SWA_HEADS), 1.0),
        'w_out': nrm(ks[10], (DEPTH, MIX_WIDTH, D_MODEL), MIX_WIDTH ** -0.5),
        'ffn_norm': gain(ks[11], (DEPTH, D_MODEL)),
        'w_router': nrm(ks[12], (DEPTH, D_MODEL, N_EXPERTS), D_MODEL ** -0.5),
        'w_gate_e': nrm(ks[13], (DEPTH, N_EXPERTS, D_MODEL, EXPERT_FF), D_MODEL ** -0.5),
        'w_up_e': nrm(ks[14], (DEPTH, N_EXPERTS, D_MODEL, EXPERT_FF), D_MODEL ** -0.5),
        'w_down_e': nrm(ks[15], (DEPTH, N_EXPERTS, EXPERT_FF, D_MODEL), EXPERT_FF ** -0.5),
        'ple_norm': gain(ks[16], (DEPTH, D_MODEL)),
        'w_ple_gate': nrm(ks[17], (DEPTH, D_MODEL, D_MODEL), D_MODEL ** -0.5),
        'w_ple_proj': nrm(ks[18], (DEPTH, PLE_DIM, D_MODEL), PLE_DIM ** -0.5),
        'final_norm': gain(ks[19], (D_MODEL,)),
    }


def reference(x, p, attn_norm, w_in, na_rpb, mla_q_norm, mla_w_q_up, mla_kv_norm, mla_w_kv_up,
              swa_sink, w_out, ffn_norm, w_router, w_gate_e, w_up_e, w_down_e,
              ple_norm, w_ple_gate, w_ple_proj, final_norm):
    B, S, D = x.shape
    pos = jnp.arange(S)
    cos_mla, sin_mla = rope_tables(pos, MLA_ROPE_DIM)
    cos_swa, sin_swa = rope_tables(pos, SWA_HEAD_DIM)
    offsets = [int(o) for o in np.cumsum(IN_SIZES)[:-1]]
    h = x
    for i in range(DEPTH):
        hn = rms_norm(h, attn_norm[i])
        proj = hn @ w_in[i]
        na_q, na_k, na_v, mla_cq, mla_ckv, mla_kr, swa_q, swa_k, swa_v = jnp.split(proj, offsets, axis=-1)
        o_na = neighbourhood_attention(
            na_q.reshape(B, S, NA_HEADS, NA_HEAD_DIM),
            na_k.reshape(B, S, NA_HEADS, NA_HEAD_DIM),
            na_v.reshape(B, S, NA_HEADS, NA_HEAD_DIM), na_rpb[i])
        o_mla = latent_attention(mla_cq, mla_ckv, mla_kr, mla_q_norm[i], mla_w_q_up[i],
                                 mla_kv_norm[i], mla_w_kv_up[i], cos_mla, sin_mla)
        o_swa = window_gqa_sink(
            swa_q.reshape(B, S, SWA_HEADS, SWA_HEAD_DIM),
            swa_k.reshape(B, S, SWA_KV_HEADS, SWA_HEAD_DIM),
            swa_v.reshape(B, S, SWA_KV_HEADS, SWA_HEAD_DIM), swa_sink[i], cos_swa, sin_swa)
        h = h + jnp.concatenate([o_na, o_mla, o_swa], axis=-1) @ w_out[i]
        h = h + expert_choice_ffn(rms_norm(h, ffn_norm[i]), w_router[i],
                                  w_gate_e[i], w_up_e[i], w_down_e[i])
        gate = jax.nn.sigmoid(rms_norm(h, ple_norm[i]) @ w_ple_gate[i])
        h = h + gate * (p[i] @ w_ple_proj[i])
    return rms_norm(h, final_norm)
```

```cpp
#include <hip/hip_runtime.h>
#include <hip/hip_bf16.h>
#include <cstdio>
#include <cstdint>
#include <cmath>

#ifndef STOP_AFTER
#define STOP_AFTER 99
#endif

namespace pg8 {
#define PG8_LAS __attribute__((address_space(3)))
typedef unsigned short bf16_t;
typedef short bf16x8 __attribute__((ext_vector_type(8)));
typedef float f32x4 __attribute__((ext_vector_type(4)));
typedef unsigned u32x4 __attribute__((ext_vector_type(4)));
typedef unsigned u32x2 __attribute__((ext_vector_type(2)));
constexpr int BM = 256, BK = 64, HALF = 128, HTB = HALF * BK * 2  , STAGE_BYTES = 8 * HTB, NXCD = 8, WGM = 8;

__host__ __device__ __forceinline__ int lds_byte(int r, int c) { const int st = (r >> 4) * 2 + (c >> 5), rr = r & 15, cc = c & 31, ob = rr * 64 + cc * 2; return st * 1024 + (ob ^ (((ob >> 9) & 1) << 5)); }
__host__ __device__ __forceinline__ int perm32(int rho) { const int n = rho >> 4, i = rho & 15; return 8 * (i >> 2) + 4 * n + (i & 3); }
__host__ __device__ __forceinline__ void stage_rc(int b, int& R, int& C) { const int st = b / 1024, sb = b % 1024, swz = sb ^ (((sb >> 9) & 1) << 5); R = (st >> 1) * 16 + swz / 64; C = (st & 1) * 32 + (swz % 64) / 2; }

struct Unit { int pm, pn; };

struct StaticOrder {
    int nM, nN, nwg, G, c;
    __host__ __device__ __forceinline__ void init(int M, int N, int G_, int c_) { nM = M / BM; nN = N / BM; nwg = nM * nN; G = G_; c = c_; }
    __host__ __device__ __forceinline__ bool next(int i, Unit& u) const {
        const long L = (long)i * G + c; if (L >= nwg) return false;
        int wgid = (int)L; { const int q = nwg / NXCD, r = nwg % NXCD, xcd = wgid % NXCD, off = wgid / NXCD; wgid = (xcd < r ? xcd * (q + 1) : r * (q + 1) + (xcd - r) * q) + off; }
        const int nig = WGM * nN, gid = wgid / nig, fm = gid * WGM, gsz = (nM - fm) < WGM ? (nM - fm) : WGM;
        u.pm = fm + ((wgid % nig) % gsz); u.pn = (wgid % nig) / gsz; return true;
    }
};

struct ExpertOrder : StaticOrder {
    __host__ __device__ __forceinline__ bool next(int i, Unit& u) const { if (!StaticOrder::next(i, u)) return false; const int q = u.pm; u.pm = ((((q >> 1) & 7) * 16 + (q >> 4)) << 1) | (q & 1); return true; }
};

struct ProbPlain {
    static constexpr bool GATHER = false;
    const bf16_t* A; const bf16_t* Bt; int K;
    __device__ __forceinline__ const char* a_tile(const Unit& u) const { return (const char*)A + (size_t)u.pm * BM * K * 2; }
    __device__ __forceinline__ const char* a_base() const { return (const char*)A; }
    __device__ __forceinline__ unsigned a_off(int, const Unit& u, int r, int C) const { return (unsigned)(((u.pm * BM + r) * K + C) * 2); }
    __device__ __forceinline__ const char* b_tile(const Unit& u) const { return (const char*)Bt + (size_t)u.pn * BM * K * 2; }
};
struct ProbExpert {
    static constexpr bool GATHER = false;
    const bf16_t* A; const bf16_t* Bt; int K; size_t estride;
    __device__ __forceinline__ const char* a_tile(const Unit& u) const { return (const char*)A + (size_t)u.pm * BM * K * 2; }
    __device__ __forceinline__ const char* a_base() const { return (const char*)A; }
    __device__ __forceinline__ unsigned a_off(int, const Unit& u, int r, int C) const { return (unsigned)(((u.pm * BM + r) * K + C) * 2); }
    __device__ __forceinline__ const char* b_tile(const Unit& u) const { return (const char*)Bt + ((size_t)((u.pm >> 1) & 15) * estride + (size_t)u.pn * BM * K) * 2; }
};
struct ProbGather {
    static constexpr bool GATHER = true;
    const bf16_t* A; const bf16_t* Bt; int K; size_t estride; const PG8_LAS unsigned* gtab;
    __device__ __forceinline__ const char* a_tile(const Unit&) const { return (const char*)A; }
    __device__ __forceinline__ const char* a_base() const { return (const char*)A; }
    __device__ __forceinline__ unsigned a_off(int ui, const Unit&, int r, int C) const { return (unsigned)((gtab[ui * BM + r] * (unsigned)K + (unsigned)C) * 2u); }
    __device__ __forceinline__ const char* b_tile(const Unit& u) const { return (const char*)Bt + ((size_t)((u.pm >> 1) & 15) * estride + (size_t)u.pn * BM * K) * 2; }
};

template <class Prob, class Epi, class Sched, bool ALIGN_EPI>
__device__ __forceinline__ void gemm_phase(PG8_LAS unsigned char* lds, const Prob& g, const Sched& S, const Epi& E) {
    int tid_ = threadIdx.x; asm volatile("" : "+v"(tid_));
    const int tid = tid_, wid = __builtin_amdgcn_readfirstlane(tid >> 6), lane = tid & 63, wr = wid >> 2, wc = wid & 3, fr = lane & 15, fq = lane >> 4;
    const int K = g.K, nt = K / BK;
    int RA[2], CA[2]; unsigned voffB[2], voffA[2];
#pragma unroll
    for (int i = 0; i < 2; ++i) { int R, C; stage_rc(tid * 16 + i * 8192, R, C); RA[i] = R; CA[i] = C; voffA[i] = (unsigned)(R * K + C) * 2u; voffB[i] = (unsigned)(((R & ~31) + perm32(R & 31)) * K + C) * 2u; }
    constexpr bool GATHER = Prob::GATHER;
    const size_t kstep = (size_t)(BK * 2);
    const size_t hstep = (size_t)HALF * K * 2;
    const unsigned ldsw = (unsigned)wid * 1024u;
    const int aoff = lds_byte(wr * 64 + fr, fq * 8), boff = lds_byte(wc * 32 + fr, fq * 8);
#define PG8_SA(b, h) (((b) * 2 + (h)) * HTB)
#define PG8_SB(b, h) ((4 + (b) * 2 + (h)) * HTB)
#define PG8_STAGE_B(bufoff, gbase) do { _Pragma("unroll") for (int _i = 0; _i < 2; ++_i) \
        __builtin_amdgcn_global_load_lds((const unsigned*)((const char*)(gbase) + voffB[_i]), (PG8_LAS unsigned*)(lds + (bufoff) + ldsw + _i * 8192), 16, 0, 0); } while (0)
#define PG8_STAGE_A(bufoff, PT, kb, OFF, h) do { _Pragma("unroll") for (int _i = 0; _i < 2; ++_i) { \
        if constexpr (GATHER) __builtin_amdgcn_global_load_lds((const unsigned*)(Ab + (size_t)(kb) + (size_t)(OFF)[h][_i]), (PG8_LAS unsigned*)(lds + (bufoff) + ldsw + _i * 8192), 16, 0, 0); \
        else __builtin_amdgcn_global_load_lds((const unsigned*)((PT) + (size_t)(kb) + (size_t)(h) * hstep + voffA[_i]), (PG8_LAS unsigned*)(lds + (bufoff) + ldsw + _i * 8192), 16, 0, 0); } } while (0)
#define PG8_LDA(dst, b, h) do { _Pragma("unroll") for (int m = 0; m < 4; ++m) _Pragma("unroll") for (int k = 0; k < 2; ++k) dst[m][k] = *(const PG8_LAS bf16x8*)(lds + PG8_SA(b, h) + aoff + m * 2048 + k * 1024); } while (0)
#define PG8_LDB(dst, b, h) do { _Pragma("unroll") for (int n = 0; n < 2; ++n) _Pragma("unroll") for (int k = 0; k < 2; ++k) dst[n][k] = *(const PG8_LAS bf16x8*)(lds + PG8_SB(b, h) + boff + n * 2048 + k * 1024); } while (0)
#define PG8_MMA(ai, bj, At, Bt) do { __builtin_amdgcn_s_setprio(1); _Pragma("unroll") for (int m = 0; m < 4; ++m) _Pragma("unroll") for (int n = 0; n < 2; ++n) _Pragma("unroll") for (int k = 0; k < 2; ++k) \
        acc[ai][bj][m][n] = __builtin_amdgcn_mfma_f32_16x16x32_bf16(Bt[n][k], At[m][k], acc[ai][bj][m][n], 0, 0, 0); __builtin_amdgcn_s_setprio(0); } while (0)
#define PG8_WAIT_V(n) asm volatile("s_waitcnt vmcnt(" #n ")" ::: "memory")
#define PG8_WAIT_L(n) asm volatile("s_waitcnt lgkmcnt(" #n ")" ::: "memory")
#define PG8_BAR __builtin_amdgcn_s_barrier()
#define PG8_SCHED __builtin_amdgcn_sched_barrier(0)
    Unit cur, nxt; int ui = 0;
    if (!S.next(0, cur)) return;
    f32x4 acc[2][2][4][2];
#pragma unroll
    for (int a = 0; a < 2; ++a)
#pragma unroll
        for (int b = 0; b < 2; ++b)
#pragma unroll
            for (int m = 0; m < 4; ++m)
#pragma unroll
                for (int n = 0; n < 2; ++n) acc[a][b][m][n] = (f32x4){0.f, 0.f, 0.f, 0.f};
    bf16x8 At[4][2], B0[2][2], B1[2][2];
    unsigned aC[2][2], aN[2][2];
    if constexpr (GATHER) {
#pragma unroll
    for (int h = 0; h < 2; ++h)
#pragma unroll
        for (int i = 0; i < 2; ++i) aC[h][i] = g.a_off(0, cur, h * HALF + RA[i], CA[i]);
    }
    const char* const Ab = g.a_base(); const char* cB = g.b_tile(cur); const char* cA = g.a_tile(cur);
    PG8_STAGE_B(PG8_SB(0, 0), cB); PG8_STAGE_B(PG8_SB(0, 1), cB + hstep); PG8_STAGE_A(PG8_SA(0, 0), cA, 0, aC, 0); PG8_STAGE_A(PG8_SA(0, 1), cA, 0, aC, 1);
    if (wr == 1) PG8_BAR;
    PG8_WAIT_V(2); PG8_BAR;
    PG8_STAGE_B(PG8_SB(1, 0), cB + kstep); PG8_STAGE_A(PG8_SA(1, 0), cA, kstep, aC, 0); PG8_STAGE_B(PG8_SB(1, 1), cB + hstep + kstep);
    PG8_WAIT_V(6); PG8_BAR;
    for (;;) {
        const bool has_next = S.next(ui + 1, nxt);
        const char* nB = cB; const char* nA = cA;
        if (has_next) {
            if constexpr (GATHER) {
#pragma unroll
            for (int h = 0; h < 2; ++h)
#pragma unroll
                for (int i = 0; i < 2; ++i) aN[h][i] = g.a_off(ui + 1, nxt, h * HALF + RA[i], CA[i]);
            }
            nB = g.b_tile(nxt); nA = g.a_tile(nxt);
        } else {
            if constexpr (GATHER) {
#pragma unroll
            for (int h = 0; h < 2; ++h)
#pragma unroll
                for (int i = 0; i < 2; ++i) aN[h][i] = aC[h][i];
            }
        }
        for (int t = 0; t < nt; t += 2) {
            const bool last = (t == nt - 2);
            const size_t k1 = (size_t)(t + 1) * kstep;
            const size_t k2 = last ? (size_t)0 : (size_t)(t + 2) * kstep, k3 = k2 + kstep;
            const char* b2 = last ? nB : cB + (size_t)(t + 2) * kstep; const char* b3 = b2 + kstep;
            const char* a2p = last ? nA : cA;
            unsigned a2[2][2];
            if constexpr (GATHER) {
#pragma unroll
            for (int h = 0; h < 2; ++h)
#pragma unroll
                for (int i = 0; i < 2; ++i) a2[h][i] = last ? aN[h][i] : aC[h][i];
            }
            PG8_LDB(B0, 0, 0); PG8_LDB(B1, 0, 1); PG8_SCHED; PG8_LDA(At, 0, 0); PG8_STAGE_A(PG8_SA(1, 1), cA, k1, aC, 1);
            PG8_WAIT_V(8); PG8_WAIT_L(0); PG8_BAR; PG8_MMA(0, 0, At, B0); PG8_MMA(0, 1, At, B1); PG8_BAR; PG8_SCHED;
            PG8_LDA(At, 0, 1); PG8_STAGE_B(PG8_SB(0, 0), b2); PG8_STAGE_B(PG8_SB(0, 1), b2 + hstep); PG8_STAGE_A(PG8_SA(0, 0), a2p, k2, a2, 0);
            PG8_WAIT_V(8); PG8_WAIT_L(0); PG8_BAR; PG8_MMA(1, 0, At, B0); PG8_MMA(1, 1, At, B1); PG8_BAR; PG8_SCHED;
            PG8_LDB(B0, 1, 0); PG8_LDB(B1, 1, 1); PG8_SCHED; PG8_LDA(At, 1, 0); PG8_STAGE_A(PG8_SA(0, 1), a2p, k2, a2, 1);
            PG8_WAIT_V(8); PG8_WAIT_L(0); PG8_BAR; PG8_MMA(0, 0, At, B0); PG8_MMA(0, 1, At, B1); PG8_BAR; PG8_SCHED;
            PG8_LDA(At, 1, 1); PG8_STAGE_B(PG8_SB(1, 0), b3); PG8_STAGE_B(PG8_SB(1, 1), b3 + hstep); PG8_STAGE_A(PG8_SA(1, 0), a2p, k3, a2, 0);
            PG8_WAIT_V(8); PG8_WAIT_L(0); PG8_BAR; PG8_MMA(1, 0, At, B0); PG8_MMA(1, 1, At, B1); PG8_BAR; PG8_SCHED;
        }
        if constexpr (ALIGN_EPI) { if (wr == 0) PG8_BAR; }
        E(acc, cur, ui, wr, wc, fr, fq);
        if (!has_next) break;
#pragma unroll
        for (int a = 0; a < 2; ++a)
#pragma unroll
            for (int b = 0; b < 2; ++b)
#pragma unroll
                for (int m = 0; m < 4; ++m)
#pragma unroll
                    for (int n = 0; n < 2; ++n) acc[a][b][m][n] = (f32x4){0.f, 0.f, 0.f, 0.f};
        cur = nxt; cB = nB; cA = nA; ++ui;
        if constexpr (GATHER) {
#pragma unroll
        for (int h = 0; h < 2; ++h)
#pragma unroll
            for (int i = 0; i < 2; ++i) aC[h][i] = aN[h][i];
        }
        if constexpr (ALIGN_EPI) { if (wr == 1) PG8_BAR; }
    }
    PG8_WAIT_V(0);
    if constexpr (!ALIGN_EPI) { if (wr == 0) PG8_BAR; }
    PG8_BAR;
#undef PG8_SA
#undef PG8_SB
#undef PG8_STAGE_A
#undef PG8_STAGE_B
#undef PG8_LDA
#undef PG8_LDB
#undef PG8_MMA
#undef PG8_WAIT_V
#undef PG8_WAIT_L
#undef PG8_BAR
#undef PG8_SCHED
}
}
namespace att {
#define ATT_LAS __attribute__((address_space(3)))
#define ATT_GAS __attribute__((address_space(1)))
typedef unsigned short bf16;
using bf16x8 = __attribute__((ext_vector_type(8))) short;
using s16x4  = __attribute__((ext_vector_type(4))) short;
using f32x16 = __attribute__((ext_vector_type(16))) float;
using u32x4  = __attribute__((ext_vector_type(4))) unsigned;
constexpr int NW = 8, QBLK = 32, KVBLK = 64;
constexpr float THR = 8.f;
constexpr int SHM_V = 8192, KBUF = 13312, OFF_K = 3 * SHM_V, OFF_WS = OFF_K + 3 * KBUF, OFF_BT = OFF_WS + NW * 64 * 4, OFF_OST = OFF_BT + 8192, LDS_BYTES = OFF_OST + NW * 4608;
#define SBAR() __builtin_amdgcn_sched_barrier(0)
__device__ __forceinline__ int crow(int r, int hi) { return (r & 3) + 8 * (r >> 2) + 4 * hi; }
__device__ __forceinline__ unsigned cvtpk(float lo, float hi) { unsigned r; asm volatile("v_cvt_pk_bf16_f32 %0, %1, %2" : "=v"(r) : "v"(lo), "v"(hi)); return r; }
__device__ __forceinline__ int clampi(int v, int lo, int hi) { return v < lo ? lo : (v > hi ? hi : v); }

template <bool TWO>
__device__ __forceinline__ void partialSM(f32x16& p0, f32x16& p1, float& m_reg, f32x16& negm, f32x16& negm2, float& alpha, bool& have_ref) {
  float pmax = fmaxf(fmaxf(p0[0], p0[1]), p1[0]);
#pragma unroll
  for (int r = 2; r < 16; r += 2) pmax = fmaxf(fmaxf(pmax, p0[r]), p0[r + 1]);
#pragma unroll
  for (int r = 1; r < 15; r += 2) pmax = fmaxf(fmaxf(pmax, p1[r]), p1[r + 1]);
  pmax = fmaxf(pmax, p1[15]);
  { auto rr = __builtin_amdgcn_permlane32_swap(__float_as_uint(pmax), __float_as_uint(pmax), false, false);
    pmax = fmaxf(__uint_as_float(rr[0]), __uint_as_float(rr[1])); }
  alpha = 1.f;
  if (__builtin_expect(!have_ref || !__all(pmax <= THR), 0)) { const float dl = have_ref ? fmaxf(pmax, 0.f) : pmax; have_ref = true; m_reg += dl; alpha = __builtin_amdgcn_exp2f(-dl);
#pragma unroll
    for (int r = 0; r < 16; ++r) { p0[r] -= dl; p1[r] -= dl; }
#pragma unroll
    for (int r = 0; r < 16; ++r) negm[r] -= dl;
    asm volatile("" : "+v"(negm));
    if constexpr (TWO) {
#pragma unroll
      for (int r = 0; r < 16; ++r) negm2[r] -= dl;
      asm volatile("" : "+v"(negm2)); } }
#pragma unroll
  for (int r = 0; r < 16; ++r) p0[r] = __builtin_amdgcn_exp2f(p0[r]);
}
__device__ __forceinline__ float psm_max(const f32x16& p0, const f32x16& p1) {
  float pmax = fmaxf(fmaxf(p0[0], p0[1]), p1[0]);
#pragma unroll
  for (int r = 2; r < 16; r += 2) pmax = fmaxf(fmaxf(pmax, p0[r]), p0[r + 1]);
#pragma unroll
  for (int r = 1; r < 15; r += 2) pmax = fmaxf(fmaxf(pmax, p1[r]), p1[r + 1]);
  pmax = fmaxf(pmax, p1[15]);
  auto rr = __builtin_amdgcn_permlane32_swap(__float_as_uint(pmax), __float_as_uint(pmax), false, false);
  return fmaxf(__uint_as_float(rr[0]), __uint_as_float(rr[1]));
}
__device__ __forceinline__ void psm_decide(f32x16& p0, f32x16& p1, float pmax, float& m_reg, f32x16& negm, float& alpha, bool& have_ref) {
  alpha = 1.f;
  if (__builtin_expect(!have_ref || !__all(pmax <= THR), 0)) { const float dl = have_ref ? fmaxf(pmax, 0.f) : pmax; have_ref = true; m_reg += dl; alpha = __builtin_amdgcn_exp2f(-dl);
#pragma unroll
    for (int r = 0; r < 16; ++r) { p0[r] -= dl; p1[r] -= dl; }
#pragma unroll
    for (int r = 0; r < 16; ++r) negm[r] -= dl;
    asm volatile("" : "+v"(negm)); }
}
__device__ __forceinline__ void psm_exp(f32x16& p0) {
#pragma unroll
  for (int r = 0; r < 16; ++r) p0[r] = __builtin_amdgcn_exp2f(p0[r]);
}
__device__ __forceinline__ void finishSM(f32x16& p0, f32x16& p1, float alpha, float& l_reg, bf16x8& pa0, bf16x8& pa1, bf16x8& pa2, bf16x8& pa3) {
#pragma unroll
  for (int r = 0; r < 16; ++r) p1[r] = __builtin_amdgcn_exp2f(p1[r]);
  float ps;
  { typedef float f8 __attribute__((ext_vector_type(8))); typedef float f4 __attribute__((ext_vector_type(4))); typedef float f2 __attribute__((ext_vector_type(2)));
    const f32x16 t16 = p0 + p1; const f8 t8 = t16.lo + t16.hi; const f4 t4 = t8.lo + t8.hi; const f2 t2 = t4.lo + t4.hi; ps = t2.x + t2.y; }
  { auto rr = __builtin_amdgcn_permlane32_swap(__float_as_uint(ps), __float_as_uint(ps), false, false);
    ps = __uint_as_float(rr[0]) + __uint_as_float(rr[1]); }
  l_reg = l_reg * alpha + ps;
#define PK4(P, BASE, OUT) do { unsigned a0 = cvtpk(P[BASE + 0], P[BASE + 1]), a1 = cvtpk(P[BASE + 2], P[BASE + 3]);   \
    unsigned b0 = cvtpk(P[BASE + 4], P[BASE + 5]), b1 = cvtpk(P[BASE + 6], P[BASE + 7]);                              \
    auto r0 = __builtin_amdgcn_permlane32_swap(a0, b0, false, false); auto r1 = __builtin_amdgcn_permlane32_swap(a1, b1, false, false); \
    u32x4 w = {r0[0], r1[0], r0[1], r1[1]}; OUT = __builtin_bit_cast(bf16x8, w); } while (0)
  PK4(p0, 0, pa0); PK4(p0, 8, pa1); PK4(p1, 0, pa2); PK4(p1, 8, pa3);
#undef PK4
}
template <int DQK, int H> __device__ __forceinline__ void kload(bf16x8* kf, const ATT_LAS char* Ks, int r32, int hi) {
  constexpr int KST = DQK * 2 + 16, NH = DQK / 32;
#pragma unroll
  for (int i = 0; i < NH; ++i) { const int d0 = H * NH + i; const int cb = (d0 * 16 + hi * 8) * 2;
    kf[2 * i] = *(const ATT_LAS bf16x8*)(Ks + r32 * KST + cb);
    kf[2 * i + 1] = *(const ATT_LAS bf16x8*)(Ks + (32 + r32) * KST + cb); }
}
template <int DQK, int H> __device__ __forceinline__ void qk_mma(f32x16& p0, f32x16& p1, const bf16x8* kf, const bf16x8* qr, const f32x16& negm, const f32x16& negm2) {
  constexpr int NH = DQK / 32;
  if (H == 0) { p0 = negm; p1 = negm2; }
#pragma unroll
  for (int i = 0; i < NH; ++i) { const int d0 = H * NH + i;
    p0 = __builtin_amdgcn_mfma_f32_32x32x16_bf16(kf[2 * i], qr[d0], p0, 0, 0, 0);
    p1 = __builtin_amdgcn_mfma_f32_32x32x16_bf16(kf[2 * i + 1], qr[d0], p1, 0, 0, 0); }
}
__device__ __forceinline__ int v_st(int k, int c) { const int kk = (k & ~0xC) | ((k & 4) << 1) | ((k & 8) >> 1); return ((kk >> 3) * 2 + (c >> 5)) * 512 + ((kk & 7) * 32 + (c & 31)) * 2; }
__device__ __forceinline__ int v_rd_base(int lane) { return ((lane & 3) << 3) | (((lane >> 2) & 3) << 6) | (((lane >> 4) & 1) << 5) | (((lane >> 5) & 1) << 8); }
constexpr int v_rd_off(int d0, int ks, int half) { return d0 * 512 + ks * 2048 + half * 1024; }
typedef short v4i16_t __attribute__((ext_vector_type(4)));
__device__ __forceinline__ s16x4 vtr(const ATT_LAS char* p) { return __builtin_bit_cast(s16x4, __builtin_amdgcn_ds_read_tr16_b64_v4i16((ATT_LAS v4i16_t*)p)); }
__device__ __forceinline__ void vload(s16x4* vf, const ATT_LAS char* vp) {
#pragma unroll
  for (int d0 = 0; d0 < 2; ++d0)
#pragma unroll
    for (int ks = 0; ks < 4; ++ks) { vf[d0 * 8 + ks * 2] = vtr(vp + v_rd_off(d0, ks, 0)); vf[d0 * 8 + ks * 2 + 1] = vtr(vp + v_rd_off(d0, ks, 1)); }
}
template <int D0> __device__ __forceinline__ void pv_mma1(f32x16& od, const s16x4* vf, bf16x8 pa0, bf16x8 pa1, bf16x8 pa2, bf16x8 pa3) {
#define PKV(i) (bf16x8){vf[i][0], vf[i][1], vf[i][2], vf[i][3], vf[(i) + 1][0], vf[(i) + 1][1], vf[(i) + 1][2], vf[(i) + 1][3]}
  od = __builtin_amdgcn_mfma_f32_32x32x16_bf16(pa0, PKV(D0 * 8 + 0), od, 0, 0, 0);
  od = __builtin_amdgcn_mfma_f32_32x32x16_bf16(pa1, PKV(D0 * 8 + 2), od, 0, 0, 0);
  od = __builtin_amdgcn_mfma_f32_32x32x16_bf16(pa2, PKV(D0 * 8 + 4), od, 0, 0, 0);
  od = __builtin_amdgcn_mfma_f32_32x32x16_bf16(pa3, PKV(D0 * 8 + 6), od, 0, 0, 0);
#undef PKV
}
__device__ __forceinline__ void pv_mma(f32x16* o, const s16x4* vf, bf16x8 pa0, bf16x8 pa1, bf16x8 pa2, bf16x8 pa3) {
#define PKV(i) (bf16x8){vf[i][0], vf[i][1], vf[i][2], vf[i][3], vf[(i) + 1][0], vf[(i) + 1][1], vf[(i) + 1][2], vf[(i) + 1][3]}
#pragma unroll
  for (int d0 = 0; d0 < 2; ++d0) {
    o[d0] = __builtin_amdgcn_mfma_f32_32x32x16_bf16(pa0, PKV(d0 * 8 + 0), o[d0], 0, 0, 0);
    o[d0] = __builtin_amdgcn_mfma_f32_32x32x16_bf16(pa1, PKV(d0 * 8 + 2), o[d0], 0, 0, 0);
    o[d0] = __builtin_amdgcn_mfma_f32_32x32x16_bf16(pa2, PKV(d0 * 8 + 4), o[d0], 0, 0, 0);
    o[d0] = __builtin_amdgcn_mfma_f32_32x32x16_bf16(pa3, PKV(d0 * 8 + 6), o[d0], 0, 0, 0); }
#undef PKV
}

struct AttnIO { const ATT_GAS bf16* q; const ATT_GAS bf16* k; const ATT_GAS bf16* k2; const ATT_GAS bf16* v; ATT_GAS bf16* o; int ldq, ldk, ldk2, ldv, ldo; };

__device__ __forceinline__ bool mla_fixed_ref(const AttnIO io, float km2, float& mrow) {
  int tid_ = threadIdx.x; asm volatile("" : "+v"(tid_));
  const int wid = __builtin_amdgcn_readfirstlane(tid_ >> 6), lane = tid_ & 63, r32 = lane & 31, hi = lane >> 5;
  const ATT_GAS bf16* Qw = io.q + (size_t)(wid * QBLK + r32) * io.ldq + hi * 8; float q2 = 0.f;
#pragma unroll
  for (int d0 = 0; d0 < 6; ++d0) { const bf16x8 v = *(const ATT_GAS bf16x8*)(Qw + d0 * 16);
#pragma unroll
    for (int e = 0; e < 8; ++e) { const float x = __uint_as_float((unsigned)(unsigned short)v[e] << 16); q2 += x * x; } }
  { auto rr = __builtin_amdgcn_permlane32_swap(__float_as_uint(q2), __float_as_uint(q2), false, false); q2 = __uint_as_float(rr[0]) + __uint_as_float(rr[1]); }
  mrow = sqrtf(q2 * km2) * 1.02f;
  return __all(mrow <= 64.f);
}
template <int MODE, bool FIXED = false>
__device__ __forceinline__ void attn_unit(const AttnIO io, const int par, const float sinkl2, const ATT_GAS float* rpb_h, ATT_LAS char* lds) {
  constexpr int DQK = (MODE == 0) ? 96 : 64, ND0 = DQK / 16, KST = DQK * 2 + 16;
  int tid_ = threadIdx.x; asm volatile("" : "+v"(tid_));
  const int tid = tid_, wid = __builtin_amdgcn_readfirstlane(tid >> 6), lane = tid & 63, r32 = lane & 31, hi = lane >> 5;
  ATT_LAS char* V_lds = lds; ATT_LAS char* K_lds = lds + OFF_K;
  ATT_LAS float* ws = (ATT_LAS float*)(lds + OFF_WS) + wid * 64; ATT_LAS float* li_l = ws; ATT_LAS float* al_l = ws + 32;
  ATT_LAS float* btab = (ATT_LAS float*)(lds + OFF_BT);
  int NT, t0, r0w = 0, rq = 0;
  if constexpr (MODE == 0) { NT = 64; t0 = 0; }
  else if constexpr (MODE == 1) { const int rq0 = 4 * par; const int klo = clampi(rq0 - 4, 0, 56), khi = clampi(rq0 - 1, 0, 56) + 7; NT = (khi - klo + 2) & ~1; t0 = klo;
    rq = rq0 + (wid >> 1); r0w = clampi(rq - 4, 0, 56);
    for (int i = tid; i < 15 * 128; i += 512) { const int dc = (i & 127) - 63; btab[i] = (dc >= -15 && dc <= 15) ? rpb_h[(i >> 7) * 31 + dc + 15] * 1.4426950408889634f : 0.f; } }
  else { NT = 8; t0 = 4 * par - 2; }
#define ACTIVE(j) ((MODE == 0) ? true : (MODE == 1) ? (((t0 + (j)) >= r0w) && ((t0 + (j)) < r0w + 8)) : \
                   (((t0 + (j)) >= 0) && ((t0 + (j)) <= 63) && (64 * (j) + 63 >= 32 * wid) && (64 * (j) <= 32 * wid + 287)))
  float m_reg = (MODE == 2) ? sinkl2 : 0.f, l_reg = (MODE == 2) ? 1.f : 0.f; f32x16 o[2] = {}; bf16x8 qr[ND0];
  { const ATT_GAS bf16* Qw = io.q + (size_t)(wid * QBLK + r32) * io.ldq + hi * 8;
#pragma unroll
    for (int d0 = 0; d0 < ND0; ++d0) qr[d0] = *(const ATT_GAS bf16x8*)(Qw + d0 * 16); }
  constexpr bool fixed = FIXED;
  if constexpr (FIXED) m_reg = sinkl2;
  f32x16 negm;
#pragma unroll
  for (int r = 0; r < 16; ++r) negm[r] = -m_reg;
  f32x16 negm2v;
  if constexpr (MODE == 1) { const int qc_ = 32 * (wid & 1) + r32; const int c0_ = clampi(qc_ - 8, 0, 48);
#pragma unroll
    for (int r = 0; r < 16; ++r) { const int ka_ = crow(r, hi), kb_ = ka_ + 32; negm2v[r] = ((kb_ >= c0_) && (kb_ < c0_ + 16)) ? 0.f : -1e30f; negm[r] = ((ka_ >= c0_) && (ka_ < c0_ + 16)) ? 0.f : -1e30f; }
    asm volatile("" : "+v"(negm2v)); }
  asm volatile("" : "+v"(negm));
#define NEGM2 (*((MODE == 1) ? &negm2v : &negm))
  const int sr = tid >> 3, sc = (tid & 7) * 8, vst0 = v_st(sr, sc), kst0 = sr * KST + sc * 2;
  const int sr2 = (tid & 255) >> 2, sc2 = (tid & 3) * 8, kst2 = sr2 * KST + (64 + sc2) * 2;
  const ATT_LAS char* vb0 = V_lds + v_rd_base(lane);
  bf16x8 st_v, st_k, st_k2;
#define TOK(j) (64 * clampi(t0 + (j), 0, 63))
#define SLOAD(j) do { const int tk_ = TOK(j); st_v = *(const ATT_GAS bf16x8*)(io.v + (size_t)(tk_ + sr) * io.ldv + sc); \
    st_k = *(const ATT_GAS bf16x8*)(io.k + (size_t)(tk_ + sr) * io.ldk + sc); \
    if constexpr (MODE == 0) { if (wid < 4) st_k2 = *(const ATT_GAS bf16x8*)(io.k2 + (size_t)(tk_ + sr2) * io.ldk2 + sc2); } } while (0)
#define SWRITE(b) do { *(ATT_LAS bf16x8*)(V_lds + (b) * SHM_V + vst0) = st_v; *(ATT_LAS bf16x8*)(K_lds + (b) * KBUF + kst0) = st_k; \
    if constexpr (MODE == 0) { if (wid < 4) *(ATT_LAS bf16x8*)(K_lds + (b) * KBUF + kst2) = st_k2; } } while (0)
#define RESC(a) do { if (__any((a) < 1.f)) { if (hi == 0) al_l[r32] = (a); asm volatile("s_waitcnt lgkmcnt(0)" ::: "memory"); \
    _Pragma("unroll") for (int d = 0; d < 2; ++d) _Pragma("unroll") for (int r = 0; r < 16; ++r) o[d][r] *= al_l[crow(r, hi)]; } } while (0)
#define MASK(P0, P1, j) do { \
    if constexpr (MODE == 1) { const ATT_LAS float* bt_ = btab + ((t0 + (j)) - rq + 7) * 128 + (4 * hi - (32 * (wid & 1) + r32) + 63); \
      _Pragma("unroll") for (int r = 0; r < 16; ++r) { P0[r] += bt_[(r & 3) + 8 * (r >> 2)]; P1[r] += bt_[(r & 3) + 8 * (r >> 2) + 32]; } } \
    else if constexpr (MODE == 2) { if (!((64 * (j) - 32 * wid - 31 >= 0) && (64 * (j) - 32 * wid <= 193))) { const int rel_ = 64 * (j) - 128 - 32 * wid - r32; \
      _Pragma("unroll") for (int r = 0; r < 16; ++r) { const int da_ = rel_ + crow(r, hi), db_ = da_ + 32; \
        P0[r] = (da_ >= -128 && da_ <= 128) ? P0[r] : -1e30f; P1[r] = (db_ >= -128 && db_ <= 128) ? P1[r] : -1e30f; } } } } while (0)
  f32x16 pA0, pA1, pB0, pB1; float alA = 1.f, alB = 1.f; bf16x8 pa0, pa1, pa2, pa3;
  bool actA = false, actB = false, have_ref = (MODE == 2) || fixed;
  int bc = 0, bp = 2, bn = 1;
#define ROT() do { const int t_ = bp; bp = bc; bc = bn; bn = t_; } while (0)
#define QKALL(P0, P1, Kp) do { bf16x8 kf0_[ND0], kf1_[ND0]; kload<DQK, 0>(kf0_, Kp, r32, hi); kload<DQK, 1>(kf1_, Kp, r32, hi); SBAR(); \
      qk_mma<DQK, 0>(P0, P1, kf0_, qr, negm, NEGM2); qk_mma<DQK, 1>(P0, P1, kf1_, qr, negm, NEGM2); } while (0)
#define SGB(mask, n) __builtin_amdgcn_sched_group_barrier(mask, n, 0)
#define STEP(PX0, PX1, alX, actX, PY0, PY1, alY, actY, j) do { \
    if ((j) + 1 < NT) SWRITE(bn); \
    if ((j) + 2 < NT) SLOAD((j) + 2); \
    actX = ACTIVE(j); \
    const ATT_LAS char* Kc_ = K_lds + bc * KBUF; const ATT_LAS char* vp_ = vb0 + bp * SHM_V; \
    SBAR(); \
    if constexpr (MODE == 0) { \
        \
      { bf16x8 kf0_[ND0], kf1_[ND0]; kload<DQK, 0>(kf0_, Kc_, r32, hi); kload<DQK, 1>(kf1_, Kc_, r32, hi); \
        qk_mma<DQK, 0>(PX0, PX1, kf0_, qr, negm, negm); qk_mma<DQK, 1>(PX0, PX1, kf1_, qr, negm, negm); \
        finishSM(PY0, PY1, alY, l_reg, pa0, pa1, pa2, pa3); \
        SGB(0x100, 12); \
        _Pragma("unroll") for (int g_ = 0; g_ < 12; ++g_) { SGB(0x008, 1); SGB(0x402, 6); } } \
      SBAR(); \
      { s16x4 vf_[16]; vload(vf_, vp_); \
        pv_mma1<0>(o[0], vf_, pa0, pa1, pa2, pa3); \
        const float pm_ = psm_max(PX0, PX1); \
        SGB(0x100, 16); \
        _Pragma("unroll") for (int g_ = 0; g_ < 4; ++g_) { SGB(0x008, 1); SGB(0x402, 10); } \
        SBAR(); \
        psm_decide(PX0, PX1, pm_, m_reg, negm, alX, have_ref); \
        SBAR(); \
        pv_mma1<1>(o[1], vf_, pa0, pa1, pa2, pa3); \
        psm_exp(PX0); \
        _Pragma("unroll") for (int g_ = 0; g_ < 4; ++g_) { SGB(0x008, 1); SGB(0x402, 4); } } \
      SBAR(); \
      RESC(alX); \
    } else { \
      if (actX) { QKALL(PX0, PX1, Kc_); MASK(PX0, PX1, j); } SBAR(); \
      if (actY) { s16x4 vf_[16]; vload(vf_, vp_); SBAR(); finishSM(PY0, PY1, alY, l_reg, pa0, pa1, pa2, pa3); SBAR(); pv_mma(o, vf_, pa0, pa1, pa2, pa3); } SBAR(); \
      if (actX) { partialSM<MODE == 1>(PX0, PX1, m_reg, negm, NEGM2, alX, have_ref); RESC(alX); } \
    } \
    ROT(); \
    __syncthreads(); } while (0)
#define STEPF(PX0, PX1, PY0, PY1, j) do { \
    if ((j) + 1 < NT) SWRITE(bn); \
    if ((j) + 2 < NT) SLOAD((j) + 2); \
    const ATT_LAS char* Kc_ = K_lds + bc * KBUF; const ATT_LAS char* vp_ = vb0 + bp * SHM_V; \
    SBAR(); \
    { bf16x8 kf0_[ND0], kf1_[ND0]; kload<DQK, 0>(kf0_, Kc_, r32, hi); kload<DQK, 1>(kf1_, Kc_, r32, hi); \
      qk_mma<DQK, 0>(PX0, PX1, kf0_, qr, negm, negm); qk_mma<DQK, 1>(PX0, PX1, kf1_, qr, negm, negm); \
      finishSM(PY0, PY1, 1.f, l_reg, pa0, pa1, pa2, pa3); \
      SGB(0x100, 12); \
      _Pragma("unroll") for (int g_ = 0; g_ < 12; ++g_) { SGB(0x008, 1); SGB(0x402, 6); } } \
    SBAR(); \
    { s16x4 vf_[16]; vload(vf_, vp_); \
      pv_mma(o, vf_, pa0, pa1, pa2, pa3); \
      psm_exp(PX0); \
      SGB(0x100, 16); \
      _Pragma("unroll") for (int g_ = 0; g_ < 8; ++g_) { SGB(0x008, 1); SGB(0x402, 2); } } \
    SBAR(); \
    ROT(); \
    __syncthreads(); } while (0)
  SLOAD(0); SWRITE(0); SLOAD(1); __syncthreads();
  actA = ACTIVE(0);
  SWRITE(1); if (2 < NT) SLOAD(2);
  if (actA) { QKALL(pA0, pA1, K_lds); MASK(pA0, pA1, 0); if (MODE == 0 && fixed) psm_exp(pA0); else partialSM<MODE == 1>(pA0, pA1, m_reg, negm, NEGM2, alA, have_ref); }
  ROT(); __syncthreads();
  if constexpr (MODE == 0 && FIXED) {
    actB = true;
    for (int j = 1; j + 1 < NT; j += 2) {
      STEPF(pB0, pB1, pA0, pA1, j);
      STEPF(pA0, pA1, pB0, pB1, j + 1);
    }
    STEPF(pB0, pB1, pA0, pA1, NT - 1);
  } else {
  for (int j = 1; j + 1 < NT; j += 2) {
    STEP(pB0, pB1, alB, actB, pA0, pA1, alA, actA, j);
    STEP(pA0, pA1, alA, actA, pB0, pB1, alB, actB, j + 1);
  }
  STEP(pB0, pB1, alB, actB, pA0, pA1, alA, actA, NT - 1);
  }
  if (actB) { s16x4 vf_[16]; vload(vf_, vb0 + bp * SHM_V); finishSM(pB0, pB1, alB, l_reg, pa0, pa1, pa2, pa3); SBAR(); pv_mma(o, vf_, pa0, pa1, pa2, pa3); }
#undef STEP
#undef STEPF
#undef SGB
#undef QKALL
#undef NEGM2
#undef ROT
  if (hi == 0) li_l[r32] = l_reg; asm volatile("s_waitcnt lgkmcnt(0)" ::: "memory");
  float rli[16];
#pragma unroll
  for (int r = 0; r < 16; ++r) rli[r] = __builtin_amdgcn_rcpf(li_l[crow(r, hi)]);
  ATT_GAS bf16* Ow = io.o + (size_t)(wid * QBLK) * io.ldo;
  { ATT_LAS char* stg = lds + OFF_OST + wid * 4608;
#pragma unroll
    for (int r = 0; r < 16; ++r) { const int orow = crow(r, hi);
#pragma unroll
      for (int d0 = 0; d0 < 2; ++d0) { const float val = o[d0][r] * rli[r]; *(ATT_LAS bf16*)(stg + orow * 144 + (d0 * 32 + r32) * 2) = (bf16)(cvtpk(val, val) & 0xffffu); } }
    asm volatile("s_waitcnt lgkmcnt(0)" ::: "memory");
#pragma unroll
    for (int i = 0; i < 4; ++i) { const int row = i * 8 + (lane >> 3), ch = lane & 7; const u32x4 v = *(const ATT_LAS u32x4*)(stg + row * 144 + ch * 16); *(ATT_GAS u32x4*)(Ow + (size_t)row * io.ldo + ch * 8) = v; } }
  __syncthreads();
#undef ACTIVE
#undef TOK
#undef SLOAD
#undef SWRITE
#undef RESC
#undef MASK
}

constexpr int K16B = 12288, V16B = 10240, V16ST = 160, OFF16_V = 3 * K16B, OFF16_WS = OFF16_V + 3 * V16B, OFF16_OST = OFF16_WS + NW * 256, OFF_FLAG = 122880;
static_assert(OFF16_OST + NW * 4608 <= OFF_FLAG && LDS_BYTES <= OFF_FLAG, "attention LDS map");
__device__ __forceinline__ int fkey(int k) { return (4 - ((k >> 2) & 3)) & 3; }
template <int NQB>
__device__ __forceinline__ void attn_unit16(const AttnIO io, const int role, ATT_LAS char* lds) {
  typedef float f32x4 __attribute__((ext_vector_type(4)));
  int tid_ = threadIdx.x; asm volatile("" : "+v"(tid_));
  const int tid = tid_, wid = __builtin_amdgcn_readfirstlane(tid >> 6), lane = tid & 63, c = lane & 15, g = lane >> 4;
  ATT_LAS char* K_lds = lds; ATT_LAS char* V_lds = lds + OFF16_V;
  ATT_LAS float* li_l = (ATT_LAS float*)(lds + OFF16_WS) + wid * 64;
  constexpr int NT = 64, WQ = 16 * NQB;
  bf16x8 qf[NQB][3];
  { const ATT_GAS bf16* Qw = io.q + (size_t)(wid * WQ + c) * io.ldq + g * 8;
#pragma unroll
    for (int qb = 0; qb < NQB; ++qb)
#pragma unroll
      for (int ks = 0; ks < 3; ++ks) qf[qb][ks] = *(const ATT_GAS bf16x8*)(Qw + (size_t)(16 * qb) * io.ldq + ks * 32); }
  const int gch = (lane & 3) ^ ((4 - g) & 3);
  const unsigned koff = (unsigned)((16 * (wid & 3) + (lane >> 2)) * io.ldk + 32 * (wid >> 2) + 8 * gch) * 2u;
  const unsigned k2off = (unsigned)((16 * (wid & 3) + (lane >> 2)) * io.ldk2 + 8 * gch) * 2u;
  const int vsA = 64 * ((wid + 4) & 7) + lane, vsB = 64 * ((wid < 4 ? wid : wid + 4) + (wid < 4 ? 4 : 0)) + lane;
  const unsigned voffA = (unsigned)((vsA / 10) * io.ldv + 8 * ((vsA % 10) > 7 ? 7 : (vsA % 10))) * 2u, voffB = (unsigned)((vsB / 10) * io.ldv + 8 * ((vsB % 10) > 7 ? 7 : (vsB % 10))) * 2u;
  const ATT_LAS char* kb0 = K_lds + c * 64 + ((g ^ fkey(c)) * 16);
  const ATT_LAS char* vb0 = V_lds + (4 * g + ((lane >> 2) & 3)) * V16ST + (lane & 3) * 8;
#define DMA16(src, dst) do { const ATT_GAS char* s_ = (const ATT_GAS char*)(src); const unsigned d_ = (unsigned)__builtin_amdgcn_readfirstlane((int)(unsigned)(size_t)(dst)); \
    asm volatile("s_mov_b32 m0, %1\n\ts_nop 0\n\tglobal_load_lds_dwordx4 %0, off" :: "v"(s_), "s"(d_) : "memory", "m0"); } while (0)
#define STAGEK(j, b) do { DMA16((const ATT_GAS char*)(io.k + (size_t)(64 * (j)) * io.ldk) + koff, K_lds + (b) * K16B + wid * 1024); \
    if (wid < 4) DMA16((const ATT_GAS char*)(io.k2 + (size_t)(64 * (j)) * io.ldk2) + k2off, K_lds + (b) * K16B + (8 + wid) * 1024); } while (0)
#define STAGEV(j, b) do { DMA16((const ATT_GAS char*)(io.v + (size_t)(64 * (j)) * io.ldv) + voffA, V_lds + (b) * V16B + ((wid + 4) & 7) * 1024); \
    if (wid == 4 || wid == 5) DMA16((const ATT_GAS char*)(io.v + (size_t)(64 * (j)) * io.ldv) + voffB, V_lds + (b) * V16B + (wid + 4) * 1024); } while (0)
#define BAR16() do { asm volatile("s_waitcnt lgkmcnt(0)" ::: "memory"); __builtin_amdgcn_s_barrier(); asm volatile("" ::: "memory"); } while (0)
#define BAR16V() do { asm volatile("s_waitcnt vmcnt(0) lgkmcnt(0)" ::: "memory"); __builtin_amdgcn_s_barrier(); asm volatile("" ::: "memory"); } while (0)
#define KREAD(KF, Kc, ks, kp) do { _Pragma("unroll") for (int kb_ = 0; kb_ < 2; ++kb_) KF[kb_] = *(const ATT_LAS bf16x8*)((Kc) + (ks) * 4096 + (2 * (kp) + kb_) * 1024); } while (0)
#define VREAD(VF, Vc, s, dp) do { _Pragma("unroll") for (int db_ = 0; db_ < 2; ++db_) { const s16x4 lo_ = vtr((Vc) + (s) * 32 * V16ST + (2 * (dp) + db_) * 32), hi_ = vtr((Vc) + ((s) * 32 + 16) * V16ST + (2 * (dp) + db_) * 32); \
      VF[db_] = (bf16x8){lo_[0], lo_[1], lo_[2], lo_[3], hi_[0], hi_[1], hi_[2], hi_[3]}; } } while (0)
#define QKMMA(KF, ks, kp) do { _Pragma("unroll") for (int kb_ = 0; kb_ < 2; ++kb_) _Pragma("unroll") for (int qb_ = 0; qb_ < NQB; ++qb_) \
      S[2 * (kp) + kb_][qb_] = __builtin_amdgcn_mfma_f32_16x16x32_bf16(KF[kb_], qf[qb_][ks], ((ks) == 0) ? (f32x4){0.f, 0.f, 0.f, 0.f} : S[2 * (kp) + kb_][qb_], 0, 0, 0); } while (0)
#define PVMMA(VF, s, dp) do { _Pragma("unroll") for (int db_ = 0; db_ < 2; ++db_) _Pragma("unroll") for (int qb_ = 0; qb_ < NQB; ++qb_) \
      o[qb_][2 * (dp) + db_] = __builtin_amdgcn_mfma_f32_16x16x32_bf16(pa[qb_][s], VF[db_], o[qb_][2 * (dp) + db_], 0, 0, 0); } while (0)
#define QKALL16(Kc, KFA, KFB) do { KREAD(KFB, Kc, 1, 0); QKMMA(KFA, 0, 0); SBAR(); KREAD(KFA, Kc, 2, 0); QKMMA(KFB, 1, 0); SBAR(); KREAD(KFB, Kc, 0, 1); QKMMA(KFA, 2, 0); SBAR(); \
      KREAD(KFA, Kc, 1, 1); QKMMA(KFB, 0, 1); SBAR(); KREAD(KFB, Kc, 2, 1); QKMMA(KFA, 1, 1); SBAR(); QKMMA(KFB, 2, 1); } while (0)
  f32x4 o[NQB][4];
#pragma unroll
  for (int qb = 0; qb < NQB; ++qb)
#pragma unroll
    for (int db = 0; db < 4; ++db) o[qb][db] = (f32x4){0.f, 0.f, 0.f, 0.f};
  f32x4 lacc[NQB];
#pragma unroll
  for (int qb = 0; qb < NQB; ++qb) lacc[qb] = (f32x4){0.f, 0.f, 0.f, 0.f};
  bf16x8 ones8; { const u32x4 w1 = {0x3F803F80u, 0x3F803F80u, 0x3F803F80u, 0x3F803F80u}; ones8 = __builtin_bit_cast(bf16x8, w1); asm volatile("" : "+v"(ones8)); }
  f32x4 S[4][NQB];
  STAGEK(0, 0); STAGEV(0, 0); STAGEK(1, 1);
  asm volatile("s_waitcnt vmcnt(0)" ::: "memory"); __syncthreads();
  { bf16x8 kfA[2], kfB[2]; KREAD(kfA, kb0, 0, 0); QKALL16(kb0, kfA, kfB); }
  if (role) BAR16();
  int i0 = 0, i1 = 1, i2 = 2;
  for (int t = 0; t < NT; ++t) {
    if (t + 2 < NT) STAGEK(t + 2, i2);
    if (t + 1 < NT) STAGEV(t + 1, i1);
    const ATT_LAS char* Vc = vb0 + i0 * V16B; const ATT_LAS char* Kc = kb0 + i1 * K16B;
    bf16x8 vfA[2], vfB[2];
    bf16x8 pa[NQB][2];
#pragma unroll
    for (int qb = 0; qb < NQB; ++qb) {
#pragma unroll
      for (int kb = 0; kb < 4; ++kb)
#pragma unroll
        for (int r = 0; r < 4; ++r) S[kb][qb][r] = __builtin_amdgcn_exp2f(S[kb][qb][r]);
#pragma unroll
      for (int s = 0; s < 2; ++s) { const u32x4 w = {cvtpk(S[2 * s][qb][0], S[2 * s][qb][1]), cvtpk(S[2 * s][qb][2], S[2 * s][qb][3]),
                                                     cvtpk(S[2 * s + 1][qb][0], S[2 * s + 1][qb][1]), cvtpk(S[2 * s + 1][qb][2], S[2 * s + 1][qb][3])};
        pa[qb][s] = __builtin_bit_cast(bf16x8, w); }
      SBAR();
      if (qb == NQB / 2 - 1) { VREAD(vfA, Vc, 0, 0); SBAR(); } }
    BAR16V();
    { bf16x8 fC[2];
#define ONES16() do { _Pragma("unroll") for (int s_ = 0; s_ < 2; ++s_) _Pragma("unroll") for (int qb_ = 0; qb_ < NQB; ++qb_) lacc[qb_] = __builtin_amdgcn_mfma_f32_16x16x32_bf16(pa[qb_][s_], ones8, lacc[qb_], 0, 0, 0); } while (0)
      const bool nx = (t + 1 < NT);
      VREAD(vfB, Vc, 0, 1); VREAD(fC, Vc, 1, 0); SBAR();
      PVMMA(vfA, 0, 0); SBAR(); VREAD(vfA, Vc, 1, 1); SBAR();
      PVMMA(vfB, 0, 1); SBAR(); if (nx) KREAD(vfB, Kc, 0, 0); SBAR();
      PVMMA(fC, 1, 0); SBAR(); if (nx) KREAD(fC, Kc, 1, 0); SBAR();
      PVMMA(vfA, 1, 1); SBAR(); if (nx) KREAD(vfA, Kc, 2, 0); SBAR();
      ONES16(); SBAR();
      if (nx) {
        QKMMA(vfB, 0, 0); SBAR(); KREAD(vfB, Kc, 0, 1); SBAR();
        QKMMA(fC, 1, 0); SBAR(); KREAD(fC, Kc, 1, 1); SBAR();
        QKMMA(vfA, 2, 0); SBAR(); KREAD(vfA, Kc, 2, 1); SBAR();
        QKMMA(vfB, 0, 1); SBAR(); QKMMA(fC, 1, 1); SBAR(); QKMMA(vfA, 2, 1); }
#undef ONES16
    }
    BAR16();
    { const int t_ = i0; i0 = i1; i1 = i2; i2 = t_; }
  }
  if (!role) BAR16();
#undef STAGEK
#undef STAGEV
#undef DMA16
#undef KREAD
#undef VREAD
#undef QKMMA
#undef PVMMA
#undef QKALL16
  ATT_GAS bf16* Ow = io.o + (size_t)(wid * WQ) * io.ldo;
  { ATT_LAS char* stg = lds + OFF16_OST + wid * 4608;
#pragma unroll
    for (int hp = 0; hp < NQB / 2; ++hp) {
#pragma unroll
      for (int q2 = 0; q2 < 2; ++q2)
#pragma unroll
        for (int r = 0; r < 4; ++r) { const int qb = 2 * hp + q2, orow = 16 * q2 + 4 * g + r; const float rl = __builtin_amdgcn_rcpf(lacc[qb][r]);
#pragma unroll
          for (int db = 0; db < 4; ++db) { const float val = o[qb][db][r] * rl; *(ATT_LAS bf16*)(stg + orow * 144 + (db * 16 + c) * 2) = (bf16)(cvtpk(val, val) & 0xffffu); } }
      asm volatile("s_waitcnt lgkmcnt(0)" ::: "memory");
#pragma unroll
      for (int i = 0; i < 4; ++i) { const int row = i * 8 + (lane >> 3), ch = lane & 7; const u32x4 v = *(const ATT_LAS u32x4*)(stg + row * 144 + ch * 16); *(ATT_GAS u32x4*)(Ow + (size_t)(32 * hp + row) * io.ldo + ch * 8) = v; }
      asm volatile("s_waitcnt lgkmcnt(0)" ::: "memory"); } }
#undef BAR16
#undef BAR16V
  __syncthreads();
}
constexpr int SWW_LDS = 10240 + 256;
__device__ __forceinline__ void swa_wave_task(const ATT_GAS bf16* qp, const ATT_GAS bf16* kp, const ATT_GAS bf16* vp, ATT_GAS bf16* op, const int q0, const float sinkl2, ATT_LAS char* wl) {
  typedef float f32x4 __attribute__((ext_vector_type(4)));
  int tid_ = threadIdx.x; asm volatile("" : "+v"(tid_));
  const int lane = tid_ & 63, c = lane & 15, g = lane >> 4;
  ATT_LAS float* al = (ATT_LAS float*)(wl + 10240);
  bf16x8 qf[2][2];
#pragma unroll
  for (int qb = 0; qb < 2; ++qb)
#pragma unroll
    for (int ks = 0; ks < 2; ++ks) qf[qb][ks] = *(const ATT_GAS bf16x8*)(qp + (size_t)(q0 + 16 * qb + c) * 256 + 32 * ks + 8 * g);
  f32x4 o[2][4], lacc[2], negm[2]; float m[2];
#pragma unroll
  for (int qb = 0; qb < 2; ++qb) { m[qb] = sinkl2; negm[qb] = (f32x4){-sinkl2, -sinkl2, -sinkl2, -sinkl2}; lacc[qb] = (f32x4){1.f, 1.f, 1.f, 1.f};
#pragma unroll
    for (int db = 0; db < 4; ++db) o[qb][db] = (f32x4){0.f, 0.f, 0.f, 0.f}; }
  bf16x8 ones8; { const u32x4 w1 = {0x3F803F80u, 0x3F803F80u, 0x3F803F80u, 0x3F803F80u}; ones8 = __builtin_bit_cast(bf16x8, w1); }
  const int jt = q0 >> 6, tlo = (jt - 2 < 0) ? 0 : jt - 2, thi = (jt + 2 > 63) ? 63 : jt + 2;
  const ATT_GAS bf16* kl = kp + (size_t)c * 128 + 8 * g;
  const ATT_GAS bf16* vl = vp + (size_t)(lane >> 3) * 128 + (lane & 7) * 8;
  ATT_LAS char* vw = wl + (lane >> 3) * V16ST + (lane & 7) * 16;
  const ATT_LAS char* vb0 = wl + (4 * g + ((lane >> 2) & 3)) * V16ST + (lane & 3) * 8;
  bf16x8 kf[4][2], vs[8];
#define SW_KLOAD(t) do { _Pragma("unroll") for (int kb_ = 0; kb_ < 4; ++kb_) _Pragma("unroll") for (int ks_ = 0; ks_ < 2; ++ks_) \
    kf[kb_][ks_] = *(const ATT_GAS bf16x8*)(kl + (size_t)(64 * (t) + 16 * kb_) * 128 + 32 * ks_); } while (0)
#define SW_VLOAD(t) do { _Pragma("unroll") for (int i_ = 0; i_ < 8; ++i_) vs[i_] = *(const ATT_GAS bf16x8*)(vl + (size_t)(64 * (t) + 8 * i_) * 128); } while (0)
  SW_KLOAD(tlo); SW_VLOAD(tlo);
  for (int t = tlo; t <= thi; ++t) {
    f32x4 S[4][2];
#pragma unroll
    for (int kb = 0; kb < 4; ++kb)
#pragma unroll
      for (int qb = 0; qb < 2; ++qb) { S[kb][qb] = __builtin_amdgcn_mfma_f32_16x16x32_bf16(kf[kb][0], qf[qb][0], negm[qb], 0, 0, 0);
        S[kb][qb] = __builtin_amdgcn_mfma_f32_16x16x32_bf16(kf[kb][1], qf[qb][1], S[kb][qb], 0, 0, 0); }
    if (t < thi) SW_KLOAD(t + 1);
    if (t == jt - 2 || t == jt + 2) {
      const int d0 = 64 * t + 4 * g - q0 - c;
#pragma unroll
      for (int kb = 0; kb < 4; ++kb)
#pragma unroll
        for (int qb = 0; qb < 2; ++qb)
#pragma unroll
          for (int r = 0; r < 4; ++r) { const int d = d0 + 16 * kb + r - 16 * qb; S[kb][qb][r] = (d >= -128 && d <= 128) ? S[kb][qb][r] : -1e30f; } }
    float pm[2];
#pragma unroll
    for (int qb = 0; qb < 2; ++qb) { float a = fmaxf(fmaxf(S[0][qb][0], S[0][qb][1]), S[0][qb][2]);
#pragma unroll
      for (int kb = 0; kb < 4; ++kb) { if (kb) a = fmaxf(fmaxf(a, S[kb][qb][0]), S[kb][qb][1]); a = fmaxf(fmaxf(a, S[kb][qb][kb ? 2 : 3]), S[kb][qb][3]); }
      pm[qb] = a; }
    if (__builtin_expect(__any(fmaxf(pm[0], pm[1]) > THR), 0)) {
#pragma unroll
      for (int qb = 0; qb < 2; ++qb) { float pmx = fmaxf(pm[qb], __shfl_xor(pm[qb], 16)); pmx = fmaxf(pmx, __shfl_xor(pmx, 32));
        const float dl = fmaxf(pmx, 0.f); m[qb] += dl; negm[qb] -= dl;
#pragma unroll
        for (int kb = 0; kb < 4; ++kb) S[kb][qb] -= dl;
        if (g == 0) al[16 * qb + c] = __builtin_amdgcn_exp2f(-dl); }
      asm volatile("s_waitcnt lgkmcnt(0)" ::: "memory");
#pragma unroll
      for (int qb = 0; qb < 2; ++qb)
#pragma unroll
        for (int r = 0; r < 4; ++r) { const float a = al[16 * qb + 4 * g + r]; lacc[qb][r] *= a;
#pragma unroll
          for (int db = 0; db < 4; ++db) o[qb][db][r] *= a; } }
    bf16x8 pa[2][2];
#pragma unroll
    for (int qb = 0; qb < 2; ++qb) {
#pragma unroll
      for (int kb = 0; kb < 4; ++kb)
#pragma unroll
        for (int r = 0; r < 4; ++r) S[kb][qb][r] = __builtin_amdgcn_exp2f(S[kb][qb][r]);
#pragma unroll
      for (int s2 = 0; s2 < 2; ++s2) { const u32x4 w = {cvtpk(S[2 * s2][qb][0], S[2 * s2][qb][1]), cvtpk(S[2 * s2][qb][2], S[2 * s2][qb][3]),
                                                       cvtpk(S[2 * s2 + 1][qb][0], S[2 * s2 + 1][qb][1]), cvtpk(S[2 * s2 + 1][qb][2], S[2 * s2 + 1][qb][3])};
        pa[qb][s2] = __builtin_bit_cast(bf16x8, w); } }
#pragma unroll
    for (int i = 0; i < 8; ++i) *(ATT_LAS bf16x8*)(vw + 8 * i * V16ST) = vs[i];
    if (t < thi) SW_VLOAD(t + 1);
#pragma unroll
    for (int s2 = 0; s2 < 2; ++s2) { bf16x8 vf[4];
#pragma unroll
      for (int db = 0; db < 4; ++db) { const s16x4 lo = vtr(vb0 + s2 * 32 * V16ST + db * 32), hi = vtr(vb0 + (s2 * 32 + 16) * V16ST + db * 32);
        vf[db] = (bf16x8){lo[0], lo[1], lo[2], lo[3], hi[0], hi[1], hi[2], hi[3]}; }
#pragma unroll
      for (int db = 0; db < 4; ++db)
#pragma unroll
        for (int qb = 0; qb < 2; ++qb) o[qb][db] = __builtin_amdgcn_mfma_f32_16x16x32_bf16(pa[qb][s2], vf[db], o[qb][db], 0, 0, 0);
#pragma unroll
      for (int qb = 0; qb < 2; ++qb) lacc[qb] = __builtin_amdgcn_mfma_f32_16x16x32_bf16(pa[qb][s2], ones8, lacc[qb], 0, 0, 0); }
  }
#undef SW_KLOAD
#undef SW_VLOAD
#pragma unroll
  for (int qb = 0; qb < 2; ++qb)
#pragma unroll
    for (int r = 0; r < 4; ++r) { const int orow = 16 * qb + 4 * g + r; const float rl = __builtin_amdgcn_rcpf(lacc[qb][r]);
#pragma unroll
      for (int db = 0; db < 4; ++db) { const float val = o[qb][db][r] * rl; *(ATT_LAS bf16*)(wl + orow * 144 + (db * 16 + c) * 2) = (bf16)(cvtpk(val, val) & 0xffffu); } }
  asm volatile("s_waitcnt lgkmcnt(0)" ::: "memory");
#pragma unroll
  for (int i = 0; i < 4; ++i) { const int row = i * 8 + (lane >> 3), ch = lane & 7; const u32x4 v = *(const ATT_LAS u32x4*)(wl + row * 144 + ch * 16); *(ATT_GAS u32x4*)(op + (size_t)(q0 + row) * 1024 + ch * 8) = v; }
  asm volatile("s_waitcnt lgkmcnt(0)" ::: "memory");
}
constexpr int SW_NB = 5, SWK_B = 8192, SWV_B = 10240, SW_OFFV = SW_NB * SWK_B, SW_OFFAL = SW_OFFV + SW_NB * SWV_B, SW_OFFO = 0;
static_assert(SW_OFFAL + NW * 256 <= 131072 && NW * 9216 <= SW_OFFAL, "SWA LDS map");
__device__ __forceinline__ void swa_unit(const ATT_GAS bf16* qp, const ATT_GAS bf16* kp, const ATT_GAS bf16* vp, ATT_GAS bf16* op, const int u0, const float sinkl2, ATT_LAS char* lds) {
  typedef float f32x4 __attribute__((ext_vector_type(4)));
  int tid_ = threadIdx.x; asm volatile("" : "+v"(tid_));
  const int tid = tid_, wid = __builtin_amdgcn_readfirstlane(tid >> 6), lane = tid & 63, c = lane & 15, g = lane >> 4;
  ATT_LAS char* K_lds = lds; ATT_LAS char* V_lds = lds + SW_OFFV;
  ATT_LAS float* al = (ATT_LAS float*)(lds + SW_OFFAL) + wid * 64;
  const int q0 = 64 * (u0 + wid);
  bf16x8 qf[4][2];
#pragma unroll
  for (int qb = 0; qb < 4; ++qb)
#pragma unroll
    for (int ks = 0; ks < 2; ++ks) qf[qb][ks] = *(const ATT_GAS bf16x8*)(qp + (size_t)(q0 + 16 * qb + c) * 256 + 32 * ks + 8 * g);
  f32x4 o[4][4], lacc[4], negm[4];
#pragma unroll
  for (int qb = 0; qb < 4; ++qb) { negm[qb] = (f32x4){-sinkl2, -sinkl2, -sinkl2, -sinkl2}; lacc[qb] = (f32x4){1.f, 1.f, 1.f, 1.f};
#pragma unroll
    for (int db = 0; db < 4; ++db) o[qb][db] = (f32x4){0.f, 0.f, 0.f, 0.f}; }
  bf16x8 ones8; { const u32x4 w1 = {0x3F803F80u, 0x3F803F80u, 0x3F803F80u, 0x3F803F80u}; ones8 = __builtin_bit_cast(bf16x8, w1); asm volatile("" : "+v"(ones8)); }
  const int gch = (lane & 3) ^ ((4 - g) & 3);
  const unsigned koff = (unsigned)((16 * (wid & 3) + (lane >> 2)) * 128 + 32 * (wid >> 2) + 8 * gch) * 2u;
  const int vsA = 64 * wid + lane, vsB = 64 * (8 + (wid & 1)) + lane;
  const unsigned voffA = (unsigned)((vsA / 10) * 128 + 8 * ((vsA % 10) > 7 ? 7 : (vsA % 10))) * 2u, voffB = (unsigned)((vsB / 10) * 128 + 8 * ((vsB % 10) > 7 ? 7 : (vsB % 10))) * 2u;
#define SW_DMA(src, dst) do { const ATT_GAS char* s_ = (const ATT_GAS char*)(src); const unsigned d_ = (unsigned)__builtin_amdgcn_readfirstlane((int)(unsigned)(size_t)(dst)); \
    asm volatile("s_mov_b32 m0, %1\n\ts_nop 0\n\tglobal_load_lds_dwordx4 %0, off" :: "v"(s_), "s"(d_) : "memory", "m0"); } while (0)
#define SW_STAGE(T, b) do { SW_DMA((const ATT_GAS char*)(kp + (size_t)(64 * (T)) * 128) + koff, K_lds + (b) * SWK_B + wid * 1024); \
    SW_DMA((const ATT_GAS char*)(vp + (size_t)(64 * (T)) * 128) + voffA, V_lds + (b) * SWV_B + wid * 1024); \
    if (wid < 2) SW_DMA((const ATT_GAS char*)(vp + (size_t)(64 * (T)) * 128) + voffB, V_lds + (b) * SWV_B + (8 + wid) * 1024); } while (0)
  const ATT_LAS char* kb0 = K_lds + c * 64 + ((g ^ fkey(c)) * 16);
  const ATT_LAS char* vb0 = V_lds + (4 * g + ((lane >> 2) & 3)) * V16ST + (lane & 3) * 8;
  const int Tlo = (u0 - 2 < 0) ? 0 : u0 - 2, Thi = (u0 + 9 > 63) ? 63 : u0 + 9;
  SW_STAGE(Tlo, 0); if (Tlo + 1 <= Thi) SW_STAGE(Tlo + 1, 1);
  asm volatile("s_waitcnt vmcnt(0)" ::: "memory");
  if (Tlo + 2 <= Thi) SW_STAGE(Tlo + 2, 2); if (Tlo + 3 <= Thi) SW_STAGE(Tlo + 3, 3);
  __syncthreads();
  int b0 = 0, b4 = 4;
  for (int T = Tlo; T <= Thi; ++T) {
    if (T + 4 <= Thi) SW_STAGE(T + 4, b4);
    const int dT = T - (u0 + wid);
    if (dT >= -2 && dT <= 2) {
      const ATT_LAS char* Kc = kb0 + b0 * SWK_B; const ATT_LAS char* Vc = vb0 + b0 * SWV_B;
      f32x4 S[4][4];
      { bf16x8 kf[4][2];
#pragma unroll
        for (int ks = 0; ks < 2; ++ks)
#pragma unroll
          for (int kb = 0; kb < 4; ++kb) kf[kb][ks] = *(const ATT_LAS bf16x8*)(Kc + ks * 4096 + kb * 1024);
#pragma unroll
        for (int ks = 0; ks < 2; ++ks)
#pragma unroll
          for (int kb = 0; kb < 4; ++kb)
#pragma unroll
            for (int qb = 0; qb < 4; ++qb) S[kb][qb] = __builtin_amdgcn_mfma_f32_16x16x32_bf16(kf[kb][ks], qf[qb][ks], ks == 0 ? negm[qb] : S[kb][qb], 0, 0, 0); }
      if (dT == -2 || dT == 2) {
        const int d0 = 64 * T + 4 * g - q0 - c;
#pragma unroll
        for (int kb = 0; kb < 4; ++kb)
#pragma unroll
          for (int qb = 0; qb < 4; ++qb)
#pragma unroll
            for (int r = 0; r < 4; ++r) { const int d = d0 + 16 * kb + r - 16 * qb; S[kb][qb][r] = (d >= -128 && d <= 128) ? S[kb][qb][r] : -1e30f; } }
      float pm[4];
#pragma unroll
      for (int qb = 0; qb < 4; ++qb) { float a = fmaxf(fmaxf(S[0][qb][0], S[0][qb][1]), S[0][qb][2]);
#pragma unroll
        for (int kb = 0; kb < 4; ++kb) { if (kb) a = fmaxf(fmaxf(a, S[kb][qb][0]), S[kb][qb][1]); a = fmaxf(fmaxf(a, S[kb][qb][kb ? 2 : 3]), S[kb][qb][3]); }
        pm[qb] = a; }
      if (__builtin_expect(__any(fmaxf(fmaxf(pm[0], pm[1]), fmaxf(pm[2], pm[3])) > THR), 0)) {
#pragma unroll
        for (int qb = 0; qb < 4; ++qb) { float pmx = fmaxf(pm[qb], __shfl_xor(pm[qb], 16)); pmx = fmaxf(pmx, __shfl_xor(pmx, 32));
          const float dl = fmaxf(pmx, 0.f); negm[qb] -= dl;
#pragma unroll
          for (int kb = 0; kb < 4; ++kb) S[kb][qb] -= dl;
          if (g == 0) al[16 * qb + c] = __builtin_amdgcn_exp2f(-dl); }
        asm volatile("s_waitcnt lgkmcnt(0)" ::: "memory");
#pragma unroll
        for (int qb = 0; qb < 4; ++qb)
#pragma unroll
          for (int r = 0; r < 4; ++r) { const float a = al[16 * qb + 4 * g + r]; lacc[qb][r] *= a;
#pragma unroll
            for (int db = 0; db < 4; ++db) o[qb][db][r] *= a; } }
      bf16x8 pa[4][2];
#pragma unroll
      for (int qb = 0; qb < 4; ++qb) {
#pragma unroll
        for (int kb = 0; kb < 4; ++kb)
#pragma unroll
          for (int r = 0; r < 4; ++r) S[kb][qb][r] = __builtin_amdgcn_exp2f(S[kb][qb][r]);
#pragma unroll
        for (int s2 = 0; s2 < 2; ++s2) { const u32x4 w = {cvtpk(S[2 * s2][qb][0], S[2 * s2][qb][1]), cvtpk(S[2 * s2][qb][2], S[2 * s2][qb][3]),
                                                         cvtpk(S[2 * s2 + 1][qb][0], S[2 * s2 + 1][qb][1]), cvtpk(S[2 * s2 + 1][qb][2], S[2 * s2 + 1][qb][3])};
          pa[qb][s2] = __builtin_bit_cast(bf16x8, w); }
        SBAR(); }
#pragma unroll
      for (int s2 = 0; s2 < 2; ++s2) { bf16x8 vf[4];
#pragma unroll
        for (int db = 0; db < 4; ++db) { const s16x4 lo = vtr(Vc + s2 * 32 * V16ST + db * 32), hi = vtr(Vc + (s2 * 32 + 16) * V16ST + db * 32);
          vf[db] = (bf16x8){lo[0], lo[1], lo[2], lo[3], hi[0], hi[1], hi[2], hi[3]}; }
#pragma unroll
        for (int db = 0; db < 4; ++db)
#pragma unroll
          for (int qb = 0; qb < 4; ++qb) o[qb][db] = __builtin_amdgcn_mfma_f32_16x16x32_bf16(pa[qb][s2], vf[db], o[qb][db], 0, 0, 0);
#pragma unroll
        for (int qb = 0; qb < 4; ++qb) lacc[qb] = __builtin_amdgcn_mfma_f32_16x16x32_bf16(pa[qb][s2], ones8, lacc[qb], 0, 0, 0); }
    }
    if (T + 4 <= Thi) { if (wid < 2) asm volatile("s_waitcnt vmcnt(9) lgkmcnt(0)" ::: "memory"); else asm volatile("s_waitcnt vmcnt(6) lgkmcnt(0)" ::: "memory"); }
    else asm volatile("s_waitcnt vmcnt(0) lgkmcnt(0)" ::: "memory");
    __builtin_amdgcn_s_barrier(); asm volatile("" ::: "memory");
    { const int t_ = b0; b0 = (b0 == SW_NB - 1) ? 0 : b0 + 1; b4 = t_; }
  }
#undef SW_DMA
#undef SW_STAGE
  { ATT_LAS char* stg = lds + SW_OFFO + wid * 9216;
#pragma unroll
    for (int qb = 0; qb < 4; ++qb)
#pragma unroll
      for (int r = 0; r < 4; ++r) { const int orow = 16 * qb + 4 * g + r; const float rl = __builtin_amdgcn_rcpf(lacc[qb][r]);
#pragma unroll
        for (int db = 0; db < 4; ++db) { const float val = o[qb][db][r] * rl; *(ATT_LAS bf16*)(stg + orow * 144 + (db * 16 + c) * 2) = (bf16)(cvtpk(val, val) & 0xffffu); } }
    asm volatile("s_waitcnt lgkmcnt(0)" ::: "memory");
#pragma unroll
    for (int i = 0; i < 8; ++i) { const int row = i * 8 + (lane >> 3), ch = lane & 7; const u32x4 v = *(const ATT_LAS u32x4*)(stg + row * 144 + ch * 16); *(ATT_GAS u32x4*)(op + (size_t)(q0 + row) * 1024 + ch * 8) = v; } }
  __syncthreads();
}
template <int NH>
__device__ __forceinline__ bool mla_block_fixed(AttnIO io, float km2, ATT_LAS char* lds, int& role) {
  float mrow; bool okw = mla_fixed_ref(io, km2, mrow);
  if constexpr (NH == 2) { io.q += (size_t)256 * io.ldq; okw = mla_fixed_ref(io, km2, mrow) && okw; }
  int tid_ = threadIdx.x; asm volatile("" : "+v"(tid_));
  const int wid = __builtin_amdgcn_readfirstlane(tid_ >> 6);
  const int simd = (int)__builtin_amdgcn_s_getreg((1 << 11) | (4 << 6) | 4);
  ATT_LAS int* fl = (ATT_LAS int*)(lds + OFF_FLAG);
  if ((tid_ & 63) == 0) fl[wid] = (okw ? 1 : 0) | (simd << 1);
  __syncthreads();
  int all = 1, rank = 0;
#pragma unroll
  for (int w = 0; w < 8; ++w) { const int f = __builtin_amdgcn_readfirstlane(fl[w]); all &= f; rank += (w < wid && (f >> 1) == simd) ? 1 : 0; }
  role = rank & 1;
  return (all & 1) != 0;
}
#undef SBAR
}
#ifndef PHMASK
#define PHMASK 0xffffffffu
#endif
#define PH(k) if (PHMASK & (1u << (k)))
#ifndef DUPMASK
#define DUPMASK 0u
#endif
#define DUP(k) for (int rep_ = 0; rep_ < (int)((DUPMASK >> (k)) & 1u) + 1; ++rep_)
constexpr int NWAVES = 8;
constexpr int DM = 1024, BATCH = 8, SEQ = 4096, TOK = BATCH * SEQ, DEPTH = 2;
constexpr int IN_W = 1952, IN_WP = 2048, NEXP = 16, EFF = 512, CAP = 512, PLE = 256;
constexpr int NSLOT = BATCH * NEXP * CAP;
constexpr float NORM_EPS = 1e-6f, LOG2E = 1.4426950408889634f;
constexpr float C2_NA = 0.125f * LOG2E, C2_SW = 0.125f * LOG2E, C2_MLA = 0.10206207261596575f * LOG2E;

constexpr size_t MiB = 1u << 20;
constexpr size_t WS_CTL = 0, CTL_ZERO_BYTES = 64 * 1024;
constexpr size_t WS_MISC = 1 * MiB;
constexpr size_t MO_COS16 = 0, MO_SIN16 = 256 * 1024, MO_COS32 = 512 * 1024, MO_SIN32 = 1024 * 1024;
constexpr size_t MO_PSSQ = 1536 * 1024;
constexpr size_t MO_GSSQ = MO_PSSQ + 2 * MiB;
constexpr size_t MO_RSF = MO_GSSQ + 2560 * 1024;
constexpr size_t MO_RSP = MO_RSF + 128 * 1024;
constexpr size_t MO_AFF = MO_RSP + 128 * 1024;
constexpr size_t MO_SIDX = MO_AFF + 2 * MiB;
constexpr size_t MO_SG = MO_SIDX + 256 * 1024;
constexpr size_t MO_SRS = MO_SG + 256 * 1024;
constexpr size_t MO_INV = MO_SRS + 256 * 1024;
constexpr size_t MO_RSA = MO_INV + 2 * MiB, MO_RSCQ = MO_RSA + 128 * 1024, MO_RSCKV = MO_RSCQ + 128 * 1024;
constexpr size_t MO_WR = MO_RSCKV + 128 * 1024;
static_assert(MO_WR + 128 * 1024 <= 16 * MiB, "misc map");
constexpr size_t WS_WPG = 17 * MiB;
constexpr size_t WS_W = 21 * MiB;
constexpr size_t WO_IN = 0, WO_QUP = 4 * MiB, WO_KVUP = 5 * MiB, WO_OUT = 6 * MiB, WO_PP = 8 * MiB, WO_GU = 9 * MiB, WO_DOWN = 41 * MiB;
constexpr size_t WS_HB = 79 * MiB, WS_PB = 143 * MiB, WS_OCAT = 159 * MiB, WS_PPO = WS_OCAT, WS_BIG = 223 * MiB, WS_END = 457 * MiB;
constexpr size_t BO_NAQKV = 0, BO_CQ = 48 * MiB, BO_CKV = 72 * MiB, BO_KR = 88 * MiB, BO_SWQ = 90 * MiB, BO_SWK = 106 * MiB, BO_SWV = 114 * MiB,
                 BO_QM = 122 * MiB, BO_KN = 170 * MiB, BO_VM = 202 * MiB, BO_ACT = 0, BO_Y = 64 * MiB;
constexpr size_t SLAB_B = 234 * MiB / 8;
#define BOX(BO, SZ_MIB) (F.xl ? (size_t)F.xb * (SLAB_B - (size_t)(SZ_MIB) * MiB / 8) + (size_t)(BO) / 8 : (size_t)(BO))
constexpr int CW_BAR = 4096;
static_assert((CW_BAR + 3456) * 4 <= 32768, "barrier words");
constexpr int CW_XL = 12544;
constexpr int CW_KMAX = 8192, CW_KRMAX = CW_KMAX + 128;

constexpr int RING_OFF = 0, RING_BYTES = 131072;
constexpr int LDSCTL_OFF = RING_BYTES, MISC_OFF = LDSCTL_OFF + 320, GTAB_OFF = RING_BYTES + 1024;
constexpr int LDS_BYTES = 147456;
static_assert(GTAB_OFF + 8192 <= LDS_BYTES && MISC_OFF + 128 <= GTAB_OFF, "LDS map");

#define GAS __attribute__((address_space(1)))
#define LAS __attribute__((address_space(3)))
typedef unsigned short bf16;
typedef unsigned v4u __attribute__((ext_vector_type(4)));
typedef unsigned v2u __attribute__((ext_vector_type(2)));
typedef int v4i __attribute__((ext_vector_type(4)));
typedef float f32x4 __attribute__((ext_vector_type(4)));
typedef float f32x2 __attribute__((ext_vector_type(2)));
typedef __bf16 bf16x2_t __attribute__((ext_vector_type(2)));
#define LDS_WAIT() asm volatile("s_waitcnt lgkmcnt(0)" ::: "memory")
#define VM_WAIT() asm volatile("s_waitcnt vmcnt(0)" ::: "memory")
__device__ __forceinline__ unsigned pk2(float lo, float hi) { f32x2 v = {lo, hi}; bf16x2_t b = __builtin_convertvector(v, bf16x2_t); return __builtin_bit_cast(unsigned, b); }
__device__ __forceinline__ v2u pk4(f32x4 v) { v2u r; r.x = pk2(v[0], v[1]); r.y = pk2(v[2], v[3]); return r; }
__device__ __forceinline__ float bf2f(unsigned short b) { return __uint_as_float((unsigned)b << 16); }
__device__ __forceinline__ float wave_sum(float v) {
#pragma unroll
    for (int o = 1; o < 64; o <<= 1) v += __shfl_xor(v, o);
    return v;
}

#define XB_TMO      128
#define XB_XCNT(j)  (256  + 64 * (j))
#define XB_XSUB(j)  (1280 + 64 * (j))
#define XB_XGEN(j)  (2304 + 64 * (j))
#define XB_TOP      3328
#define XB_TOPGEN   3392
#define XCD_BAR_WORDS 3456
#define XB_SPIN_CAP (1u << 22)
__device__ __forceinline__ unsigned xb_ld(unsigned* p)              { return __hip_atomic_load(p, __ATOMIC_RELAXED, __HIP_MEMORY_SCOPE_AGENT); }
__device__ __forceinline__ unsigned xb_add(unsigned* p, unsigned v) { return __hip_atomic_fetch_add(p, v, __ATOMIC_RELAXED, __HIP_MEMORY_SCOPE_AGENT); }
__device__ __forceinline__ unsigned xb_xcc_id() { return (unsigned)__builtin_amdgcn_s_getreg((3 << 11) | 20) & 0xFu; }
#define XB_SPIN(cond, bar) do { unsigned _sp = 0; while (cond) { __builtin_amdgcn_s_sleep(1); \
    if ((++_sp & 255u) == 0u) { if (xb_ld(&(bar)[XB_TMO])) break; if (_sp > XB_SPIN_CAP) { atomicAdd(&(bar)[XB_TMO], 1u); break; } } } } while (0)
struct XcdBarrier { unsigned* bar; unsigned x; volatile LAS unsigned* st; };
__device__ __forceinline__ XcdBarrier xcd_barrier_post(unsigned* bar, volatile LAS unsigned* st) {
    XcdBarrier b; b.bar = bar; b.x = xb_xcc_id(); b.st = st;
    if (threadIdx.x == 0) st[2] = xb_add(&bar[XB_XCNT(b.x)], 1u);
    return b;
}
__device__ __forceinline__ void xcd_barrier_complete(unsigned* bar, unsigned x, unsigned& nloc, unsigned& nx) {
    const unsigned G = gridDim.x * gridDim.y * gridDim.z;
    unsigned sum, cnt, mine, sp = 0u;
    for (;;) {
        sum = 0u; cnt = 0u; mine = 0u;
#pragma unroll
        for (unsigned j = 0; j < 16; ++j) { const unsigned c = xb_ld(&bar[XB_XCNT(j)]); sum += c; cnt += (c > 0u) ? 1u : 0u; mine = (j == x) ? c : mine; }
        if (sum == G) break;
        __builtin_amdgcn_s_sleep(1);
        if ((++sp & 255u) == 0u) { if (xb_ld(&bar[XB_TMO])) break; if (sp > XB_SPIN_CAP) { atomicAdd(&bar[XB_TMO], 1u); break; } }
    }
    nloc = mine > 0u ? mine : 1u; nx = cnt > 0u ? cnt : 1u;
}
__device__ __forceinline__ void xcd_local_barrier(unsigned* cnt, unsigned n, unsigned* bar) {
    asm volatile("s_waitcnt vmcnt(0)" ::: "memory");
    __syncthreads();
    if (threadIdx.x == 0) {
        const unsigned old = xb_add(cnt, 1u); const unsigned target = (old / n + 1u) * n;
        XB_SPIN(xb_ld(cnt) < target, bar);
        asm volatile("buffer_inv sc0\n\ts_waitcnt vmcnt(0)" ::: "memory");
    }
    __syncthreads();
}
__device__ __forceinline__ void xcd_barrier(const XcdBarrier& b) {
    asm volatile("s_waitcnt vmcnt(0)" ::: "memory");
    __syncthreads();
    if (threadIdx.x == 0) {
        unsigned* bar = b.bar;
        __builtin_amdgcn_s_waitcnt(0);
        unsigned nloc = b.st[0], nx = b.st[1];
        if (nloc == 0u) { xcd_barrier_complete(bar, b.x, nloc, nx); b.st[0] = nloc; b.st[1] = nx; }
        const unsigned old = xb_add(&bar[XB_XSUB(b.x)], 1u);
        const unsigned gen = old / nloc;
        if (old + 1u == (gen + 1u) * nloc) {
            __builtin_amdgcn_fence(__ATOMIC_RELEASE, "agent");
            asm volatile("s_waitcnt vmcnt(0)" ::: "memory");
            const unsigned og = xb_add(&bar[XB_TOP], 1u);
            const unsigned tg = og / nx;
            if (og + 1u == (tg + 1u) * nx) xb_add(&bar[XB_TOPGEN], 1u);
            else XB_SPIN(xb_ld(&bar[XB_TOPGEN]) == tg, bar);
            __builtin_amdgcn_fence(__ATOMIC_ACQUIRE, "agent");
            xb_add(&bar[XB_XGEN(b.x)], 1u);
            asm volatile("s_waitcnt vmcnt(0)" ::: "memory");
        } else {
            XB_SPIN(xb_ld(&bar[XB_XGEN(b.x)]) == gen, bar);
            asm volatile("buffer_inv sc0\n\ts_waitcnt vmcnt(0)" ::: "memory");
        }
    }
    __syncthreads();
}

struct Args { const float* in[20]; float* out; unsigned char* ws; double inv16[16]; double inv32[32]; };
enum { I_X = 0, I_P, I_ATTN_NORM, I_W_IN, I_NA_RPB, I_MLA_Q_NORM, I_MLA_W_Q_UP, I_MLA_KV_NORM, I_MLA_W_KV_UP, I_SWA_SINK, I_W_OUT, I_FFN_NORM, I_W_ROUTER,
       I_W_GATE, I_W_UP, I_W_DOWN, I_PLE_NORM, I_W_PLE_GATE, I_W_PLE_PROJ, I_FINAL_NORM };

struct Frame {
    LAS unsigned char* lds;
    volatile LAS unsigned* MISC;
    int vcu, G;
    unsigned char* ws;
    float* out;
    bf16* hb;
    int xl, xb;
};
#define LAUNDER_LANES() int tid_ = threadIdx.x; asm volatile("" : "+v"(tid_)); const int tid = tid_, lane = tid & 63, wave = __builtin_amdgcn_readfirstlane(tid >> 6); (void)tid; (void)lane; (void)wave
#define WSP(T, off) ((T*)(F.ws + (off)))
#define MISCP(T, off) ((T*)(F.ws + WS_MISC + (off)))

template <class Src>
__device__ __forceinline__ void transpose_item(const Src& src, int K, bf16* WT, LAS float* scr, int item, int nblk, int lane) {
    const int kb = item / nblk, nb = item % nblk, k0 = 64 * kb, n0 = 32 * nb;
#pragma unroll 8
    for (int i = 0; i < 32; ++i) { const int kk = 2 * i + (lane >> 5); scr[kk * 33 + (lane & 31)] = src(k0 + kk, n0 + (lane & 31)); }
    LDS_WAIT(); asm volatile("" ::: "memory");
    const int c = lane & 7;
#pragma unroll
    for (int j = 0; j < 4; ++j) { const int n = (lane >> 3) + 8 * j; const LAS float* s = scr + (8 * c) * 33 + n;
        v4u o; o.x = pk2(s[0 * 33], s[1 * 33]); o.y = pk2(s[2 * 33], s[3 * 33]); o.z = pk2(s[4 * 33], s[5 * 33]); o.w = pk2(s[6 * 33], s[7 * 33]);
        *(GAS v4u*)(WT + (size_t)(n0 + n) * K + k0 + 8 * c) = o; }
    LDS_WAIT(); asm volatile("" ::: "memory");
}
__device__ __forceinline__ int pair16(int p) { return 16 * ((p >> 2) & 1) + 4 * (p >> 3) + (p & 3); }
struct SrcPlain { const float* W; int N; const float* g;
    __device__ __forceinline__ float operator()(int k, int n) const { const float w = __builtin_nontemporal_load((const GAS float*)(W + (size_t)k * N + n)); return g ? w * g[k] : w; } };
struct SrcIn { const float* W; const float* g;
    __device__ __forceinline__ float operator()(int k, int n) const {
        if (n >= IN_W) return 0.f;
        int c = n;
        if (n >= 1408 && n < 1440) c = 1408 + pair16(n - 1408);
        else if (n >= 1440 && n < 1824) { const int base = (n < 1696) ? 1440 : 1696; const int p = (n - base) & 63, hb = (n - base) & ~63, sub = p >> 5, q = p & 31;
            c = base + hb + 16 * sub + 32 * ((q >> 2) & 1) + 4 * (q >> 3) + (q & 3); }
        return __builtin_nontemporal_load((const GAS float*)(W + (size_t)k * IN_W + c)) * g[k]; } };
struct SrcQup { const float* W; const float* g;
    __device__ __forceinline__ float operator()(int k, int n) const { const int h = n / 96, r = n % 96; const int c = (r < 64) ? n : h * 96 + 64 + pair16(r - 64); return W[(size_t)k * 768 + c] * g[k]; } };
struct SrcGU { const float* Wg; const float* Wu; const float* g;
    __device__ __forceinline__ float operator()(int k, int n) const { const int grp = n >> 5, p = n & 31; const ptrdiff_t d = ((p >> 2) & 1) ? (Wu - Wg) : (ptrdiff_t)0; return __builtin_nontemporal_load((const GAS float*)(Wg + d + (ptrdiff_t)k * EFF + 16 * grp + 4 * (p >> 3) + (p & 3))) * g[k]; } };

__device__ __forceinline__ void convert_layer_weights(Frame& F, const Args& a, int l, bool with_pg_both, bf16* Wl) {
    LAUNDER_LANES();
    LAS float* scr = (LAS float*)(F.lds + RING_OFF + wave * 16384);
    const int gw = F.vcu * NWAVES + wave, NGW = F.G * NWAVES;
    constexpr int I_IN = 16 * 64, I_QUP = 6 * 24, I_KVUP = 4 * 32, I_OUT = 16 * 32, I_PPI = 4 * 32, I_GU1 = 16 * 32, I_DN1 = 8 * 32, I_PG = 16 * 32;
    constexpr int NITEMS = I_IN + I_QUP + I_KVUP + I_OUT + I_PPI + NEXP * I_GU1 + NEXP * I_DN1;
    const int total = NITEMS + (with_pg_both ? 2 * I_PG : 0);
    for (int it = gw; it < total; it += NGW) {
        int r = it;
        if (r < I_IN) { SrcIn s{a.in[I_W_IN] + (size_t)l * DM * IN_W, a.in[I_ATTN_NORM] + l * DM}; transpose_item(s, DM, (bf16*)((char*)Wl + WO_IN), scr, r, 64, lane); continue; } r -= I_IN;
        if (r < I_QUP) { SrcQup s{a.in[I_MLA_W_Q_UP] + (size_t)l * 384 * 768, a.in[I_MLA_Q_NORM] + l * 384}; transpose_item(s, 384, (bf16*)((char*)Wl + WO_QUP), scr, r, 24, lane); continue; } r -= I_QUP;
        if (r < I_KVUP) { SrcPlain s{a.in[I_MLA_W_KV_UP] + (size_t)l * 256 * 1024, 1024, a.in[I_MLA_KV_NORM] + l * 256}; transpose_item(s, 256, (bf16*)((char*)Wl + WO_KVUP), scr, r, 32, lane); continue; } r -= I_KVUP;
        if (r < I_OUT) { SrcPlain s{a.in[I_W_OUT] + (size_t)l * DM * DM, DM, nullptr}; transpose_item(s, DM, (bf16*)((char*)Wl + WO_OUT), scr, r, 32, lane); continue; } r -= I_OUT;
        if (r < I_PPI) { SrcPlain s{a.in[I_W_PLE_PROJ] + (size_t)l * PLE * DM, DM, nullptr}; transpose_item(s, PLE, (bf16*)((char*)Wl + WO_PP), scr, r, 32, lane); continue; } r -= I_PPI;
        if (r < NEXP * I_GU1) { const int e = r / I_GU1; const size_t eo = ((size_t)l * NEXP + e) * DM * EFF;
            SrcGU s{a.in[I_W_GATE] + eo, a.in[I_W_UP] + eo, a.in[I_FFN_NORM] + l * DM}; transpose_item(s, DM, (bf16*)((char*)Wl + WO_GU) + (size_t)e * DM * DM, scr, r % I_GU1, 32, lane); continue; } r -= NEXP * I_GU1;
        if (r < NEXP * I_DN1) { const int e = r / I_DN1; SrcPlain s{a.in[I_W_DOWN] + ((size_t)l * NEXP + e) * EFF * DM, DM, nullptr};
            transpose_item(s, EFF, (bf16*)((char*)Wl + WO_DOWN) + (size_t)e * DM * EFF, scr, r % I_DN1, 32, lane); continue; } r -= NEXP * I_DN1;
        { const int ll = r / I_PG; SrcPlain s{a.in[I_W_PLE_GATE] + (size_t)ll * DM * DM, DM, a.in[I_PLE_NORM] + ll * DM}; transpose_item(s, DM, WSP(bf16, WS_WPG) + (size_t)ll * DM * DM, scr, r % I_PG, 32, lane); }
    }
}
__device__ __forceinline__ void convert_p(Frame& F, const Args& a, int l, bf16* pb) {
    LAUNDER_LANES();
    const float* p = a.in[I_P] + (size_t)l * TOK * PLE;
    const size_t n8 = (size_t)TOK * PLE / 8, gt = (size_t)F.vcu * 512 + tid, NT = (size_t)F.G * 512;
    for (size_t i = gt; i < n8; i += NT) { const f32x4 x0 = __builtin_nontemporal_load((const GAS f32x4*)(p + i * 8)), x1 = __builtin_nontemporal_load((const GAS f32x4*)(p + i * 8 + 4));
        v4u o; o.x = pk2(x0[0], x0[1]); o.y = pk2(x0[2], x0[3]); o.z = pk2(x1[0], x1[1]); o.w = pk2(x1[2], x1[3]); *(GAS v4u*)(pb + i * 8) = o; }
}
__device__ __forceinline__ void rope_tables(Frame& F, const Args& a) {
    LAUNDER_LANES();
    float* c16 = MISCP(float, MO_COS16); float* s16 = MISCP(float, MO_SIN16); float* c32 = MISCP(float, MO_COS32); float* s32 = MISCP(float, MO_SIN32);
    const int gt = F.vcu * 512 + tid, NT = F.G * 512;
    for (int i = gt; i < SEQ * 48; i += NT) {
        const int pos = i / 48, f = i % 48; const double inv = (f < 16) ? a.inv16[f] : a.inv32[f - 16];
        const double ang = (double)pos * inv; const double k = __builtin_rint(ang * 0.15915494309189535); const double rr = ang - k * 6.283185307179586476925;
        const float r = (float)rr; const float cs = __cosf(r), sn = __sinf(r);
        if (f < 16) { c16[pos * 16 + f] = cs; s16[pos * 16 + f] = sn; } else { c32[pos * 32 + f - 16] = cs; s32[pos * 32 + f - 16] = sn; }
    }
}
__device__ __forceinline__ void router_weights(Frame& F, const Args& a) {
    LAUNDER_LANES();
    bf16* wr = MISCP(bf16, MO_WR);
    const int gt = F.vcu * 512 + tid, NT = F.G * 512;
    for (int i = gt; i < DEPTH * NEXP * DM; i += NT) { const int l = i / (NEXP * DM), e = (i / DM) % NEXP, k = i % DM;
        const float w = a.in[I_W_ROUTER][((size_t)l * DM + k) * NEXP + e] * a.in[I_FFN_NORM][l * DM + k];
        const unsigned hi = pk2(w, 0.f) & 0xffffu; const float wl = w - __uint_as_float(hi << 16); const unsigned lo = pk2(wl, 0.f) & 0xffffu;
        wr[((size_t)l * 32 + e) * DM + k] = (bf16)hi; wr[((size_t)l * 32 + 16 + e) * DM + k] = (bf16)lo; }
}
__device__ __forceinline__ void x_to_hb(Frame& F, const Args& a) {
    LAUNDER_LANES();
    const float* x = a.in[I_X]; bf16* hb = WSP(bf16, WS_HB);
    const int gw = F.vcu * NWAVES + wave, NGW = F.G * NWAVES;
    for (int m4 = gw; m4 < TOK / 4; m4 += NGW) {
        f32x4 v[4][4];
#pragma unroll
        for (int r = 0; r < 4; ++r) { const GAS f32x4* xr = (const GAS f32x4*)(x + (size_t)(m4 * 4 + r) * DM) + lane;
#pragma unroll
            for (int j = 0; j < 4; ++j) v[r][j] = __builtin_nontemporal_load(xr + 64 * j); }
#pragma unroll
        for (int r = 0; r < 4; ++r) { const int m = m4 * 4 + r; float s = 0.f;
#pragma unroll
            for (int j = 0; j < 4; ++j) s += (v[r][j][0] * v[r][j][0] + v[r][j][1] * v[r][j][1]) + (v[r][j][2] * v[r][j][2] + v[r][j][3] * v[r][j][3]);
            s = wave_sum(s);
            GAS v2u* o8 = (GAS v2u*)(hb + (size_t)m * DM) + lane;
#pragma unroll
            for (int j = 0; j < 4; ++j) o8[64 * j] = pk4(v[r][j]);
            if (lane < 16) MISCP(float, MO_PSSQ)[(size_t)m * 16 + lane] = (lane == 0) ? s : 0.f; }
    }
}
__device__ __forceinline__ void finalize_rstd(Frame& F, int mode) {
    LAUNDER_LANES();
    const int gt = F.vcu * 512 + tid, NT = F.G * 512;
    for (int m = gt; m < TOK; m += NT) {
        if (mode == 0) { const GAS f32x4* p = (const GAS f32x4*)(MISCP(float, MO_PSSQ) + (size_t)m * 16); const f32x4 a = p[0], b = p[1], c = p[2], d = p[3];
            const float s = ((a[0] + a[1]) + (a[2] + a[3])) + ((b[0] + b[1]) + (b[2] + b[3])) + ((c[0] + c[1]) + (c[2] + c[3])) + ((d[0] + d[1]) + (d[2] + d[3]));
            MISCP(float, MO_RSA)[m] = 1.0f / sqrtf(s * (1.f / DM) + NORM_EPS); }
        else { const GAS f32x4* p = (const GAS f32x4*)(MISCP(float, MO_GSSQ) + (size_t)m * 20); const f32x4 a = p[0], b = p[1], c = p[2], d = p[3], e = p[4];
            const float sq = ((a[0] + a[1]) + (a[2] + a[3])) + ((b[0] + b[1]) + (b[2] + b[3])) + ((c[0] + c[1]) + (c[2] + c[3])), sk = ((d[0] + d[1]) + (d[2] + d[3])) + ((e[0] + e[1]) + (e[2] + e[3]));
            MISCP(float, MO_RSCQ)[m] = 1.0f / sqrtf(sq * (1.f / 384.f) + NORM_EPS); MISCP(float, MO_RSCKV)[m] = 1.0f / sqrtf(sk * (1.f / 256.f) + NORM_EPS); }
    }
}
__device__ __forceinline__ void final_norm(Frame& F, const Args& a) {
    LAUNDER_LANES();
    const float* g = a.in[I_FINAL_NORM]; f32x4 gv[4];
#pragma unroll
    for (int j = 0; j < 4; ++j) gv[j] = *((const GAS f32x4*)g + lane + 64 * j);
    const GAS unsigned short* hb = (const GAS unsigned short*)F.hb;
    const int gw = F.vcu * NWAVES + wave, NGW = F.G * NWAVES;
    for (int m4 = gw; m4 < TOK / 4; m4 += NGW) {
        v2u w[4][4];
#pragma unroll
        for (int r = 0; r < 4; ++r) { const GAS v2u* xr = (const GAS v2u*)(hb + (size_t)(m4 * 4 + r) * DM) + lane;
#pragma unroll
            for (int j = 0; j < 4; ++j) w[r][j] = xr[64 * j]; }
#pragma unroll
        for (int r = 0; r < 4; ++r) { f32x4 v[4]; float s = 0.f;
#pragma unroll
            for (int j = 0; j < 4; ++j) { v[j][0] = __uint_as_float(w[r][j].x << 16); v[j][1] = __uint_as_float(w[r][j].x & 0xffff0000u); v[j][2] = __uint_as_float(w[r][j].y << 16); v[j][3] = __uint_as_float(w[r][j].y & 0xffff0000u);
                s += (v[j][0] * v[j][0] + v[j][1] * v[j][1]) + (v[j][2] * v[j][2] + v[j][3] * v[j][3]); }
            const float rs = 1.0f / sqrtf(wave_sum(s) * (1.f / DM) + NORM_EPS);
            GAS f32x4* o = (GAS f32x4*)(F.out + (size_t)(m4 * 4 + r) * DM) + lane;
#pragma unroll
            for (int j = 0; j < 4; ++j) __builtin_nontemporal_store(v[j] * rs * gv[j], o + 64 * j); }
    }
}
typedef pg8::Unit Unit;
typedef const f32x4 (&AccRef)[2][2][4][2];
#define EPI_ROW(u, ai, m) ((u).pm * 256 + (ai) * 128 + wr * 64 + (m) * 16 + fr)
#define EPI_GRP(u, bj) (((u).pn * 256 + (bj) * 128 + wc * 32) >> 5)
typedef GAS bf16 gbf16; typedef GAS float gf32; typedef const GAS float cgf32; typedef const GAS bf16 cgbf16;
__device__ __forceinline__ void st_bf4(gbf16* p, f32x4 v) { *(GAS v2u*)p = pk4(v); }
__device__ __forceinline__ void st_bf8(gbf16* p, f32x4 a, f32x4 b) { v4u w; w.x = pk2(a[0], a[1]); w.y = pk2(a[2], a[3]); w.z = pk2(b[0], b[1]); w.w = pk2(b[2], b[3]); *(GAS v4u*)p = w; }
__device__ __forceinline__ f32x4 ld_bf4(cgbf16* p) { const v2u w = *(const GAS v2u*)p; f32x4 r; r[0] = __uint_as_float(w.x << 16); r[1] = __uint_as_float(w.x & 0xffff0000u); r[2] = __uint_as_float(w.y << 16); r[3] = __uint_as_float(w.y & 0xffff0000u); return r; }
__device__ __forceinline__ f32x4 bflo(v4u w) { f32x4 r; r[0] = __uint_as_float(w.x << 16); r[1] = __uint_as_float(w.x & 0xffff0000u); r[2] = __uint_as_float(w.y << 16); r[3] = __uint_as_float(w.y & 0xffff0000u); return r; }
__device__ __forceinline__ f32x4 bfhi(v4u w) { f32x4 r; r[0] = __uint_as_float(w.z << 16); r[1] = __uint_as_float(w.z & 0xffff0000u); r[2] = __uint_as_float(w.w << 16); r[3] = __uint_as_float(w.w & 0xffff0000u); return r; }
#define EPI_LOAD_ROWS(arr, ptr, scale) float arr[2][4]; _Pragma("unroll") for (int ai = 0; ai < 2; ++ai) _Pragma("unroll") for (int m = 0; m < 4; ++m) arr[ai][m] = (ptr)[EPI_ROW(u, ai, m)] * (scale)
#define EPI_RSTD_ROWS(arr, ptr, STRIDE, OFF, N4, INVN, scale) float arr[2][4]; { f32x4 t_[2][4]; \
    _Pragma("unroll") for (int ai = 0; ai < 2; ++ai) _Pragma("unroll") for (int m = 0; m < 4; ++m) t_[ai][m] = (fq < (N4)) ? *(const GAS f32x4*)((ptr) + (size_t)EPI_ROW(u, ai, m) * (STRIDE) + (OFF) + 4 * fq) : (f32x4){0.f, 0.f, 0.f, 0.f}; \
    _Pragma("unroll") for (int ai = 0; ai < 2; ++ai) _Pragma("unroll") for (int m = 0; m < 4; ++m) { float s_ = (t_[ai][m][0] + t_[ai][m][1]) + (t_[ai][m][2] + t_[ai][m][3]); \
        s_ += __shfl_xor(s_, 16); s_ += __shfl_xor(s_, 32); arr[ai][m] = (scale) / sqrtf(s_ * (INVN) + NORM_EPS); } }

struct EpiIn {
    cgf32* rsa; gf32* gssq; gbf16 *naqkv, *cq, *ckv, *kr, *swq, *swk, *swv; cgf32 *c16, *s16, *c32, *s32; unsigned* krmax;
    __device__ __forceinline__ void operator()(AccRef acc, const Unit& u, int, int wr, int wc, int fr, int fq) const {
        EPI_RSTD_ROWS(rs, rsa, 16, 0, 4, 1.f / DM, 1.f);
#pragma unroll
        for (int bj = 0; bj < 2; ++bj) { const int g = EPI_GRP(u, bj);
            if (g >= 61) continue;
            float kmx = 0.f;
#pragma unroll
            for (int ai = 0; ai < 2; ++ai)
#pragma unroll
                for (int m = 0; m < 4; ++m) { const int row = EPI_ROW(u, ai, m); const int spos = row & (SEQ - 1);
                    const f32x4 v0 = acc[ai][bj][m][0] * rs[ai][m], v1 = acc[ai][bj][m][1] * rs[ai][m];
                    if (g < 24) { const float sc = (g < 8) ? C2_NA : 1.f; st_bf8(naqkv + (size_t)row * 768 + g * 32 + 8 * fq, v0 * sc, v1 * sc); }
                    else if (g < 44) { st_bf8((g < 36) ? cq + (size_t)row * 384 + (g - 24) * 32 + 8 * fq : ckv + (size_t)row * 256 + (g - 36) * 32 + 8 * fq, v0, v1);
                        float ss = ((v0[0] * v0[0] + v0[1] * v0[1]) + (v0[2] * v0[2] + v0[3] * v0[3])) + ((v1[0] * v1[0] + v1[1] * v1[1]) + (v1[2] * v1[2] + v1[3] * v1[3]));
                        ss += __shfl_xor(ss, 16); ss += __shfl_xor(ss, 32); if (fq == 0) gssq[(size_t)row * 20 + (g - 24)] = ss; }
                    else if (g == 44) { const f32x4 c = *(const GAS f32x4*)(c16 + spos * 16 + 4 * fq), sn = *(const GAS f32x4*)(s16 + spos * 16 + 4 * fq);
                        gbf16* d = kr + (size_t)row * 32 + 4 * fq; st_bf4(d, v0 * c - v1 * sn); st_bf4(d + 16, v1 * c + v0 * sn);
                        float ss = ((v0[0] * v0[0] + v0[1] * v0[1]) + (v0[2] * v0[2] + v0[3] * v0[3])) + ((v1[0] * v1[0] + v1[1] * v1[1]) + (v1[2] * v1[2] + v1[3] * v1[3]));
                        ss += __shfl_xor(ss, 16); ss += __shfl_xor(ss, 32); kmx = fmaxf(kmx, ss); }
                    else if (g < 57) { const bool isq = g < 53; const int gg = isq ? g - 45 : g - 53, head = gg >> 1, i0 = 16 * (gg & 1) + 4 * fq;
                        const f32x4 c = *(const GAS f32x4*)(c32 + spos * 32 + i0), sn = *(const GAS f32x4*)(s32 + spos * 32 + i0); const float sc = isq ? C2_SW : 1.f;
                        gbf16* d = (isq ? swq + (size_t)row * 256 : swk + (size_t)row * 128) + head * 64 + i0; st_bf4(d, (v0 * c - v1 * sn) * sc); st_bf4(d + 32, (v1 * c + v0 * sn) * sc); }
                    else st_bf8(swv + (size_t)row * 128 + (g - 57) * 32 + 8 * fq, v0, v1);
                }
            if (g == 44) { kmx = fmaxf(kmx, __shfl_xor(kmx, 1)); kmx = fmaxf(kmx, __shfl_xor(kmx, 2)); kmx = fmaxf(kmx, __shfl_xor(kmx, 4)); kmx = fmaxf(kmx, __shfl_xor(kmx, 8));
                if (fr == 0 && fq == 0) atomicMax(krmax + ((u.pm * 256) >> 12), __float_as_uint(kmx)); }
        }
    }
};
struct EpiQup {
    cgf32* rscq; gbf16* qm; cgf32 *c16, *s16;
    __device__ __forceinline__ void operator()(AccRef acc, const Unit& u, int, int wr, int wc, int fr, int fq) const {
        EPI_RSTD_ROWS(rs, rscq, 20, 0, 3, 1.f / 384.f, C2_MLA);
#pragma unroll
        for (int bj = 0; bj < 2; ++bj) { const int g = EPI_GRP(u, bj); const bool rope = (g % 3) == 2;
#pragma unroll
            for (int ai = 0; ai < 2; ++ai)
#pragma unroll
                for (int m = 0; m < 4; ++m) { const int row = EPI_ROW(u, ai, m); const f32x4 v0 = acc[ai][bj][m][0] * rs[ai][m], v1 = acc[ai][bj][m][1] * rs[ai][m];
                    if (rope) { const int sq = row & (SEQ - 1); const f32x4 c = *(const GAS f32x4*)(c16 + sq * 16 + 4 * fq), sn = *(const GAS f32x4*)(s16 + sq * 16 + 4 * fq);
                        gbf16* d = qm + (size_t)row * 768 + g * 32 + 4 * fq; st_bf4(d, v0 * c - v1 * sn); st_bf4(d + 16, v1 * c + v0 * sn); }
                    else st_bf8(qm + (size_t)row * 768 + g * 32 + 8 * fq, v0, v1); } }
    }
};
struct EpiKVup {
    cgf32* rsckv; gbf16 *kn, *vm; unsigned* kmax;
    __device__ __forceinline__ void operator()(AccRef acc, const Unit& u, int, int wr, int wc, int fr, int fq) const {
        EPI_RSTD_ROWS(rs, rsckv, 20, 12, 2, 1.f / 256.f, 1.f);
#pragma unroll
        for (int bj = 0; bj < 2; ++bj) { const int g = EPI_GRP(u, bj), h = g >> 2, part = g & 3; gbf16* base = ((part < 2) ? kn : vm) + h * 64 + (part & 1) * 32 + 8 * fq; float mx = 0.f;
#pragma unroll
            for (int ai = 0; ai < 2; ++ai)
#pragma unroll
                for (int m = 0; m < 4; ++m) { const f32x4 v0 = acc[ai][bj][m][0] * rs[ai][m], v1 = acc[ai][bj][m][1] * rs[ai][m]; st_bf8(base + (size_t)EPI_ROW(u, ai, m) * 512, v0, v1);
                    if (part < 2) { float ss = ((v0[0] * v0[0] + v0[1] * v0[1]) + (v0[2] * v0[2] + v0[3] * v0[3])) + ((v1[0] * v1[0] + v1[1] * v1[1]) + (v1[2] * v1[2] + v1[3] * v1[3]));
                        ss += __shfl_xor(ss, 16); ss += __shfl_xor(ss, 32); mx = fmaxf(mx, ss); } }
            if (part < 2) { mx = fmaxf(mx, __shfl_xor(mx, 1)); mx = fmaxf(mx, __shfl_xor(mx, 2)); mx = fmaxf(mx, __shfl_xor(mx, 4)); mx = fmaxf(mx, __shfl_xor(mx, 8));
                if (fr == 0 && fq == 0) atomicMax(kmax + (((u.pm * 256) >> 12) * 8 + h) * 2 + part, __float_as_uint(mx)); } }
    }
};
struct EpiBf {
    gbf16* o; int ldc;
    __device__ __forceinline__ void operator()(AccRef acc, const Unit& u, int, int wr, int wc, int fr, int fq) const {
#pragma unroll
        for (int bj = 0; bj < 2; ++bj) { gbf16* base = o + EPI_GRP(u, bj) * 32 + 8 * fq;
#pragma unroll
            for (int ai = 0; ai < 2; ++ai)
#pragma unroll
                for (int m = 0; m < 4; ++m) st_bf8(base + (size_t)EPI_ROW(u, ai, m) * ldc, acc[ai][bj][m][0], acc[ai][bj][m][1]); }
    }
};
struct EpiRes {
    gbf16* hb;
    __device__ __forceinline__ void operator()(AccRef acc, const Unit& u, int, int wr, int wc, int fr, int fq) const {
#pragma unroll
        for (int ai = 0; ai < 2; ++ai) { v4u hv[4][2];
#pragma unroll
            for (int m = 0; m < 4; ++m)
#pragma unroll
                for (int bj = 0; bj < 2; ++bj) hv[m][bj] = *(const GAS v4u*)(hb + (size_t)EPI_ROW(u, ai, m) * DM + EPI_GRP(u, bj) * 32 + 8 * fq);
#pragma unroll
            for (int m = 0; m < 4; ++m)
#pragma unroll
                for (int bj = 0; bj < 2; ++bj) st_bf8(hb + (size_t)EPI_ROW(u, ai, m) * DM + EPI_GRP(u, bj) * 32 + 8 * fq, bflo(hv[m][bj]) + acc[ai][bj][m][0], bfhi(hv[m][bj]) + acc[ai][bj][m][1]);
            asm volatile("" ::: "memory"); }
    }
};
struct EpiSwiglu {
    cgf32* srs; gbf16* act;
    __device__ __forceinline__ void operator()(AccRef acc, const Unit& u, int, int wr, int wc, int fr, int fq) const {
        EPI_LOAD_ROWS(rs, srs, 1.f);
#pragma unroll
        for (int ai = 0; ai < 2; ++ai)
#pragma unroll
            for (int m = 0; m < 4; ++m) { const int row = EPI_ROW(u, ai, m);
#pragma unroll
                for (int bj = 0; bj < 2; ++bj) { const f32x4 a = acc[ai][bj][m][0] * rs[ai][m], up = acc[ai][bj][m][1] * rs[ai][m]; f32x4 r;
#pragma unroll
                    for (int e = 0; e < 4; ++e) r[e] = a[e] * __builtin_amdgcn_rcpf(1.f + __builtin_amdgcn_exp2f(-a[e] * LOG2E)) * up[e];
                    st_bf4(act + (size_t)row * EFF + EPI_GRP(u, bj) * 16 + 4 * fq, r); } }
    }
};
struct EpiDown {
    cgf32* sg; gbf16* y;
    __device__ __forceinline__ void operator()(AccRef acc, const Unit& u, int, int wr, int wc, int fr, int fq) const {
        EPI_LOAD_ROWS(gw, sg, 1.f);
#pragma unroll
        for (int bj = 0; bj < 2; ++bj) { gbf16* base = y + EPI_GRP(u, bj) * 32 + 8 * fq;
#pragma unroll
            for (int ai = 0; ai < 2; ++ai)
#pragma unroll
                for (int m = 0; m < 4; ++m) st_bf8(base + (size_t)EPI_ROW(u, ai, m) * DM, acc[ai][bj][m][0] * gw[ai][m], acc[ai][bj][m][1] * gw[ai][m]); }
    }
};
struct EpiPle {
    cgf32* rsp; cgbf16* pp; cgbf16* hb; gbf16* hbo; gf32* pssq;
    __device__ __forceinline__ void operator()(AccRef acc, const Unit& u, int, int wr, int wc, int fr, int fq) const {
        EPI_LOAD_ROWS(rs, rsp, 1.f);
#pragma unroll
        for (int ai = 0; ai < 2; ++ai) { v4u hv[4][2], pv[4][2];
#pragma unroll
            for (int m = 0; m < 4; ++m)
#pragma unroll
                for (int bj = 0; bj < 2; ++bj) { const size_t off = (size_t)EPI_ROW(u, ai, m) * DM + EPI_GRP(u, bj) * 32 + 8 * fq; hv[m][bj] = *(const GAS v4u*)(hb + off); pv[m][bj] = __builtin_nontemporal_load((const GAS v4u*)(pp + off)); }
#pragma unroll
            for (int m = 0; m < 4; ++m) { float ss = 0.f; const int row = EPI_ROW(u, ai, m);
#pragma unroll
                for (int bj = 0; bj < 2; ++bj) { const f32x4 a0 = acc[ai][bj][m][0] * rs[ai][m], a1 = acc[ai][bj][m][1] * rs[ai][m]; const f32x4 h0 = bflo(hv[m][bj]), h1 = bfhi(hv[m][bj]), p0 = bflo(pv[m][bj]), p1 = bfhi(pv[m][bj]); f32x4 r0, r1;
#pragma unroll
                    for (int e = 0; e < 4; ++e) { r0[e] = h0[e] + __builtin_amdgcn_rcpf(1.f + __builtin_amdgcn_exp2f(-a0[e] * LOG2E)) * p0[e]; r1[e] = h1[e] + __builtin_amdgcn_rcpf(1.f + __builtin_amdgcn_exp2f(-a1[e] * LOG2E)) * p1[e]; }
                    st_bf8(hbo + (size_t)row * DM + EPI_GRP(u, bj) * 32 + 8 * fq, r0, r1);
                    ss += ((r0[0] * r0[0] + r0[1] * r0[1]) + (r0[2] * r0[2] + r0[3] * r0[3])) + ((r1[0] * r1[0] + r1[1] * r1[1]) + (r1[2] * r1[2] + r1[3] * r1[3])); }
                ss += __shfl_xor(ss, 16); ss += __shfl_xor(ss, 32);
                if (fq == 0) pssq[(size_t)row * 16 + u.pn * 4 + wc] = ss; }
            asm volatile("" ::: "memory"); }
    }
};

__device__ __forceinline__ void router_pass(Frame& F, const Args& a, int l) {
    LAUNDER_LANES();
    typedef short bf16x8_t __attribute__((ext_vector_type(8)));
    constexpr int WST = 2064;
    LAS char* WB = (LAS char*)(F.lds + RING_OFF);
    LAS float* sc = (LAS float*)(F.lds + RING_OFF + 32 * WST) + wave * 16;
    const GAS char* wsrc = (const GAS char*)(F.ws + WS_MISC + MO_WR) + (size_t)l * 32 * DM * 2;
    for (int c = tid; c < 32 * 128; c += 512) { const int r = c >> 7, ch = c & 127; *(LAS v4u*)(WB + r * WST + ch * 16) = *(const GAS v4u*)(wsrc + (size_t)r * 2048 + ch * 16); }
    __syncthreads();
    gf32* aff = (gf32*)MISCP(float, MO_AFF); gf32* rsf = (gf32*)MISCP(float, MO_RSF);
    const int gw = F.vcu * NWAVES + wave, NGW = F.G * NWAVES, fr = lane & 15, fq = lane >> 4;
    for (int grp = gw; grp < TOK / 16; grp += NGW) {
        const int row0 = grp * 16;
        const GAS char* ap = (const GAS char*)F.hb + ((size_t)(row0 + fr) * DM + fq * 8) * 2;
        const LAS char* bp = WB + fr * WST + fq * 16;
        f32x4 ah = {0.f, 0.f, 0.f, 0.f}, al = {0.f, 0.f, 0.f, 0.f}, as = {0.f, 0.f, 0.f, 0.f};
#pragma unroll 8
        for (int ks = 0; ks < 32; ++ks) { const bf16x8_t av = *(const GAS bf16x8_t*)(ap + ks * 64);
            const bf16x8_t bh = *(const LAS bf16x8_t*)(bp + ks * 64), bl = *(const LAS bf16x8_t*)(bp + 16 * WST + ks * 64);
            ah = __builtin_amdgcn_mfma_f32_16x16x32_bf16(av, bh, ah, 0, 0, 0); al = __builtin_amdgcn_mfma_f32_16x16x32_bf16(av, bl, al, 0, 0, 0);
            as = __builtin_amdgcn_mfma_f32_16x16x32_bf16(av, av, as, 0, 0, 0); }
        { const float d = (fr & 3) == 0 ? as[0] : (fr & 3) == 1 ? as[1] : (fr & 3) == 2 ? as[2] : as[3]; if ((fr >> 2) == fq) sc[fr] = d; }
        LDS_WAIT();
        const f32x4 ssq = *(const LAS f32x4*)(sc + 4 * fq);
#pragma unroll
        for (int r = 0; r < 4; ++r) { const float rs = 1.0f / sqrtf(ssq[r] * (1.f / DM) + NORM_EPS); const float lg = (ah[r] + al[r]) * rs;
            float mx = lg; mx = fmaxf(mx, __shfl_xor(mx, 1)); mx = fmaxf(mx, __shfl_xor(mx, 2)); mx = fmaxf(mx, __shfl_xor(mx, 4)); mx = fmaxf(mx, __shfl_xor(mx, 8));
            const float ex = __expf(lg - mx); float sm = ex; sm += __shfl_xor(sm, 1); sm += __shfl_xor(sm, 2); sm += __shfl_xor(sm, 4); sm += __shfl_xor(sm, 8);
            const int m = row0 + 4 * fq + r;
            aff[((size_t)(m >> 12) * NEXP + fr) * SEQ + (m & (SEQ - 1))] = ex / sm;
            if (fr == 0) rsf[m] = rs; }
        LDS_WAIT(); asm volatile("" ::: "memory");
    }
}
__device__ __forceinline__ unsigned block_excl_scan(unsigned v, LAS unsigned* wsum, int lane, int wave) {
    unsigned s = v;
#pragma unroll
    for (int d = 1; d < 64; d <<= 1) { const unsigned t = __shfl_up(s, d); if (lane >= d) s += t; }
    if (lane == 63) wsum[wave] = s;
    __syncthreads();
    unsigned base = 0;
    for (int w = 0; w < wave; ++w) base += wsum[w];
    __syncthreads();
    return base + s - v;
}
__device__ __forceinline__ void topk_block(Frame& F, int be) {
    LAUNDER_LANES();
    LAS unsigned* hist = (LAS unsigned*)(F.lds + RING_OFF); LAS unsigned* ctl = hist + 256; LAS unsigned* wsum = hist + 272;
    const float* aff = MISCP(float, MO_AFF) + (size_t)be * SEQ; const float* rsf = MISCP(float, MO_RSF);
    unsigned* sidx = MISCP(unsigned, MO_SIDX) + be * CAP; float* sg = MISCP(float, MO_SG) + be * CAP; float* srs = MISCP(float, MO_SRS) + be * CAP; int* inv = MISCP(int, MO_INV);
    const int b = be >> 4, e = be & 15;
    unsigned key[8];
    { const v4u k0 = *(const GAS v4u*)(aff + tid * 8), k1 = *(const GAS v4u*)(aff + tid * 8 + 4); key[0] = k0.x; key[1] = k0.y; key[2] = k0.z; key[3] = k0.w; key[4] = k1.x; key[5] = k1.y; key[6] = k1.z; key[7] = k1.w; }
    unsigned prefix = 0, need = CAP;
#pragma unroll
    for (int pass = 0; pass < 4; ++pass) { const int shift = 24 - 8 * pass;
        if (tid < 256) hist[tid] = 0u;
        __syncthreads();
#pragma unroll
        for (int i = 0; i < 8; ++i) { const bool match = (pass == 0) ? true : ((key[i] >> ((shift + 8) & 31)) == prefix); if (match) (void)__hip_atomic_fetch_add(&hist[(key[i] >> shift) & 255u], 1u, __ATOMIC_RELAXED, __HIP_MEMORY_SCOPE_WORKGROUP); }
        __syncthreads();
        if (wave == 0) { const unsigned h0 = hist[255 - 4 * lane], h1 = hist[254 - 4 * lane], h2 = hist[253 - 4 * lane], h3 = hist[252 - 4 * lane]; const unsigned c = h0 + h1 + h2 + h3; unsigned s = c;
#pragma unroll
            for (int d = 1; d < 64; d <<= 1) { const unsigned t = __shfl_up(s, d); if (lane >= d) s += t; }
            const unsigned excl = s - c;
            if (excl < need && need <= s) { const unsigned r = need - excl; unsigned bin, above;
                if (r <= h0) { bin = 255 - 4 * lane; above = 0; } else if (r <= h0 + h1) { bin = 254 - 4 * lane; above = h0; } else if (r <= h0 + h1 + h2) { bin = 253 - 4 * lane; above = h0 + h1; } else { bin = 252 - 4 * lane; above = h0 + h1 + h2; }
                ctl[0] = (prefix << 8) | bin; ctl[1] = r - above; } }
        __syncthreads();
        prefix = ctl[0]; need = ctl[1];
    }
    const unsigned T = prefix;
    unsigned cgt = 0, ceq = 0;
#pragma unroll
    for (int i = 0; i < 8; ++i) { cgt += key[i] > T ? 1u : 0u; ceq += key[i] == T ? 1u : 0u; }
    const unsigned eqb = block_excl_scan(ceq, wsum, lane, wave);
    const unsigned take = (eqb >= need) ? 0u : ((need - eqb) < ceq ? (need - eqb) : ceq);
    unsigned pos = block_excl_scan(cgt + take, wsum, lane, wave);
    unsigned eqr = 0;
#pragma unroll
    for (int i = 0; i < 8; ++i) { const int s = tid * 8 + i; bool sel = key[i] > T; if (key[i] == T) { sel = eqr < take; ++eqr; }
        const int grow = b * SEQ + s;
        if (sel) { sidx[pos] = (unsigned)grow; sg[pos] = __uint_as_float(key[i]); srs[pos] = rsf[grow]; inv[(size_t)grow * NEXP + e] = (int)pos; ++pos; }
        else inv[(size_t)grow * NEXP + e] = -1; }
    __syncthreads();
}
__device__ __forceinline__ void combine_pass(Frame& F) {
    LAUNDER_LANES();
    const GAS int* inv = (const GAS int*)MISCP(int, MO_INV); cgbf16* Y = (cgbf16*)(F.ws + WS_BIG + BOX(BO_Y, 128)); gbf16* hb = (gbf16*)F.hb; gf32* rsp = (gf32*)MISCP(float, MO_RSP);
    const bool loc = (F.G == 256); const int NGW = loc ? 256 : F.G * NWAVES, gw = loc ? (F.vcu >> 5) * SEQ + (F.vcu & 31) * NWAVES + wave : F.vcu * NWAVES + wave, mend = loc ? ((F.vcu >> 5) + 1) * SEQ : TOK;
    v2u hn[4]; int ivn = -1;
    if (gw < mend) { const GAS v2u* hr = (const GAS v2u*)(hb + (size_t)gw * DM) + lane;
#pragma unroll
        for (int j = 0; j < 4; ++j) hn[j] = hr[64 * j];
        ivn = (lane < 16) ? inv[(size_t)gw * NEXP + lane] : -1; }
    for (int m = gw; m < mend; m += NGW) {
        f32x4 v[4]; const int ivl = ivn;
#pragma unroll
        for (int j = 0; j < 4; ++j) { v[j][0] = __uint_as_float(hn[j].x << 16); v[j][1] = __uint_as_float(hn[j].x & 0xffff0000u); v[j][2] = __uint_as_float(hn[j].y << 16); v[j][3] = __uint_as_float(hn[j].y & 0xffff0000u); }
        const int mn = m + NGW;
        if (mn < mend) { const GAS v2u* hr = (const GAS v2u*)(hb + (size_t)mn * DM) + lane;
#pragma unroll
            for (int j = 0; j < 4; ++j) hn[j] = hr[64 * j];
            ivn = (lane < 16) ? inv[(size_t)mn * NEXP + lane] : -1; }
        unsigned mk = (unsigned)__ballot(ivl >= 0) & 0xffffu;
        cgbf16* ybase = Y + (size_t)(m >> 12) * NEXP * CAP * DM + 4 * lane;
        while (mk) {
            v2u y[4][4]; bool has[4];
#pragma unroll
            for (int g = 0; g < 4; ++g) { has[g] = mk != 0u; const int e = has[g] ? (__builtin_ctz(mk)) : 0; if (has[g]) mk &= mk - 1u;
                const int pos = __builtin_amdgcn_readlane(ivl, e);
                if (has[g]) { const GAS v2u* yr = (const GAS v2u*)(ybase + ((size_t)e * CAP + pos) * DM);
#pragma unroll
                    for (int j = 0; j < 4; ++j) y[g][j] = __builtin_nontemporal_load(yr + 64 * j); } }
#pragma unroll
            for (int g = 0; g < 4; ++g) if (has[g]) {
#pragma unroll
                for (int j = 0; j < 4; ++j) { v[j][0] += __uint_as_float(y[g][j].x << 16); v[j][1] += __uint_as_float(y[g][j].x & 0xffff0000u); v[j][2] += __uint_as_float(y[g][j].y << 16); v[j][3] += __uint_as_float(y[g][j].y & 0xffff0000u); } }
        }
        gbf16* ho = hb + (size_t)m * DM + 4 * lane; float s = 0.f;
#pragma unroll
        for (int j = 0; j < 4; ++j) { st_bf4(ho + 256 * j, v[j]); s += (v[j][0] * v[j][0] + v[j][1] * v[j][1]) + (v[j][2] * v[j][2] + v[j][3] * v[j][3]); }
        const float rs = 1.0f / sqrtf(wave_sum(s) * (1.f / DM) + NORM_EPS);
        if (lane == 0) rsp[m] = rs;
    }
}

__device__ __forceinline__ void attention_phase(Frame& F, const Args& a, int l) {
    const GAS bf16* big = (const GAS bf16*)(F.ws + WS_BIG); GAS bf16* ocat = (GAS bf16*)(F.ws + WS_OCAT);
    const GAS bf16* naqkv = (const GAS bf16*)((const GAS char*)big + BOX(BO_NAQKV, 48)); const GAS bf16* krp = (const GAS bf16*)((const GAS char*)big + BOX(BO_KR, 2));
    const GAS bf16* swq = (const GAS bf16*)((const GAS char*)big + BOX(BO_SWQ, 16)); const GAS bf16* swk = (const GAS bf16*)((const GAS char*)big + BOX(BO_SWK, 8)); const GAS bf16* swv = (const GAS bf16*)((const GAS char*)big + BOX(BO_SWV, 8));
    const GAS bf16* qm = (const GAS bf16*)((const GAS char*)big + BOX(BO_QM, 48)); const GAS bf16* kn = (const GAS bf16*)((const GAS char*)big + BOX(BO_KN, 32)); const GAS bf16* vm = (const GAS bf16*)((const GAS char*)big + BOX(BO_VM, 32));
    LAS char* lds = (LAS char*)(F.lds + RING_OFF);
    DUP(15) PH(15) for (int i = 0; i < 2 * 256; i += 1) {
        int uidx;
        if (F.G == 256) { if (i >= 2) break; const int x = F.vcu >> 5, v = F.vcu & 31; uidx = ((x * 8 + 4 * i + (v >> 3)) << 3) | (v & 7); }
        else { uidx = F.vcu + i * F.G; if (uidx >= 512) break; }
        const int bh = uidx >> 3, qb = uidx & 7, b = bh >> 3, h = bh & 7; const size_t r0 = (size_t)b * SEQ;
        att::AttnIO io; io.q = qm + (r0 + qb * 512) * 768 + h * 96; io.ldq = 768; io.k = kn + r0 * 512 + h * 64; io.ldk = 512; io.k2 = krp + r0 * 32; io.ldk2 = 32;
        io.v = vm + r0 * 512 + h * 64; io.ldv = 512; io.o = ocat + (r0 + qb * 512) * DM + 256 + h * 64; io.ldo = DM;
        const unsigned* km = (const unsigned*)(F.ws + WS_CTL) + CW_KMAX; const float km2 = __uint_as_float(__hip_atomic_load(km + bh * 2, __ATOMIC_RELAXED, __HIP_MEMORY_SCOPE_AGENT)) + __uint_as_float(__hip_atomic_load(km + bh * 2 + 1, __ATOMIC_RELAXED, __HIP_MEMORY_SCOPE_AGENT)) + __uint_as_float(__hip_atomic_load(km + 128 + b, __ATOMIC_RELAXED, __HIP_MEMORY_SCOPE_AGENT));
        int role; if (att::mla_block_fixed<2>(io, km2, lds, role)) att::attn_unit16<4>(io, role, lds);
        else { att::attn_unit<0, false>(io, 0, 0.f, nullptr, lds); io.q += (size_t)256 * io.ldq; io.o += (size_t)256 * io.ldo; att::attn_unit<0, false>(io, 0, 0.f, nullptr, lds); }
    }
    DUP(16) PH(16) for (int uq = F.vcu; uq < 512; uq += F.G) { const int uidx = (F.G == 256) ? ((F.vcu >> 5) << 6) | ((uq >> 8) << 5) | (F.vcu & 31) : uq;
        const int r4 = uidx & 15, h = (uidx >> 4) & 3, b = uidx >> 6; const size_t r0 = (size_t)b * SEQ;
        att::AttnIO io; io.q = naqkv + (r0 + r4 * 256) * 768 + h * 64; io.ldq = 768; io.k = naqkv + r0 * 768 + 256 + h * 64; io.ldk = 768; io.k2 = nullptr; io.ldk2 = 0;
        io.v = naqkv + r0 * 768 + 512 + h * 64; io.ldv = 768; io.o = ocat + (r0 + r4 * 256) * DM + h * 64; io.ldo = DM;
        att::attn_unit<1>(io, r4, 0.f, (const GAS float*)(a.in[I_NA_RPB] + ((size_t)l * 4 + h) * 465), lds);
    }
    DUP(17) PH(17) { int tid3_ = threadIdx.x; asm volatile("" : "+v"(tid3_)); const int wv = __builtin_amdgcn_readfirstlane(tid3_ >> 6);
      __syncthreads();
      for (int wt = F.vcu * 8 + wv; wt < 2048; wt += F.G * 8) {
#pragma unroll 1
        for (int k2 = 0; k2 < 2; ++k2) { const int tsk = wt * 2 + k2, jb = tsk & 127, h = (tsk >> 7) & 3, b = tsk >> 9; const size_t r0 = (size_t)b * SEQ;
          att::swa_wave_task(swq + r0 * 256 + h * 64, swk + r0 * 128 + (h >> 1) * 64, swv + r0 * 128 + (h >> 1) * 64, ocat + r0 * DM + 768 + h * 64, jb * 32,
                             a.in[I_SWA_SINK][l * 4 + h] * LOG2E, lds + wv * att::SWW_LDS); } }
      __syncthreads(); }
}

__global__ void __launch_bounds__(NWAVES * 64, 2) enc_fwd(Args args) {
    extern __shared__ __attribute__((aligned(16))) unsigned char lds[];
    Frame F;
    F.lds = (LAS unsigned char*)lds;
    F.MISC = (volatile LAS unsigned*)(F.lds + MISC_OFF);
    F.G = gridDim.x; { const int bx = blockIdx.x; F.vcu = (F.G % 8 == 0) ? (bx % 8) * (F.G / 8) + bx / 8 : bx; }
    F.ws = args.ws; F.out = args.out; F.xl = 0; F.xb = 0;
    for (int u = threadIdx.x; u < (GTAB_OFF - LDSCTL_OFF) / 4; u += NWAVES * 64) ((LAS unsigned*)(F.lds + LDSCTL_OFF))[u] = 0u;
    __syncthreads();
    XcdBarrier bar = xcd_barrier_post((unsigned*)(F.ws + WS_CTL) + CW_BAR, F.MISC + 8);
#define BAR_REFRESH() do { unsigned char* ws_ = args.ws; asm volatile("" : "+s"(ws_)); F.ws = ws_; bar.bar = (unsigned*)(ws_ + WS_CTL) + CW_BAR; Wl = lcur ? (bf16*)((char*)F.out + ((size_t)64 << 20)) : WSP(bf16, WS_W); hb = hb_in_out ? (bf16*)F.out : WSP(bf16, WS_HB); F.hb = hb; big = F.ws + WS_BIG; } while (0)
#define GRID_BAR() do { { unsigned x_ = bar.x; asm volatile("" : "+s"(x_)); bar.x = x_; } xcd_barrier(bar); BAR_REFRESH(); } while (0)
#define LAYER_BAR() do { if (xl_ok) { { unsigned x_ = bar.x; asm volatile("" : "+s"(x_)); bar.x = x_; } xcd_local_barrier((unsigned*)(F.ws + WS_CTL) + CW_XL + bar.x, 32u, bar.bar); } else { { unsigned x_ = bar.x; asm volatile("" : "+s"(x_)); bar.x = x_; } xcd_barrier(bar); } BAR_REFRESH(); } while (0)
    int lcur = 0;
    bool hb_in_out = false;
    bf16* Wl = WSP(bf16, WS_W); bf16* hb = WSP(bf16, WS_HB); unsigned char* big = F.ws + WS_BIG; F.hb = hb;
    const int bx = (int)blockIdx.x;

    DUP(0) PH(0) { convert_layer_weights(F, args, 0, true, WSP(bf16, WS_W));
    rope_tables(F, args);
    router_weights(F, args);
    x_to_hb(F, args);
    convert_p(F, args, 0, WSP(bf16, WS_PB));
    if (DEPTH > 1) { convert_layer_weights(F, args, 1, false, (bf16*)((char*)F.out + ((size_t)64 << 20))); convert_p(F, args, 1, (bf16*)(F.ws + WS_END)); } }
    static_assert(DEPTH <= 2, "weight regions");
    GRID_BAR();
    int cid = bx; bool xl_ok = false;
    { if (threadIdx.x == 0) { unsigned* bw = (unsigned*)(F.ws + WS_CTL) + CW_BAR; unsigned n32 = 0, sum = 0;
          for (unsigned j = 0; j < 16; ++j) { const unsigned c = xb_ld(&bw[XB_XCNT(j)]); sum += c; n32 += (c == 32u) ? 1u : 0u; }
          F.MISC[8 + 3] = (n32 == 8u && sum == 256u && F.G == 256) ? 1u : 0u; }
      __syncthreads();
      xl_ok = F.MISC[8 + 3] != 0u; const int rank = (int)F.MISC[8 + 2], xcc = (int)bar.x;
      if (xl_ok) { cid = __builtin_amdgcn_readfirstlane(rank * 8 + xcc); F.vcu = __builtin_amdgcn_readfirstlane(xcc * 32 + rank); F.xl = 1; F.xb = __builtin_amdgcn_readfirstlane(xcc); } }

    int done_layers = 0;
#pragma unroll 1
    for (int l = 0; l < DEPTH; ++l) {
        if (STOP_AFTER <= 10 * l) break;
        lcur = l; Wl = lcur ? (bf16*)((char*)F.out + ((size_t)64 << 20)) : WSP(bf16, WS_W);
        DUP(1) PH(1) { pg8::ProbPlain g{hb, (const bf16*)((char*)Wl + WO_IN), DM}; pg8::StaticOrder S; S.init(TOK, IN_WP, F.G, cid);
          EpiIn E{(cgf32*)MISCP(float, MO_PSSQ), (gf32*)MISCP(float, MO_GSSQ), (gbf16*)(big + BOX(BO_NAQKV, 48)), (gbf16*)(big + BOX(BO_CQ, 24)), (gbf16*)(big + BOX(BO_CKV, 16)), (gbf16*)(big + BOX(BO_KR, 2)), (gbf16*)(big + BOX(BO_SWQ, 16)), (gbf16*)(big + BOX(BO_SWK, 8)), (gbf16*)(big + BOX(BO_SWV, 8)),
                  (cgf32*)MISCP(float, MO_COS16), (cgf32*)MISCP(float, MO_SIN16), (cgf32*)MISCP(float, MO_COS32), (cgf32*)MISCP(float, MO_SIN32), (unsigned*)(F.ws + WS_CTL) + CW_KRMAX};
          pg8::gemm_phase<pg8::ProbPlain, EpiIn, pg8::StaticOrder, true>(F.lds + RING_OFF, g, S, E); }
        LAYER_BAR();
        const bool p2split = (F.G == 256);
        DUP(2) PH(2) if (!p2split || cid < 128) { pg8::ProbPlain g{(const bf16*)(big + BOX(BO_CQ, 24)), (const bf16*)((char*)Wl + WO_QUP), 384}; pg8::StaticOrder S; S.init(TOK, 768, p2split ? 128 : F.G, cid);
          EpiQup E{(cgf32*)MISCP(float, MO_GSSQ), (gbf16*)(big + BOX(BO_QM, 48)), (cgf32*)MISCP(float, MO_COS16), (cgf32*)MISCP(float, MO_SIN16)};
          pg8::gemm_phase<pg8::ProbPlain, EpiQup, pg8::StaticOrder, true>(F.lds + RING_OFF, g, S, E); }
        DUP(2) PH(3) if (!p2split || cid >= 128) { pg8::ProbPlain g{(const bf16*)(big + BOX(BO_CKV, 16)), (const bf16*)((char*)Wl + WO_KVUP), 256}; pg8::StaticOrder S; S.init(TOK, 1024, p2split ? 128 : F.G, p2split ? cid - 128 : cid);
          EpiKVup E{(cgf32*)MISCP(float, MO_GSSQ), (gbf16*)(big + BOX(BO_KN, 32)), (gbf16*)(big + BOX(BO_VM, 32)), (unsigned*)(F.ws + WS_CTL) + CW_KMAX};
          pg8::gemm_phase<pg8::ProbPlain, EpiKVup, pg8::StaticOrder, true>(F.lds + RING_OFF, g, S, E); }
        LAYER_BAR();
        DUP(4) PH(4) attention_phase(F, args, l);
        LAYER_BAR();
        PH(5) { pg8::ProbPlain g{WSP(bf16, WS_OCAT), (const bf16*)((char*)Wl + WO_OUT), DM}; pg8::StaticOrder S; S.init(TOK, DM, F.G, cid);
          EpiRes E{(gbf16*)hb};
          pg8::gemm_phase<pg8::ProbPlain, EpiRes, pg8::StaticOrder, true>(F.lds + RING_OFF, g, S, E); }
        LAYER_BAR();
        done_layers = l + 1;
        if (STOP_AFTER <= 10 * l + 1) break;
        DUP(6) PH(6) router_pass(F, args, l);
        LAYER_BAR();
        DUP(7) PH(7) { if (F.G == 256) { if (cid < 128) topk_block(F, (cid & 7) * NEXP + (cid >> 3)); }
                       else for (int be = bx; be < BATCH * NEXP; be += F.G) topk_block(F, be); }
        DUP(8) PH(8) { pg8::ProbPlain g{lcur ? (const bf16*)(F.ws + WS_END) : WSP(bf16, WS_PB), (const bf16*)((char*)Wl + WO_PP), PLE}; pg8::StaticOrder S; S.init(TOK, DM, (F.G == 256) ? (cid < 128 ? 512 : 128) : F.G, cid);
          EpiBf E{(gbf16*)WSP(bf16, WS_PPO), DM};
          pg8::gemm_phase<pg8::ProbPlain, EpiBf, pg8::StaticOrder, true>(F.lds + RING_OFF, g, S, E); }
        LAYER_BAR();
        DUP(9) PH(9) { pg8::StaticOrder S; S.init(NSLOT, DM, F.G, cid);
          LAS unsigned* gtab = (LAS unsigned*)(F.lds + GTAB_OFF); const unsigned* sidx = MISCP(unsigned, MO_SIDX);
          { LAUNDER_LANES(); Unit u; for (int i = 0; i < 8; ++i) if (S.next(i, u) && tid < 256) gtab[i * 256 + tid] = sidx[u.pm * 256 + tid]; }
          __syncthreads();
          pg8::ProbGather g{hb, (const bf16*)((char*)Wl + WO_GU), DM, (size_t)DM * DM, gtab};
          EpiSwiglu E{(cgf32*)MISCP(float, MO_SRS), (gbf16*)(big + BOX(BO_ACT, 64))};
          pg8::gemm_phase<pg8::ProbGather, EpiSwiglu, pg8::StaticOrder, true>(F.lds + RING_OFF, g, S, E); }
        LAYER_BAR();
        DUP(10) PH(10) { pg8::ProbExpert g{(const bf16*)(big + BOX(BO_ACT, 64)), (const bf16*)((char*)Wl + WO_DOWN), EFF, (size_t)DM * EFF}; pg8::StaticOrder S; S.init(NSLOT, DM, F.G, cid);
          EpiDown E{(cgf32*)MISCP(float, MO_SG), (gbf16*)(big + BOX(BO_Y, 128))};
          pg8::gemm_phase<pg8::ProbExpert, EpiDown, pg8::StaticOrder, true>(F.lds + RING_OFF, g, S, E); }
        LAYER_BAR();
        PH(11) combine_pass(F);
        if (STOP_AFTER <= 10 * l + 2) { GRID_BAR(); break; }
        LAYER_BAR();
        DUP(13) PH(13) { pg8::ProbPlain g{hb, WSP(bf16, WS_WPG) + (size_t)l * DM * DM, DM}; pg8::StaticOrder S; S.init(TOK, DM, F.G, cid);
          EpiPle E{(cgf32*)MISCP(float, MO_RSP), (cgbf16*)WSP(bf16, WS_PPO), (cgbf16*)hb, (gbf16*)(hb_in_out ? WSP(bf16, WS_HB) : (bf16*)F.out), (gf32*)MISCP(float, MO_PSSQ)};
          pg8::gemm_phase<pg8::ProbPlain, EpiPle, pg8::StaticOrder, true>(F.lds + RING_OFF, g, S, E); }
        hb_in_out = !hb_in_out;
        if (l == DEPTH - 1) GRID_BAR(); else LAYER_BAR();
    }
    DUP(14) PH(14) final_norm(F, args);
    if (bx == 0 && threadIdx.x == 0) { unsigned* b = (unsigned*)(F.ws + WS_CTL) + CW_BAR; if (xb_ld(&b[XB_TMO]) != 0u) { const float q = __builtin_nanf(""); F.out[0] = q; } }
#undef GRID_BAR
}

extern "C" void kernel_launch(void* const* d_in, const int* in_sizes, int n_in, void* d_out, int out_size, void* d_ws, size_t ws_size, hipStream_t stream) {
    static int grid = 0;
    if (grid == 0) {
        if (n_in != 20 || in_sizes[0] != TOK * DM || out_size != TOK * DM || ws_size < WS_END + (size_t)TOK * PLE * 2) {
            fprintf(stderr, "kernel_launch: unexpected shapes: n_in %d in0 %d out %d ws %zu (need %zu)\n", n_in, n_in > 0 ? in_sizes[0] : -1, out_size, ws_size, (size_t)WS_END); grid = -1; return; }
        int dev = 0, cus = 0, per_cu = 0;
        if (hipGetDevice(&dev) != hipSuccess || hipDeviceGetAttribute(&cus, hipDeviceAttributeMultiprocessorCount, dev) != hipSuccess) { grid = -1; return; }
        if (hipFuncSetAttribute((const void*)enc_fwd, hipFuncAttributeMaxDynamicSharedMemorySize, LDS_BYTES) != hipSuccess) { fprintf(stderr, "kernel_launch: hipFuncSetAttribute failed\n"); grid = -1; return; }
        if (hipOccupancyMaxActiveBlocksPerMultiprocessor(&per_cu, (const void*)enc_fwd, NWAVES * 64, LDS_BYTES) != hipSuccess || per_cu < 1) {
            fprintf(stderr, "kernel_launch: occupancy query reports %d workgroups per CU\n", per_cu); (void)hipGetLastError(); grid = -1; return; }
        if (cus < 128) { fprintf(stderr, "kernel_launch: needs >= 128 CUs\n"); grid = -1; return; }
        grid = cus;
    }
    if (grid < 0) return;
    if (hipMemsetAsync((char*)d_ws + WS_CTL, 0, CTL_ZERO_BYTES, stream) != hipSuccess) { fprintf(stderr, "kernel_launch: memset failed\n"); return; }
    Args a{};
    for (int i = 0; i < 20; ++i) a.in[i] = (const float*)d_in[i];
    a.out = (float*)d_out; a.ws = (unsigned char*)d_ws;
    for (int i = 0; i < 16; ++i) a.inv16[i] = 1.0 / pow(10000.0, (double)(2 * i) / 32.0);
    for (int i = 0; i < 32; ++i) a.inv32[i] = 1.0 / pow(10000.0, (double)(2 * i) / 64.0);
    void* kargs[] = {&a};
    const hipError_t le = hipLaunchCooperativeKernel((const void*)enc_fwd, dim3(grid), dim3(NWAVES * 64), kargs, LDS_BYTES, stream);
    if (le != hipSuccess) fprintf(stderr, "kernel_launch: launch failed: %s (grid %d)\n", hipGetErrorName(le), grid);
}
```

```cpp
#include <hip/hip_runtime.h>
#include <hip/hip_bf16.h>
#include <cstdio>
#include <cstdint>
#include <cmath>

#ifndef STOP_AFTER
#define STOP_AFTER 99
#endif

namespace pg8 {
#define PG8_LAS __attribute__((address_space(3)))
typedef unsigned short bf16_t;
typedef short bf16x8 __attribute__((ext_vector_type(8)));
typedef float f32x4 __attribute__((ext_vector_type(4)));
typedef unsigned u32x4 __attribute__((ext_vector_type(4)));
typedef unsigned u32x2 __attribute__((ext_vector_type(2)));
constexpr int BM = 256, BK = 64, HALF = 128, HTB = HALF * BK * 2  , STAGE_BYTES = 8 * HTB, NXCD = 8, WGM = 8;

__host__ __device__ __forceinline__ int lds_byte(int r, int c) { const int st = (r >> 4) * 2 + (c >> 5), rr = r & 15, cc = c & 31, ob = rr * 64 + cc * 2; return st * 1024 + (ob ^ (((ob >> 9) & 1) << 5)); }
__host__ __device__ __forceinline__ int perm32(int rho) { const int n = rho >> 4, i = rho & 15; return 8 * (i >> 2) + 4 * n + (i & 3); }
__host__ __device__ __forceinline__ void stage_rc(int b, int& R, int& C) { const int st = b / 1024, sb = b % 1024, swz = sb ^ (((sb >> 9) & 1) << 5); R = (st >> 1) * 16 + swz / 64; C = (st & 1) * 32 + (swz % 64) / 2; }

struct Unit { int pm, pn; };

struct StaticOrder {
    int nM, nN, nwg, G, c;
    __host__ __device__ __forceinline__ void init(int M, int N, int G_, int c_) { nM = M / BM; nN = N / BM; nwg = nM * nN; G = G_; c = c_; }
    __host__ __device__ __forceinline__ bool next(int i, Unit& u) const {
        const long L = (long)i * G + c; if (L >= nwg) return false;
        int wgid = (int)L; { const int q = nwg / NXCD, r = nwg % NXCD, xcd = wgid % NXCD, off = wgid / NXCD; wgid = (xcd < r ? xcd * (q + 1) : r * (q + 1) + (xcd - r) * q) + off; }
        const int nig = WGM * nN, gid = wgid / nig, fm = gid * WGM, gsz = (nM - fm) < WGM ? (nM - fm) : WGM;
        u.pm = fm + ((wgid % nig) % gsz); u.pn = (wgid % nig) / gsz; return true;
    }
};

struct ExpertOrder : StaticOrder {
    __host__ __device__ __forceinline__ bool next(int i, Unit& u) const { if (!StaticOrder::next(i, u)) return false; const int q = u.pm; u.pm = ((((q >> 1) & 7) * 16 + (q >> 4)) << 1) | (q & 1); return true; }
};

struct ProbPlain {
    static constexpr bool GATHER = false;
    const bf16_t* A; const bf16_t* Bt; int K;
    __device__ __forceinline__ const char* a_tile(const Unit& u) const { return (const char*)A + (size_t)u.pm * BM * K * 2; }
    __device__ __forceinline__ const char* a_base() const { return (const char*)A; }
    __device__ __forceinline__ unsigned a_off(int, const Unit& u, int r, int C) const { return (unsigned)(((u.pm * BM + r) * K + C) * 2); }
    __device__ __forceinline__ const char* b_tile(const Unit& u) const { return (const char*)Bt + (size_t)u.pn * BM * K * 2; }
};
struct ProbExpert {
    static constexpr bool GATHER = false;
    const bf16_t* A; const bf16_t* Bt; int K; size_t estride;
    __device__ __forceinline__ const char* a_tile(const Unit& u) const { return (const char*)A + (size_t)u.pm * BM * K * 2; }
    __device__ __forceinline__ const char* a_base() const { return (const char*)A; }
    __device__ __forceinline__ unsigned a_off(int, const Unit& u, int r, int C) const { return (unsigned)(((u.pm * BM + r) * K + C) * 2); }
    __device__ __forceinline__ const char* b_tile(const Unit& u) const { return (const char*)Bt + ((size_t)((u.pm >> 1) & 15) * estride + (size_t)u.pn * BM * K) * 2; }
};
struct ProbGather {
    static constexpr bool GATHER = true;
    const bf16_t* A; const bf16_t* Bt; int K; size_t estride; const PG8_LAS unsigned* gtab;
    __device__ __forceinline__ const char* a_tile(const Unit&) const { return (const char*)A; }
    __device__ __forceinline__ const char* a_base() const { return (const char*)A; }
    __device__ __forceinline__ unsigned a_off(int ui, const Unit&, int r, int C) const { return (unsigned)((gtab[ui * BM + r] * (unsigned)K + (unsigned)C) * 2u); }
    __device__ __forceinline__ const char* b_tile(const Unit& u) const { return (const char*)Bt + ((size_t)((u.pm >> 1) & 15) * estride + (size_t)u.pn * BM * K) * 2; }
};

template <class Prob, class Epi, class Sched, bool ALIGN_EPI>
__device__ __forceinline__ void gemm_phase(PG8_LAS unsigned char* lds, const Prob& g, const Sched& S, const Epi& E) {
    int tid_ = threadIdx.x; asm volatile("" : "+v"(tid_));
    const int tid = tid_, wid = __builtin_amdgcn_readfirstlane(tid >> 6), lane = tid & 63, wr = wid >> 2, wc = wid & 3, fr = lane & 15, fq = lane >> 4;
    const int K = g.K, nt = K / BK;
    int RA[2], CA[2]; unsigned voffB[2], voffA[2];
#pragma unroll
    for (int i = 0; i < 2; ++i) { int R, C; stage_rc(tid * 16 + i * 8192, R, C); RA[i] = R; CA[i] = C; voffA[i] = (unsigned)(R * K + C) * 2u; voffB[i] = (unsigned)(((R & ~31) + perm32(R & 31)) * K + C) * 2u; }
    constexpr bool GATHER = Prob::GATHER;
    const size_t kstep = (size_t)(BK * 2);
    const size_t hstep = (size_t)HALF * K * 2;
    const unsigned ldsw = (unsigned)wid * 1024u;
    const int aoff = lds_byte(wr * 64 + fr, fq * 8), boff = lds_byte(wc * 32 + fr, fq * 8);
#define PG8_SA(b, h) (((b) * 2 + (h)) * HTB)
#define PG8_SB(b, h) ((4 + (b) * 2 + (h)) * HTB)
#define PG8_STAGE_B(bufoff, gbase) do { _Pragma("unroll") for (int _i = 0; _i < 2; ++_i) \
        __builtin_amdgcn_global_load_lds((const unsigned*)((const char*)(gbase) + voffB[_i]), (PG8_LAS unsigned*)(lds + (bufoff) + ldsw + _i * 8192), 16, 0, 0); } while (0)
#define PG8_STAGE_A(bufoff, PT, kb, OFF, h) do { _Pragma("unroll") for (int _i = 0; _i < 2; ++_i) { \
        if constexpr (GATHER) __builtin_amdgcn_global_load_lds((const unsigned*)(Ab + (size_t)(kb) + (size_t)(OFF)[h][_i]), (PG8_LAS unsigned*)(lds + (bufoff) + ldsw + _i * 8192), 16, 0, 0); \
        else __builtin_amdgcn_global_load_lds((const unsigned*)((PT) + (size_t)(kb) + (size_t)(h) * hstep + voffA[_i]), (PG8_LAS unsigned*)(lds + (bufoff) + ldsw + _i * 8192), 16, 0, 0); } } while (0)
#define PG8_LDA(dst, b, h) do { _Pragma("unroll") for (int m = 0; m < 4; ++m) _Pragma("unroll") for (int k = 0; k < 2; ++k) dst[m][k] = *(const PG8_LAS bf16x8*)(lds + PG8_SA(b, h) + aoff + m * 2048 + k * 1024); } while (0)
#define PG8_LDB(dst, b, h) do { _Pragma("unroll") for (int n = 0; n < 2; ++n) _Pragma("unroll") for (int k = 0; k < 2; ++k) dst[n][k] = *(const PG8_LAS bf16x8*)(lds + PG8_SB(b, h) + boff + n * 2048 + k * 1024); } while (0)
#define PG8_MMA(ai, bj, At, Bt) do { __builtin_amdgcn_s_setprio(1); _Pragma("unroll") for (int m = 0; m < 4; ++m) _Pragma("unroll") for (int n = 0; n < 2; ++n) _Pragma("unroll") for (int k = 0; k < 2; ++k) \
        acc[ai][bj][m][n] = __builtin_amdgcn_mfma_f32_16x16x32_bf16(Bt[n][k], At[m][k], acc[ai][bj][m][n], 0, 0, 0); __builtin_amdgcn_s_setprio(0); } while (0)
#define PG8_WAIT_V(n) asm volatile("s_waitcnt vmcnt(" #n ")" ::: "memory")
#define PG8_WAIT_L(n) asm volatile("s_waitcnt lgkmcnt(" #n ")" ::: "memory")
#define PG8_BAR __builtin_amdgcn_s_barrier()
#define PG8_SCHED __builtin_amdgcn_sched_barrier(0)
    Unit cur, nxt; int ui = 0;
    if (!S.next(0, cur)) return;
    f32x4 acc[2][2][4][2];
#pragma unroll
    for (int a = 0; a < 2; ++a)
#pragma unroll
        for (int b = 0; b < 2; ++b)
#pragma unroll
            for (int m = 0; m < 4; ++m)
#pragma unroll
                for (int n = 0; n < 2; ++n) acc[a][b][m][n] = (f32x4){0.f, 0.f, 0.f, 0.f};
    bf16x8 At[4][2], B0[2][2], B1[2][2];
    unsigned aC[2][2], aN[2][2];
    if constexpr (GATHER) {
#pragma unroll
    for (int h = 0; h < 2; ++h)
#pragma unroll
        for (int i = 0; i < 2; ++i) aC[h][i] = g.a_off(0, cur, h * HALF + RA[i], CA[i]);
    }
    const char* const Ab = g.a_base(); const char* cB = g.b_tile(cur); const char* cA = g.a_tile(cur);
    PG8_STAGE_B(PG8_SB(0, 0), cB); PG8_STAGE_B(PG8_SB(0, 1), cB + hstep); PG8_STAGE_A(PG8_SA(0, 0), cA, 0, aC, 0); PG8_STAGE_A(PG8_SA(0, 1), cA, 0, aC, 1);
    if (wr == 1) PG8_BAR;
    PG8_WAIT_V(2); PG8_BAR;
    PG8_STAGE_B(PG8_SB(1, 0), cB + kstep); PG8_STAGE_A(PG8_SA(1, 0), cA, kstep, aC, 0); PG8_STAGE_B(PG8_SB(1, 1), cB + hstep + kstep);
    PG8_WAIT_V(6); PG8_BAR;
    for (;;) {
        const bool has_next = S.next(ui + 1, nxt);
        const char* nB = cB; const char* nA = cA;
        if (has_next) {
            if constexpr (GATHER) {
#pragma unroll
            for (int h = 0; h < 2; ++h)
#pragma unroll
                for (int i = 0; i < 2; ++i) aN[h][i] = g.a_off(ui + 1, nxt, h * HALF + RA[i], CA[i]);
            }
            nB = g.b_tile(nxt); nA = g.a_tile(nxt);
        } else {
            if constexpr (GATHER) {
#pragma unroll
            for (int h = 0; h < 2; ++h)
#pragma unroll
                for (int i = 0; i < 2; ++i) aN[h][i] = aC[h][i];
            }
        }
        for (int t = 0; t < nt; t += 2) {
            const bool last = (t == nt - 2);
            const size_t k1 = (size_t)(t + 1) * kstep;
            const size_t k2 = last ? (size_t)0 : (size_t)(t + 2) * kstep, k3 = k2 + kstep;
            const char* b2 = last ? nB : cB + (size_t)(t + 2) * kstep; const char* b3 = b2 + kstep;
            const char* a2p = last ? nA : cA;
            unsigned a2[2][2];
            if constexpr (GATHER) {
#pragma unroll
            for (int h = 0; h < 2; ++h)
#pragma unroll
                for (int i = 0; i < 2; ++i) a2[h][i] = last ? aN[h][i] : aC[h][i];
            }
            PG8_LDB(B0, 0, 0); PG8_LDB(B1, 0, 1); PG8_SCHED; PG8_LDA(At, 0, 0); PG8_STAGE_A(PG8_SA(1, 1), cA, k1, aC, 1);
            PG8_WAIT_V(8); PG8_WAIT_L(0); PG8_BAR; PG8_MMA(0, 0, At, B0); PG8_MMA(0, 1, At, B1); PG8_BAR; PG8_SCHED;
            PG8_LDA(At, 0, 1); PG8_STAGE_B(PG8_SB(0, 0), b2); PG8_STAGE_B(PG8_SB(0, 1), b2 + hstep); PG8_STAGE_A(PG8_SA(0, 0), a2p, k2, a2, 0);
            PG8_WAIT_V(8); PG8_WAIT_L(0); PG8_BAR; PG8_MMA(1, 0, At, B0); PG8_MMA(1, 1, At, B1); PG8_BAR; PG8_SCHED;
            PG8_LDB(B0, 1, 0); PG8_LDB(B1, 1, 1); PG8_SCHED; PG8_LDA(At, 1, 0); PG8_STAGE_A(PG8_SA(0, 1), a2p, k2, a2, 1);
            PG8_WAIT_V(8); PG8_WAIT_L(0); PG8_BAR; PG8_MMA(0, 0, At, B0); PG8_MMA(0, 1, At, B1); PG8_BAR; PG8_SCHED;
            PG8_LDA(At, 1, 1); PG8_STAGE_B(PG8_SB(1, 0), b3); PG8_STAGE_B(PG8_SB(1, 1), b3 + hstep); PG8_STAGE_A(PG8_SA(1, 0), a2p, k3, a2, 0);
            PG8_WAIT_V(8); PG8_WAIT_L(0); PG8_BAR; PG8_MMA(1, 0, At, B0); PG8_MMA(1, 1, At, B1); PG8_BAR; PG8_SCHED;
        }
        if constexpr (ALIGN_EPI) { if (wr == 0) PG8_BAR; }
        E(acc, cur, ui, wr, wc, fr, fq);
        if (!has_next) break;
#pragma unroll
        for (int a = 0; a < 2; ++a)
#pragma unroll
            for (int b = 0; b < 2; ++b)
#pragma unroll
                for (int m = 0; m < 4; ++m)
#pragma unroll
                    for (int n = 0; n < 2; ++n) acc[a][b][m][n] = (f32x4){0.f, 0.f, 0.f, 0.f};
        cur = nxt; cB = nB; cA = nA; ++ui;
        if constexpr (GATHER) {
#pragma unroll
        for (int h = 0; h < 2; ++h)
#pragma unroll
            for (int i = 0; i < 2; ++i) aC[h][i] = aN[h][i];
        }
        if constexpr (ALIGN_EPI) { if (wr == 1) PG8_BAR; }
    }
    PG8_WAIT_V(0);
    if constexpr (!ALIGN_EPI) { if (wr == 0) PG8_BAR; }
    PG8_BAR;
#undef PG8_SA
#undef PG8_SB
#undef PG8_STAGE_A
#undef PG8_STAGE_B
#undef PG8_LDA
#undef PG8_LDB
#undef PG8_MMA
#undef PG8_WAIT_V
#undef PG8_WAIT_L
#undef PG8_BAR
#undef PG8_SCHED
}
}
namespace att {
#define ATT_LAS __attribute__((address_space(3)))
#define ATT_GAS __attribute__((address_space(1)))
typedef unsigned short bf16;
using bf16x8 = __attribute__((ext_vector_type(8))) short;
using s16x4  = __attribute__((ext_vector_type(4))) short;
using f32x16 = __attribute__((ext_vector_type(16))) float;
using u32x4  = __attribute__((ext_vector_type(4))) unsigned;
constexpr int NW = 8, QBLK = 32, KVBLK = 64;
constexpr float THR = 8.f;
constexpr int SHM_V = 8192, KBUF = 13312, OFF_K = 3 * SHM_V, OFF_WS = OFF_K + 3 * KBUF, OFF_BT = OFF_WS + NW * 64 * 4, OFF_OST = OFF_BT + 8192, LDS_BYTES = OFF_OST + NW * 4608;
#define SBAR() __builtin_amdgcn_sched_barrier(0)
__device__ __forceinline__ int crow(int r, int hi) { return (r & 3) + 8 * (r >> 2) + 4 * hi; }
__device__ __forceinline__ unsigned cvtpk(float lo, float hi) { unsigned r; asm volatile("v_cvt_pk_bf16_f32 %0, %1, %2" : "=v"(r) : "v"(lo), "v"(hi)); return r; }
__device__ __forceinline__ int clampi(int v, int lo, int hi) { return v < lo ? lo : (v > hi ? hi : v); }

template <bool TWO>
__device__ __forceinline__ void partialSM(f32x16& p0, f32x16& p1, float& m_reg, f32x16& negm, f32x16& negm2, float& alpha, bool& have_ref) {
  float pmax = fmaxf(fmaxf(p0[0], p0[1]), p1[0]);
#pragma unroll
  for (int r = 2; r < 16; r += 2) pmax = fmaxf(fmaxf(pmax, p0[r]), p0[r + 1]);
#pragma unroll
  for (int r = 1; r < 15; r += 2) pmax = fmaxf(fmaxf(pmax, p1[r]), p1[r + 1]);
  pmax = fmaxf(pmax, p1[15]);
  { auto rr = __builtin_amdgcn_permlane32_swap(__float_as_uint(pmax), __float_as_uint(pmax), false, false);
    pmax = fmaxf(__uint_as_float(rr[0]), __uint_as_float(rr[1])); }
  alpha = 1.f;
  if (__builtin_expect(!have_ref || !__all(pmax <= THR), 0)) { const float dl = have_ref ? fmaxf(pmax, 0.f) : pmax; have_ref = true; m_reg += dl; alpha = __builtin_amdgcn_exp2f(-dl);
#pragma unroll
    for (int r = 0; r < 16; ++r) { p0[r] -= dl; p1[r] -= dl; }
#pragma unroll
    for (int r = 0; r < 16; ++r) negm[r] -= dl;
    asm volatile("" : "+v"(negm));
    if constexpr (TWO) {
#pragma unroll
      for (int r = 0; r < 16; ++r) negm2[r] -= dl;
      asm volatile("" : "+v"(negm2)); } }
#pragma unroll
  for (int r = 0; r < 16; ++r) p0[r] = __builtin_amdgcn_exp2f(p0[r]);
}
__device__ __forceinline__ float psm_max(const f32x16& p0, const f32x16& p1) {
  float pmax = fmaxf(fmaxf(p0[0], p0[1]), p1[0]);
#pragma unroll
  for (int r = 2; r < 16; r += 2) pmax = fmaxf(fmaxf(pmax, p0[r]), p0[r + 1]);
#pragma unroll
  for (int r = 1; r < 15; r += 2) pmax = fmaxf(fmaxf(pmax, p1[r]), p1[r + 1]);
  pmax = fmaxf(pmax, p1[15]);
  auto rr = __builtin_amdgcn_permlane32_swap(__float_as_uint(pmax), __float_as_uint(pmax), false, false);
  return fmaxf(__uint_as_float(rr[0]), __uint_as_float(rr[1]));
}
__device__ __forceinline__ void psm_decide(f32x16& p0, f32x16& p1, float pmax, float& m_reg, f32x16& negm, float& alpha, bool& have_ref) {
  alpha = 1.f;
  if (__builtin_expect(!have_ref || !__all(pmax <= THR), 0)) { const float dl = have_ref ? fmaxf(pmax, 0.f) : pmax; have_ref = true; m_reg += dl; alpha = __builtin_amdgcn_exp2f(-dl);
#pragma unroll
    for (int r = 0; r < 16; ++r) { p0[r] -= dl; p1[r] -= dl; }
#pragma unroll
    for (int r = 0; r < 16; ++r) negm[r] -= dl;
    asm volatile("" : "+v"(negm)); }
}
__device__ __forceinline__ void psm_exp(f32x16& p0) {
#pragma unroll
  for (int r = 0; r < 16; ++r) p0[r] = __builtin_amdgcn_exp2f(p0[r]);
}
__device__ __forceinline__ void finishSM(f32x16& p0, f32x16& p1, float alpha, float& l_reg, bf16x8& pa0, bf16x8& pa1, bf16x8& pa2, bf16x8& pa3) {
#pragma unroll
  for (int r = 0; r < 16; ++r) p1[r] = __builtin_amdgcn_exp2f(p1[r]);
  float ps;
  { typedef float f8 __attribute__((ext_vector_type(8))); typedef float f4 __attribute__((ext_vector_type(4))); typedef float f2 __attribute__((ext_vector_type(2)));
    const f32x16 t16 = p0 + p1; const f8 t8 = t16.lo + t16.hi; const f4 t4 = t8.lo + t8.hi; const f2 t2 = t4.lo + t4.hi; ps = t2.x + t2.y; }
  { auto rr = __builtin_amdgcn_permlane32_swap(__float_as_uint(ps), __float_as_uint(ps), false, false);
    ps = __uint_as_float(rr[0]) + __uint_as_float(rr[1]); }
  l_reg = l_reg * alpha + ps;
#define PK4(P, BASE, OUT) do { unsigned a0 = cvtpk(P[BASE + 0], P[BASE + 1]), a1 = cvtpk(P[BASE + 2], P[BASE + 3]);   \
    unsigned b0 = cvtpk(P[BASE + 4], P[BASE + 5]), b1 = cvtpk(P[BASE + 6], P[BASE + 7]);                              \
    auto r0 = __builtin_amdgcn_permlane32_swap(a0, b0, false, false); auto r1 = __builtin_amdgcn_permlane32_swap(a1, b1, false, false); \
    u32x4 w = {r0[0], r1[0], r0[1], r1[1]}; OUT = __builtin_bit_cast(bf16x8, w); } while (0)
  PK4(p0, 0, pa0); PK4(p0, 8, pa1); PK4(p1, 0, pa2); PK4(p1, 8, pa3);
#undef PK4
}
template <int DQK, int H> __device__ __forceinline__ void kload(bf16x8* kf, const ATT_LAS char* Ks, int r32, int hi) {
  constexpr int KST = DQK * 2 + 16, NH = DQK / 32;
#pragma unroll
  for (int i = 0; i < NH; ++i) { const int d0 = H * NH + i; const int cb = (d0 * 16 + hi * 8) * 2;
    kf[2 * i] = *(const ATT_LAS bf16x8*)(Ks + r32 * KST + cb);
    kf[2 * i + 1] = *(const ATT_LAS bf16x8*)(Ks + (32 + r32) * KST + cb); }
}
template <int DQK, int H> __device__ __forceinline__ void qk_mma(f32x16& p0, f32x16& p1, const bf16x8* kf, const bf16x8* qr, const f32x16& negm, const f32x16& negm2) {
  constexpr int NH = DQK / 32;
  if (H == 0) { p0 = negm; p1 = negm2; }
#pragma unroll
  for (int i = 0; i < NH; ++i) { const int d0 = H * NH + i;
    p0 = __builtin_amdgcn_mfma_f32_32x32x16_bf16(kf[2 * i], qr[d0], p0, 0, 0, 0);
    p1 = __builtin_amdgcn_mfma_f32_32x32x16_bf16(kf[2 * i + 1], qr[d0], p1, 0, 0, 0); }
}
__device__ __forceinline__ int v_st(int k, int c) { const int kk = (k & ~0xC) | ((k & 4) << 1) | ((k & 8) >> 1); return ((kk >> 3) * 2 + (c >> 5)) * 512 + ((kk & 7) * 32 + (c & 31)) * 2; }
__device__ __forceinline__ int v_rd_base(int lane) { return ((lane & 3) << 3) | (((lane >> 2) & 3) << 6) | (((lane >> 4) & 1) << 5) | (((lane >> 5) & 1) << 8); }
constexpr int v_rd_off(int d0, int ks, int half) { return d0 * 512 + ks * 2048 + half * 1024; }
typedef short v4i16_t __attribute__((ext_vector_type(4)));
__device__ __forceinline__ s16x4 vtr(const ATT_LAS char* p) { return __builtin_bit_cast(s16x4, __builtin_amdgcn_ds_read_tr16_b64_v4i16((ATT_LAS v4i16_t*)p)); }
__device__ __forceinline__ void vload(s16x4* vf, const ATT_LAS char* vp) {
#pragma unroll
  for (int d0 = 0; d0 < 2; ++d0)
#pragma unroll
    for (int ks = 0; ks < 4; ++ks) { vf[d0 * 8 + ks * 2] = vtr(vp + v_rd_off(d0, ks, 0)); vf[d0 * 8 + ks * 2 + 1] = vtr(vp + v_rd_off(d0, ks, 1)); }
}
template <int D0> __device__ __forceinline__ void pv_mma1(f32x16& od, const s16x4* vf, bf16x8 pa0, bf16x8 pa1, bf16x8 pa2, bf16x8 pa3) {
#define PKV(i) (bf16x8){vf[i][0], vf[i][1], vf[i][2], vf[i][3], vf[(i) + 1][0], vf[(i) + 1][1], vf[(i) + 1][2], vf[(i) + 1][3]}
  od = __builtin_amdgcn_mfma_f32_32x32x16_bf16(pa0, PKV(D0 * 8 + 0), od, 0, 0, 0);
  od = __builtin_amdgcn_mfma_f32_32x32x16_bf16(pa1, PKV(D0 * 8 + 2), od, 0, 0, 0);
  od = __builtin_amdgcn_mfma_f32_32x32x16_bf16(pa2, PKV(D0 * 8 + 4), od, 0, 0, 0);
  od = __builtin_amdgcn_mfma_f32_32x32x16_bf16(pa3, PKV(D0 * 8 + 6), od, 0, 0, 0);
#undef PKV
}
__device__ __forceinline__ void pv_mma(f32x16* o, const s16x4* vf, bf16x8 pa0, bf16x8 pa1, bf16x8 pa2, bf16x8 pa3) {
#define PKV(i) (bf16x8){vf[i][0], vf[i][1], vf[i][2], vf[i][3], vf[(i) + 1][0], vf[(i) + 1][1], vf[(i) + 1][2], vf[(i) + 1][3]}
#pragma unroll
  for (int d0 = 0; d0 < 2; ++d0) {
    o[d0] = __builtin_amdgcn_mfma_f32_32x32x16_bf16(pa0, PKV(d0 * 8 + 0), o[d0], 0, 0, 0);
    o[d0] = __builtin_amdgcn_mfma_f32_32x32x16_bf16(pa1, PKV(d0 * 8 + 2), o[d0], 0, 0, 0);
    o[d0] = __builtin_amdgcn_mfma_f32_32x32x16_bf16(pa2, PKV(d0 * 8 + 4), o[d0], 0, 0, 0);
    o[d0] = __builtin_amdgcn_mfma_f32_32x32x16_bf16(pa3, PKV(d0 * 8 + 6), o[d0], 0, 0, 0); }
#undef PKV
}

struct AttnIO { const ATT_GAS bf16* q; const ATT_GAS bf16* k; const ATT_GAS bf16* k2; const ATT_GAS bf16* v; ATT_GAS bf16* o; int ldq, ldk, ldk2, ldv, ldo; };

__device__ __forceinline__ bool mla_fixed_ref(const AttnIO io, float km2, float& mrow) {
  int tid_ = threadIdx.x; asm volatile("" : "+v"(tid_));
  const int wid = __builtin_amdgcn_readfirstlane(tid_ >> 6), lane = tid_ & 63, r32 = lane & 31, hi = lane >> 5;
  const ATT_GAS bf16* Qw = io.q + (size_t)(wid * QBLK + r32) * io.ldq + hi * 8; float q2 = 0.f;
#pragma unroll
  for (int d0 = 0; d0 < 6; ++d0) { const bf16x8 v = *(const ATT_GAS bf16x8*)(Qw + d0 * 16);
#pragma unroll
    for (int e = 0; e < 8; ++e) { const float x = __uint_as_float((unsigned)(unsigned short)v[e] << 16); q2 += x * x; } }
  { auto rr = __builtin_amdgcn_permlane32_swap(__float_as_uint(q2), __float_as_uint(q2), false, false); q2 = __uint_as_float(rr[0]) + __uint_as_float(rr[1]); }
  mrow = sqrtf(q2 * km2) * 1.02f;
  return __all(mrow <= 64.f);
}
template <int MODE, bool FIXED = false>
__device__ __forceinline__ void attn_unit(const AttnIO io, const int par, const float sinkl2, const ATT_GAS float* rpb_h, ATT_LAS char* lds) {
  constexpr int DQK = (MODE == 0) ? 96 : 64, ND0 = DQK / 16, KST = DQK * 2 + 16;
  int tid_ = threadIdx.x; asm volatile("" : "+v"(tid_));
  const int tid = tid_, wid = __builtin_amdgcn_readfirstlane(tid >> 6), lane = tid & 63, r32 = lane & 31, hi = lane >> 5;
  ATT_LAS char* V_lds = lds; ATT_LAS char* K_lds = lds + OFF_K;
  ATT_LAS float* ws = (ATT_LAS float*)(lds + OFF_WS) + wid * 64; ATT_LAS float* li_l = ws; ATT_LAS float* al_l = ws + 32;
  ATT_LAS float* btab = (ATT_LAS float*)(lds + OFF_BT);
  int NT, t0, r0w = 0, rq = 0;
  if constexpr (MODE == 0) { NT = 64; t0 = 0; }
  else if constexpr (MODE == 1) { const int rq0 = 4 * par; const int klo = clampi(rq0 - 4, 0, 56), khi = clampi(rq0 - 1, 0, 56) + 7; NT = (khi - klo + 2) & ~1; t0 = klo;
    rq = rq0 + (wid >> 1); r0w = clampi(rq - 4, 0, 56);
    for (int i = tid; i < 15 * 128; i += 512) { const int dc = (i & 127) - 63; btab[i] = (dc >= -15 && dc <= 15) ? rpb_h[(i >> 7) * 31 + dc + 15] * 1.4426950408889634f : 0.f; } }
  else { NT = 8; t0 = 4 * par - 2; }
#define ACTIVE(j) ((MODE == 0) ? true : (MODE == 1) ? (((t0 + (j)) >= r0w) && ((t0 + (j)) < r0w + 8)) : \
                   (((t0 + (j)) >= 0) && ((t0 + (j)) <= 63) && (64 * (j) + 63 >= 32 * wid) && (64 * (j) <= 32 * wid + 287)))
  float m_reg = (MODE == 2) ? sinkl2 : 0.f, l_reg = (MODE == 2) ? 1.f : 0.f; f32x16 o[2] = {}; bf16x8 qr[ND0];
  { const ATT_GAS bf16* Qw = io.q + (size_t)(wid * QBLK + r32) * io.ldq + hi * 8;
#pragma unroll
    for (int d0 = 0; d0 < ND0; ++d0) qr[d0] = *(const ATT_GAS bf16x8*)(Qw + d0 * 16); }
  constexpr bool fixed = FIXED;
  if constexpr (FIXED) m_reg = sinkl2;
  f32x16 negm;
#pragma unroll
  for (int r = 0; r < 16; ++r) negm[r] = -m_reg;
  f32x16 negm2v;
  if constexpr (MODE == 1) { const int qc_ = 32 * (wid & 1) + r32; const int c0_ = clampi(qc_ - 8, 0, 48);
#pragma unroll
    for (int r = 0; r < 16; ++r) { const int ka_ = crow(r, hi), kb_ = ka_ + 32; negm2v[r] = ((kb_ >= c0_) && (kb_ < c0_ + 16)) ? 0.f : -1e30f; negm[r] = ((ka_ >= c0_) && (ka_ < c0_ + 16)) ? 0.f : -1e30f; }
    asm volatile("" : "+v"(negm2v)); }
  asm volatile("" : "+v"(negm));
#define NEGM2 (*((MODE == 1) ? &negm2v : &negm))
  const int sr = tid >> 3, sc = (tid & 7) * 8, vst0 = v_st(sr, sc), kst0 = sr * KST + sc * 2;
  const int sr2 = (tid & 255) >> 2, sc2 = (tid & 3) * 8, kst2 = sr2 * KST + (64 + sc2) * 2;
  const ATT_LAS char* vb0 = V_lds + v_rd_base(lane);
  bf16x8 st_v, st_k, st_k2;
#define TOK(j) (64 * clampi(t0 + (j), 0, 63))
#define SLOAD(j) do { const int tk_ = TOK(j); st_v = *(const ATT_GAS bf16x8*)(io.v + (size_t)(tk_ + sr) * io.ldv + sc); \
    st_k = *(const ATT_GAS bf16x8*)(io.k + (size_t)(tk_ + sr) * io.ldk + sc); \
    if constexpr (MODE == 0) { if (wid < 4) st_k2 = *(const ATT_GAS bf16x8*)(io.k2 + (size_t)(tk_ + sr2) * io.ldk2 + sc2); } } while (0)
#define SWRITE(b) do { *(ATT_LAS bf16x8*)(V_lds + (b) * SHM_V + vst0) = st_v; *(ATT_LAS bf16x8*)(K_lds + (b) * KBUF + kst0) = st_k; \
    if constexpr (MODE == 0) { if (wid < 4) *(ATT_LAS bf16x8*)(K_lds + (b) * KBUF + kst2) = st_k2; } } while (0)
#define RESC(a) do { if (__any((a) < 1.f)) { if (hi == 0) al_l[r32] = (a); asm volatile("s_waitcnt lgkmcnt(0)" ::: "memory"); \
    _Pragma("unroll") for (int d = 0; d < 2; ++d) _Pragma("unroll") for (int r = 0; r < 16; ++r) o[d][r] *= al_l[crow(r, hi)]; } } while (0)
#define MASK(P0, P1, j) do { \
    if constexpr (MODE == 1) { const ATT_LAS float* bt_ = btab + ((t0 + (j)) - rq + 7) * 128 + (4 * hi - (32 * (wid & 1) + r32) + 63); \
      _Pragma("unroll") for (int r = 0; r < 16; ++r) { P0[r] += bt_[(r & 3) + 8 * (r >> 2)]; P1[r] += bt_[(r & 3) + 8 * (r >> 2) + 32]; } } \
    else if constexpr (MODE == 2) { if (!((64 * (j) - 32 * wid - 31 >= 0) && (64 * (j) - 32 * wid <= 193))) { const int rel_ = 64 * (j) - 128 - 32 * wid - r32; \
      _Pragma("unroll") for (int r = 0; r < 16; ++r) { const int da_ = rel_ + crow(r, hi), db_ = da_ + 32; \
        P0[r] = (da_ >= -128 && da_ <= 128) ? P0[r] : -1e30f; P1[r] = (db_ >= -128 && db_ <= 128) ? P1[r] : -1e30f; } } } } while (0)
  f32x16 pA0, pA1, pB0, pB1; float alA = 1.f, alB = 1.f; bf16x8 pa0, pa1, pa2, pa3;
  bool actA = false, actB = false, have_ref = (MODE == 2) || fixed;
  int bc = 0, bp = 2, bn = 1;
#define ROT() do { const int t_ = bp; bp = bc; bc = bn; bn = t_; } while (0)
#define QKALL(P0, P1, Kp) do { bf16x8 kf0_[ND0], kf1_[ND0]; kload<DQK, 0>(kf0_, Kp, r32, hi); kload<DQK, 1>(kf1_, Kp, r32, hi); SBAR(); \
      qk_mma<DQK, 0>(P0, P1, kf0_, qr, negm, NEGM2); qk_mma<DQK, 1>(P0, P1, kf1_, qr, negm, NEGM2); } while (0)
#define SGB(mask, n) __builtin_amdgcn_sched_group_barrier(mask, n, 0)
#define STEP(PX0, PX1, alX, actX, PY0, PY1, alY, actY, j) do { \
    if ((j) + 1 < NT) SWRITE(bn); \
    if ((j) + 2 < NT) SLOAD((j) + 2); \
    actX = ACTIVE(j); \
    const ATT_LAS char* Kc_ = K_lds + bc * KBUF; const ATT_LAS char* vp_ = vb0 + bp * SHM_V; \
    SBAR(); \
    if constexpr (MODE == 0) { \
        \
      { bf16x8 kf0_[ND0], kf1_[ND0]; kload<DQK, 0>(kf0_, Kc_, r32, hi); kload<DQK, 1>(kf1_, Kc_, r32, hi); \
        qk_mma<DQK, 0>(PX0, PX1, kf0_, qr, negm, negm); qk_mma<DQK, 1>(PX0, PX1, kf1_, qr, negm, negm); \
        finishSM(PY0, PY1, alY, l_reg, pa0, pa1, pa2, pa3); \
        SGB(0x100, 12); \
        _Pragma("unroll") for (int g_ = 0; g_ < 12; ++g_) { SGB(0x008, 1); SGB(0x402, 6); } } \
      SBAR(); \
      { s16x4 vf_[16]; vload(vf_, vp_); \
        pv_mma1<0>(o[0], vf_, pa0, pa1, pa2, pa3); \
        const float pm_ = psm_max(PX0, PX1); \
        SGB(0x100, 16); \
        _Pragma("unroll") for (int g_ = 0; g_ < 4; ++g_) { SGB(0x008, 1); SGB(0x402, 10); } \
        SBAR(); \
        psm_decide(PX0, PX1, pm_, m_reg, negm, alX, have_ref); \
        SBAR(); \
        pv_mma1<1>(o[1], vf_, pa0, pa1, pa2, pa3); \
        psm_exp(PX0); \
        _Pragma("unroll") for (int g_ = 0; g_ < 4; ++g_) { SGB(0x008, 1); SGB(0x402, 4); } } \
      SBAR(); \
      RESC(alX); \
    } else { \
      if (actX) { QKALL(PX0, PX1, Kc_); MASK(PX0, PX1, j); } SBAR(); \
      if (actY) { s16x4 vf_[16]; vload(vf_, vp_); SBAR(); finishSM(PY0, PY1, alY, l_reg, pa0, pa1, pa2, pa3); SBAR(); pv_mma(o, vf_, pa0, pa1, pa2, pa3); } SBAR(); \
      if (actX) { partialSM<MODE == 1>(PX0, PX1, m_reg, negm, NEGM2, alX, have_ref); RESC(alX); } \
    } \
    ROT(); \
    __syncthreads(); } while (0)
#define STEPF(PX0, PX1, PY0, PY1, j) do { \
    if ((j) + 1 < NT) SWRITE(bn); \
    if ((j) + 2 < NT) SLOAD((j) + 2); \
    const ATT_LAS char* Kc_ = K_lds + bc * KBUF; const ATT_LAS char* vp_ = vb0 + bp * SHM_V; \
    SBAR(); \
    { bf16x8 kf0_[ND0], kf1_[ND0]; kload<DQK, 0>(kf0_, Kc_, r32, hi); kload<DQK, 1>(kf1_, Kc_, r32, hi); \
      qk_mma<DQK, 0>(PX0, PX1, kf0_, qr, negm, negm); qk_mma<DQK, 1>(PX0, PX1, kf1_, qr, negm, negm); \
      finishSM(PY0, PY1, 1.f, l_reg, pa0, pa1, pa2, pa3); \
      SGB(0x100, 12); \
      _Pragma("unroll") for (int g_ = 0; g_ < 12; ++g_) { SGB(0x008, 1); SGB(0x402, 6); } } \
    SBAR(); \
    { s16x4 vf_[16]; vload(vf_, vp_); \
      pv_mma(o, vf_, pa0, pa1, pa2, pa3); \
      psm_exp(PX0); \
      SGB(0x100, 16); \
      _Pragma("unroll") for (int g_ = 0; g_ < 8; ++g_) { SGB(0x008, 1); SGB(0x402, 2); } } \
    SBAR(); \
    ROT(); \
    __syncthreads(); } while (0)
  SLOAD(0); SWRITE(0); SLOAD(1); __syncthreads();
  actA = ACTIVE(0);
  SWRITE(1); if (2 < NT) SLOAD(2);
  if (actA) { QKALL(pA0, pA1, K_lds); MASK(pA0, pA1, 0); if (MODE == 0 && fixed) psm_exp(pA0); else partialSM<MODE == 1>(pA0, pA1, m_reg, negm, NEGM2, alA, have_ref); }
  ROT(); __syncthreads();
  if constexpr (MODE == 0 && FIXED) {
    actB = true;
    for (int j = 1; j + 1 < NT; j += 2) {
      STEPF(pB0, pB1, pA0, pA1, j);
      STEPF(pA0, pA1, pB0, pB1, j + 1);
    }
    STEPF(pB0, pB1, pA0, pA1, NT - 1);
  } else {
  for (int j = 1; j + 1 < NT; j += 2) {
    STEP(pB0, pB1, alB, actB, pA0, pA1, alA, actA, j);
    STEP(pA0, pA1, alA, actA, pB0, pB1, alB, actB, j + 1);
  }
  STEP(pB0, pB1, alB, actB, pA0, pA1, alA, actA, NT - 1);
  }
  if (actB) { s16x4 vf_[16]; vload(vf_, vb0 + bp * SHM_V); finishSM(pB0, pB1, alB, l_reg, pa0, pa1, pa2, pa3); SBAR(); pv_mma(o, vf_, pa0, pa1, pa2, pa3); }
#undef STEP
#undef STEPF
#undef SGB
#undef QKALL
#undef NEGM2
#undef ROT
  if (hi == 0) li_l[r32] = l_reg; asm volatile("s_waitcnt lgkmcnt(0)" ::: "memory");
  float rli[16];
#pragma unroll
  for (int r = 0; r < 16; ++r) rli[r] = __builtin_amdgcn_rcpf(li_l[crow(r, hi)]);
  ATT_GAS bf16* Ow = io.o + (size_t)(wid * QBLK) * io.ldo;
  { ATT_LAS char* stg = lds + OFF_OST + wid * 4608;
#pragma unroll
    for (int r = 0; r < 16; ++r) { const int orow = crow(r, hi);
#pragma unroll
      for (int d0 = 0; d0 < 2; ++d0) { const float val = o[d0][r] * rli[r]; *(ATT_LAS bf16*)(stg + orow * 144 + (d0 * 32 + r32) * 2) = (bf16)(cvtpk(val, val) & 0xffffu); } }
    asm volatile("s_waitcnt lgkmcnt(0)" ::: "memory");
#pragma unroll
    for (int i = 0; i < 4; ++i) { const int row = i * 8 + (lane >> 3), ch = lane & 7; const u32x4 v = *(const ATT_LAS u32x4*)(stg + row * 144 + ch * 16); *(ATT_GAS u32x4*)(Ow + (size_t)row * io.ldo + ch * 8) = v; } }
  __syncthreads();
#undef ACTIVE
#undef TOK
#undef SLOAD
#undef SWRITE
#undef RESC
#undef MASK
}

constexpr int K16B = 12288, V16B = 10240, V16ST = 160, OFF16_V = 3 * K16B, OFF16_WS = OFF16_V + 3 * V16B, OFF16_OST = OFF16_WS + NW * 256, OFF_FLAG = 122880;
static_assert(OFF16_OST + NW * 4608 <= OFF_FLAG && LDS_BYTES <= OFF_FLAG, "attention LDS map");
__device__ __forceinline__ int fkey(int k) { return (4 - ((k >> 2) & 3)) & 3; }
template <int NQB>
__device__ __forceinline__ void attn_unit16(const AttnIO io, const int role, ATT_LAS char* lds) {
  typedef float f32x4 __attribute__((ext_vector_type(4)));
  int tid_ = threadIdx.x; asm volatile("" : "+v"(tid_));
  const int tid = tid_, wid = __builtin_amdgcn_readfirstlane(tid >> 6), lane = tid & 63, c = lane & 15, g = lane >> 4;
  ATT_LAS char* K_lds = lds; ATT_LAS char* V_lds = lds + OFF16_V;
  ATT_LAS float* li_l = (ATT_LAS float*)(lds + OFF16_WS) + wid * 64;
  constexpr int NT = 64, WQ = 16 * NQB;
  bf16x8 qf[NQB][3];
  { const ATT_GAS bf16* Qw = io.q + (size_t)(wid * WQ + c) * io.ldq + g * 8;
#pragma unroll
    for (int qb = 0; qb < NQB; ++qb)
#pragma unroll
      for (int ks = 0; ks < 3; ++ks) qf[qb][ks] = *(const ATT_GAS bf16x8*)(Qw + (size_t)(16 * qb) * io.ldq + ks * 32); }
  const int gch = (lane & 3) ^ ((4 - g) & 3);
  const unsigned koff = (unsigned)((16 * (wid & 3) + (lane >> 2)) * io.ldk + 32 * (wid >> 2) + 8 * gch) * 2u;
  const unsigned k2off = (unsigned)((16 * (wid & 3) + (lane >> 2)) * io.ldk2 + 8 * gch) * 2u;
  const int vsA = 64 * ((wid + 4) & 7) + lane, vsB = 64 * ((wid < 4 ? wid : wid + 4) + (wid < 4 ? 4 : 0)) + lane;
  const unsigned voffA = (unsigned)((vsA / 10) * io.ldv + 8 * ((vsA % 10) > 7 ? 7 : (vsA % 10))) * 2u, voffB = (unsigned)((vsB / 10) * io.ldv + 8 * ((vsB % 10) > 7 ? 7 : (vsB % 10))) * 2u;
  const ATT_LAS char* kb0 = K_lds + c * 64 + ((g ^ fkey(c)) * 16);
  const ATT_LAS char* vb0 = V_lds + (4 * g + ((lane >> 2) & 3)) * V16ST + (lane & 3) * 8;
#define DMA16(src, dst) do { const ATT_GAS char* s_ = (const ATT_GAS char*)(src); const unsigned d_ = (unsigned)__builtin_amdgcn_readfirstlane((int)(unsigned)(size_t)(dst)); \
    asm volatile("s_mov_b32 m0, %1\n\ts_nop 0\n\tglobal_load_lds_dwordx4 %0, off" :: "v"(s_), "s"(d_) : "memory", "m0"); } while (0)
#define STAGEK(j, b) do { DMA16((const ATT_GAS char*)(io.k + (size_t)(64 * (j)) * io.ldk) + koff, K_lds + (b) * K16B + wid * 1024); \
    if (wid < 4) DMA16((const ATT_GAS char*)(io.k2 + (size_t)(64 * (j)) * io.ldk2) + k2off, K_lds + (b) * K16B + (8 + wid) * 1024); } while (0)
#define STAGEV(j, b) do { DMA16((const ATT_GAS char*)(io.v + (size_t)(64 * (j)) * io.ldv) + voffA, V_lds + (b) * V16B + ((wid + 4) & 7) * 1024); \
    if (wid == 4 || wid == 5) DMA16((const ATT_GAS char*)(io.v + (size_t)(64 * (j)) * io.ldv) + voffB, V_lds + (b) * V16B + (wid + 4) * 1024); } while (0)
#define BAR16() do { asm volatile("s_waitcnt lgkmcnt(0)" ::: "memory"); __builtin_amdgcn_s_barrier(); asm volatile("" ::: "memory"); } while (0)
#define BAR16V() do { asm volatile("s_waitcnt vmcnt(0) lgkmcnt(0)" ::: "memory"); __builtin_amdgcn_s_barrier(); asm volatile("" ::: "memory"); } while (0)
#define KREAD(KF, Kc, ks, kp) do { _Pragma("unroll") for (int kb_ = 0; kb_ < 2; ++kb_) KF[kb_] = *(const ATT_LAS bf16x8*)((Kc) + (ks) * 4096 + (2 * (kp) + kb_) * 1024); } while (0)
#define VREAD(VF, Vc, s, dp) do { _Pragma("unroll") for (int db_ = 0; db_ < 2; ++db_) { const s16x4 lo_ = vtr((Vc) + (s) * 32 * V16ST + (2 * (dp) + db_) * 32), hi_ = vtr((Vc) + ((s) * 32 + 16) * V16ST + (2 * (dp) + db_) * 32); \
      VF[db_] = (bf16x8){lo_[0], lo_[1], lo_[2], lo_[3], hi_[0], hi_[1], hi_[2], hi_[3]}; } } while (0)
#define QKMMA(KF, ks, kp) do { _Pragma("unroll") for (int kb_ = 0; kb_ < 2; ++kb_) _Pragma("unroll") for (int qb_ = 0; qb_ < NQB; ++qb_) \
      S[2 * (kp) + kb_][qb_] = __builtin_amdgcn_mfma_f32_16x16x32_bf16(KF[kb_], qf[qb_][ks], ((ks) == 0) ? (f32x4){0.f, 0.f, 0.f, 0.f} : S[2 * (kp) + kb_][qb_], 0, 0, 0); } while (0)
#define PVMMA(VF, s, dp) do { _Pragma("unroll") for (int db_ = 0; db_ < 2; ++db_) _Pragma("unroll") for (int qb_ = 0; qb_ < NQB; ++qb_) \
      o[qb_][2 * (dp) + db_] = __builtin_amdgcn_mfma_f32_16x16x32_bf16(pa[qb_][s], VF[db_], o[qb_][2 * (dp) + db_], 0, 0, 0); } while (0)
#define QKALL16(Kc, KFA, KFB) do { KREAD(KFB, Kc, 1, 0); QKMMA(KFA, 0, 0); SBAR(); KREAD(KFA, Kc, 2, 0); QKMMA(KFB, 1, 0); SBAR(); KREAD(KFB, Kc, 0, 1); QKMMA(KFA, 2, 0); SBAR(); \
      KREAD(KFA, Kc, 1, 1); QKMMA(KFB, 0, 1); SBAR(); KREAD(KFB, Kc, 2, 1); QKMMA(KFA, 1, 1); SBAR(); QKMMA(KFB, 2, 1); } while (0)
  f32x4 o[NQB][4];
#pragma unroll
  for (int qb = 0; qb < NQB; ++qb)
#pragma unroll
    for (int db = 0; db < 4; ++db) o[qb][db] = (f32x4){0.f, 0.f, 0.f, 0.f};
  f32x4 lacc[NQB];
#pragma unroll
  for (int qb = 0; qb < NQB; ++qb) lacc[qb] = (f32x4){0.f, 0.f, 0.f, 0.f};
  bf16x8 ones8; { const u32x4 w1 = {0x3F803F80u, 0x3F803F80u, 0x3F803F80u, 0x3F803F80u}; ones8 = __builtin_bit_cast(bf16x8, w1); asm volatile("" : "+v"(ones8)); }
  f32x4 S[4][NQB];
  STAGEK(0, 0); STAGEV(0, 0); STAGEK(1, 1);
  asm volatile("s_waitcnt vmcnt(0)" ::: "memory"); __syncthreads();
  { bf16x8 kfA[2], kfB[2]; KREAD(kfA, kb0, 0, 0); QKALL16(kb0, kfA, kfB); }
  if (role) BAR16();
  int i0 = 0, i1 = 1, i2 = 2;
  for (int t = 0; t < NT; ++t) {
    if (t + 2 < NT) STAGEK(t + 2, i2);
    if (t + 1 < NT) STAGEV(t + 1, i1);
    const ATT_LAS char* Vc = vb0 + i0 * V16B; const ATT_LAS char* Kc = kb0 + i1 * K16B;
    bf16x8 vfA[2], vfB[2];
    bf16x8 pa[NQB][2];
#pragma unroll
    for (int qb = 0; qb < NQB; ++qb) {
#pragma unroll
      for (int kb = 0; kb < 4; ++kb)
#pragma unroll
        for (int r = 0; r < 4; ++r) S[kb][qb][r] = __builtin_amdgcn_exp2f(S[kb][qb][r]);
#pragma unroll
      for (int s = 0; s < 2; ++s) { const u32x4 w = {cvtpk(S[2 * s][qb][0], S[2 * s][qb][1]), cvtpk(S[2 * s][qb][2], S[2 * s][qb][3]),
                                                     cvtpk(S[2 * s + 1][qb][0], S[2 * s + 1][qb][1]), cvtpk(S[2 * s + 1][qb][2], S[2 * s + 1][qb][3])};
        pa[qb][s] = __builtin_bit_cast(bf16x8, w); }
      SBAR();
      if (qb == NQB / 2 - 1) { VREAD(vfA, Vc, 0, 0); SBAR(); } }
    BAR16V();
    { bf16x8 fC[2];
#define ONES16() do { _Pragma("unroll") for (int s_ = 0; s_ < 2; ++s_) _Pragma("unroll") for (int qb_ = 0; qb_ < NQB; ++qb_) lacc[qb_] = __builtin_amdgcn_mfma_f32_16x16x32_bf16(pa[qb_][s_], ones8, lacc[qb_], 0, 0, 0); } while (0)
      const bool nx = (t + 1 < NT);
      VREAD(vfB, Vc, 0, 1); VREAD(fC, Vc, 1, 0); SBAR();
      PVMMA(vfA, 0, 0); SBAR(); VREAD(vfA, Vc, 1, 1); SBAR();
      PVMMA(vfB, 0, 1); SBAR(); if (nx) KREAD(vfB, Kc, 0, 0); SBAR();
      PVMMA(fC, 1, 0); SBAR(); if (nx) KREAD(fC, Kc, 1, 0); SBAR();
      PVMMA(vfA, 1, 1); SBAR(); if (nx) KREAD(vfA, Kc, 2, 0); SBAR();
      ONES16(); SBAR();
      if (nx) {
        QKMMA(vfB, 0, 0); SBAR(); KREAD(vfB, Kc, 0, 1); SBAR();
        QKMMA(fC, 1, 0); SBAR(); KREAD(fC, Kc, 1, 1); SBAR();
        QKMMA(vfA, 2, 0); SBAR(); KREAD(vfA, Kc, 2, 1); SBAR();
        QKMMA(vfB, 0, 1); SBAR(); QKMMA(fC, 1, 1); SBAR(); QKMMA(vfA, 2, 1); }
#undef ONES16
    }
    BAR16();
    { const int t_ = i0; i0 = i1; i1 = i2; i2 = t_; }
  }
  if (!role) BAR16();
#undef STAGEK
#undef STAGEV
#undef DMA16
#undef KREAD
#undef VREAD
#undef QKMMA
#undef PVMMA
#undef QKALL16
  ATT_GAS bf16* Ow = io.o + (size_t)(wid * WQ) * io.ldo;
  { ATT_LAS char* stg = lds + OFF16_OST + wid * 4608;
#pragma unroll
    for (int hp = 0; hp < NQB / 2; ++hp) {
#pragma unroll
      for (int q2 = 0; q2 < 2; ++q2)
#pragma unroll
        for (int r = 0; r < 4; ++r) { const int qb = 2 * hp + q2, orow = 16 * q2 + 4 * g + r; const float rl = __builtin_amdgcn_rcpf(lacc[qb][r]);
#pragma unroll
          for (int db = 0; db < 4; ++db) { const float val = o[qb][db][r] * rl; *(ATT_LAS bf16*)(stg + orow * 144 + (db * 16 + c) * 2) = (bf16)(cvtpk(val, val) & 0xffffu); } }
      asm volatile("s_waitcnt lgkmcnt(0)" ::: "memory");
#pragma unroll
      for (int i = 0; i < 4; ++i) { const int row = i * 8 + (lane >> 3), ch = lane & 7; const u32x4 v = *(const ATT_LAS u32x4*)(stg + row * 144 + ch * 16); *(ATT_GAS u32x4*)(Ow + (size_t)(32 * hp + row) * io.ldo + ch * 8) = v; }
      asm volatile("s_waitcnt lgkmcnt(0)" ::: "memory"); } }
#undef BAR16
#undef BAR16V
  __syncthreads();
}
constexpr int SWW_LDS = 10240 + 256;
__device__ __forceinline__ void swa_wave_task(const ATT_GAS bf16* qp, const ATT_GAS bf16* kp, const ATT_GAS bf16* vp, ATT_GAS bf16* op, const int q0, const float sinkl2, ATT_LAS char* wl) {
  typedef float f32x4 __attribute__((ext_vector_type(4)));
  int tid_ = threadIdx.x; asm volatile("" : "+v"(tid_));
  const int lane = tid_ & 63, c = lane & 15, g = lane >> 4;
  ATT_LAS float* al = (ATT_LAS float*)(wl + 10240);
  bf16x8 qf[2][2];
#pragma unroll
  for (int qb = 0; qb < 2; ++qb)
#pragma unroll
    for (int ks = 0; ks < 2; ++ks) qf[qb][ks] = *(const ATT_GAS bf16x8*)(qp + (size_t)(q0 + 16 * qb + c) * 256 + 32 * ks + 8 * g);
  f32x4 o[2][4], lacc[2], negm[2]; float m[2];
#pragma unroll
  for (int qb = 0; qb < 2; ++qb) { m[qb] = sinkl2; negm[qb] = (f32x4){-sinkl2, -sinkl2, -sinkl2, -sinkl2}; lacc[qb] = (f32x4){1.f, 1.f, 1.f, 1.f};
#pragma unroll
    for (int db = 0; db < 4; ++db) o[qb][db] = (f32x4){0.f, 0.f, 0.f, 0.f}; }
  bf16x8 ones8; { const u32x4 w1 = {0x3F803F80u, 0x3F803F80u, 0x3F803F80u, 0x3F803F80u}; ones8 = __builtin_bit_cast(bf16x8, w1); }
  const int jt = q0 >> 6, tlo = (jt - 2 < 0) ? 0 : jt - 2, thi = (jt + 2 > 63) ? 63 : jt + 2;
  const ATT_GAS bf16* kl = kp + (size_t)c * 128 + 8 * g;
  const ATT_GAS bf16* vl = vp + (size_t)(lane >> 3) * 128 + (lane & 7) * 8;
  ATT_LAS char* vw = wl + (lane >> 3) * V16ST + (lane & 7) * 16;
  const ATT_LAS char* vb0 = wl + (4 * g + ((lane >> 2) & 3)) * V16ST + (lane & 3) * 8;
  bf16x8 kf[4][2], vs[8];
#define SW_KLOAD(t) do { _Pragma("unroll") for (int kb_ = 0; kb_ < 4; ++kb_) _Pragma("unroll") for (int ks_ = 0; ks_ < 2; ++ks_) \
    kf[kb_][ks_] = *(const ATT_GAS bf16x8*)(kl + (size_t)(64 * (t) + 16 * kb_) * 128 + 32 * ks_); } while (0)
#define SW_VLOAD(t) do { _Pragma("unroll") for (int i_ = 0; i_ < 8; ++i_) vs[i_] = *(const ATT_GAS bf16x8*)(vl + (size_t)(64 * (t) + 8 * i_) * 128); } while (0)
  SW_KLOAD(tlo); SW_VLOAD(tlo);
  for (int t = tlo; t <= thi; ++t) {
    f32x4 S[4][2];
#pragma unroll
    for (int kb = 0; kb < 4; ++kb)
#pragma unroll
      for (int qb = 0; qb < 2; ++qb) { S[kb][qb] = __builtin_amdgcn_mfma_f32_16x16x32_bf16(kf[kb][0], qf[qb][0], negm[qb], 0, 0, 0);
        S[kb][qb] = __builtin_amdgcn_mfma_f32_16x16x32_bf16(kf[kb][1], qf[qb][1], S[kb][qb], 0, 0, 0); }
    if (t < thi) SW_KLOAD(t + 1);
    if (t == jt - 2 || t == jt + 2) {
      const int d0 = 64 * t + 4 * g - q0 - c;
#pragma unroll
      for (int kb = 0; kb < 4; ++kb)
#pragma unroll
        for (int qb = 0; qb < 2; ++qb)
#pragma unroll
          for (int r = 0; r < 4; ++r) { const int d = d0 + 16 * kb + r - 16 * qb; S[kb][qb][r] = (d >= -128 && d <= 128) ? S[kb][qb][r] : -1e30f; } }
    float pm[2];
#pragma unroll
    for (int qb = 0; qb < 2; ++qb) { float a = fmaxf(fmaxf(S[0][qb][0], S[0][qb][1]), S[0][qb][2]);
#pragma unroll
      for (int kb = 0; kb < 4; ++kb) { if (kb) a = fmaxf(fmaxf(a, S[kb][qb][0]), S[kb][qb][1]); a = fmaxf(fmaxf(a, S[kb][qb][kb ? 2 : 3]), S[kb][qb][3]); }
      pm[qb] = a; }
    if (__builtin_expect(__any(fmaxf(pm[0], pm[1]) > THR), 0)) {
#pragma unroll
      for (int qb = 0; qb < 2; ++qb) { float pmx = fmaxf(pm[qb], __shfl_xor(pm[qb], 16)); pmx = fmaxf(pmx, __shfl_xor(pmx, 32));
        const float dl = fmaxf(pmx, 0.f); m[qb] += dl; negm[qb] -= dl;
#pragma unroll
        for (int kb = 0; kb < 4; ++kb) S[kb][qb] -= dl;
        if (g == 0) al[16 * qb + c] = __builtin_amdgcn_exp2f(-dl); }
      asm volatile("s_waitcnt lgkmcnt(0)" ::: "memory");
#pragma unroll
      for (int qb = 0; qb < 2; ++qb)
#pragma unroll
        for (int r = 0; r < 4; ++r) { const float a = al[16 * qb + 4 * g + r]; lacc[qb][r] *= a;
#pragma unroll
          for (int db = 0; db < 4; ++db) o[qb][db][r] *= a; } }
    bf16x8 pa[2][2];
#pragma unroll
    for (int qb = 0; qb < 2; ++qb) {
#pragma unroll
      for (int kb = 0; kb < 4; ++kb)
#pragma unroll
        for (int r = 0; r < 4; ++r) S[kb][qb][r] = __builtin_amdgcn_exp2f(S[kb][qb][r]);
#pragma unroll
      for (int s2 = 0; s2 < 2; ++s2) { const u32x4 w = {cvtpk(S[2 * s2][qb][0], S[2 * s2][qb][1]), cvtpk(S[2 * s2][qb][2], S[2 * s2][qb][3]),
                                                       cvtpk(S[2 * s2 + 1][qb][0], S[2 * s2 + 1][qb][1]), cvtpk(S[2 * s2 + 1][qb][2], S[2 * s2 + 1][qb][3])};
        pa[qb][s2] = __builtin_bit_cast(bf16x8, w); } }
#pragma unroll
    for (int i = 0; i < 8; ++i) *(ATT_LAS bf16x8*)(vw + 8 * i * V16ST) = vs[i];
    if (t < thi) SW_VLOAD(t + 1);
#pragma unroll
    for (int s2 = 0; s2 < 2; ++s2) { bf16x8 vf[4];
#pragma unroll
      for (int db = 0; db < 4; ++db) { const s16x4 lo = vtr(vb0 + s2 * 32 * V16ST + db * 32), hi = vtr(vb0 + (s2 * 32 + 16) * V16ST + db * 32);
        vf[db] = (bf16x8){lo[0], lo[1], lo[2], lo[3], hi[0], hi[1], hi[2], hi[3]}; }
#pragma unroll
      for (int db = 0; db < 4; ++db)
#pragma unroll
        for (int qb = 0; qb < 2; ++qb) o[qb][db] = __builtin_amdgcn_mfma_f32_16x16x32_bf16(pa[qb][s2], vf[db], o[qb][db], 0, 0, 0);
#pragma unroll
      for (int qb = 0; qb < 2; ++qb) lacc[qb] = __builtin_amdgcn_mfma_f32_16x16x32_bf16(pa[qb][s2], ones8, lacc[qb], 0, 0, 0); }
  }
#undef SW_KLOAD
#undef SW_VLOAD
#pragma unroll
  for (int qb = 0; qb < 2; ++qb)
#pragma unroll
    for (int r = 0; r < 4; ++r) { const int orow = 16 * qb + 4 * g + r; const float rl = __builtin_amdgcn_rcpf(lacc[qb][r]);
#pragma unroll
      for (int db = 0; db < 4; ++db) { const float val = o[qb][db][r] * rl; *(ATT_LAS bf16*)(wl + orow * 144 + (db * 16 + c) * 2) = (bf16)(cvtpk(val, val) & 0xffffu); } }
  asm volatile("s_waitcnt lgkmcnt(0)" ::: "memory");
#pragma unroll
  for (int i = 0; i < 4; ++i) { const int row = i * 8 + (lane >> 3), ch = lane & 7; const u32x4 v = *(const ATT_LAS u32x4*)(wl + row * 144 + ch * 16); *(ATT_GAS u32x4*)(op + (size_t)(q0 + row) * 1024 + ch * 8) = v; }
  asm volatile("s_waitcnt lgkmcnt(0)" ::: "memory");
}
constexpr int SW_NB = 5, SWK_B = 8192, SWV_B = 10240, SW_OFFV = SW_NB * SWK_B, SW_OFFAL = SW_OFFV + SW_NB * SWV_B, SW_OFFO = 0;
static_assert(SW_OFFAL + NW * 256 <= 131072 && NW * 9216 <= SW_OFFAL, "SWA LDS map");
__device__ __forceinline__ void swa_unit(const ATT_GAS bf16* qp, const ATT_GAS bf16* kp, const ATT_GAS bf16* vp, ATT_GAS bf16* op, const int u0, const float sinkl2, ATT_LAS char* lds) {
  typedef float f32x4 __attribute__((ext_vector_type(4)));
  int tid_ = threadIdx.x; asm volatile("" : "+v"(tid_));
  const int tid = tid_, wid = __builtin_amdgcn_readfirstlane(tid >> 6), lane = tid & 63, c = lane & 15, g = lane >> 4;
  ATT_LAS char* K_lds = lds; ATT_LAS char* V_lds = lds + SW_OFFV;
  ATT_LAS float* al = (ATT_LAS float*)(lds + SW_OFFAL) + wid * 64;
  const int q0 = 64 * (u0 + wid);
  bf16x8 qf[4][2];
#pragma unroll
  for (int qb = 0; qb < 4; ++qb)
#pragma unroll
    for (int ks = 0; ks < 2; ++ks) qf[qb][ks] = *(const ATT_GAS bf16x8*)(qp + (size_t)(q0 + 16 * qb + c) * 256 + 32 * ks + 8 * g);
  f32x4 o[4][4], lacc[4], negm[4];
#pragma unroll
  for (int qb = 0; qb < 4; ++qb) { negm[qb] = (f32x4){-sinkl2, -sinkl2, -sinkl2, -sinkl2}; lacc[qb] = (f32x4){1.f, 1.f, 1.f, 1.f};
#pragma unroll
    for (int db = 0; db < 4; ++db) o[qb][db] = (f32x4){0.f, 0.f, 0.f, 0.f}; }
  bf16x8 ones8; { const u32x4 w1 = {0x3F803F80u, 0x3F803F80u, 0x3F803F80u, 0x3F803F80u}; ones8 = __builtin_bit_cast(bf16x8, w1); asm volatile("" : "+v"(ones8)); }
  const int gch = (lane & 3) ^ ((4 - g) & 3);
  const unsigned koff = (unsigned)((16 * (wid & 3) + (lane >> 2)) * 128 + 32 * (wid >> 2) + 8 * gch) * 2u;
  const int vsA = 64 * wid + lane, vsB = 64 * (8 + (wid & 1)) + lane;
  const unsigned voffA = (unsigned)((vsA / 10) * 128 + 8 * ((vsA % 10) > 7 ? 7 : (vsA % 10))) * 2u, voffB = (unsigned)((vsB / 10) * 128 + 8 * ((vsB % 10) > 7 ? 7 : (vsB % 10))) * 2u;
#define SW_DMA(src, dst) do { const ATT_GAS char* s_ = (const ATT_GAS char*)(src); const unsigned d_ = (unsigned)__builtin_amdgcn_readfirstlane((int)(unsigned)(size_t)(dst)); \
    asm volatile("s_mov_b32 m0, %1\n\ts_nop 0\n\tglobal_load_lds_dwordx4 %0, off" :: "v"(s_), "s"(d_) : "memory", "m0"); } while (0)
#define SW_STAGE(T, b) do { SW_DMA((const ATT_GAS char*)(kp + (size_t)(64 * (T)) * 128) + koff, K_lds + (b) * SWK_B + wid * 1024); \
    SW_DMA((const ATT_GAS char*)(vp + (size_t)(64 * (T)) * 128) + voffA, V_lds + (b) * SWV_B + wid * 1024); \
    if (wid < 2) SW_DMA((const ATT_GAS char*)(vp + (size_t)(64 * (T)) * 128) + voffB, V_lds + (b) * SWV_B + (8 + wid) * 1024); } while (0)
  const ATT_LAS char* kb0 = K_lds + c * 64 + ((g ^ fkey(c)) * 16);
  const ATT_LAS char* vb0 = V_lds + (4 * g + ((lane >> 2) & 3)) * V16ST + (lane & 3) * 8;
  const int Tlo = (u0 - 2 < 0) ? 0 : u0 - 2, Thi = (u0 + 9 > 63) ? 63 : u0 + 9;
  SW_STAGE(Tlo, 0); if (Tlo + 1 <= Thi) SW_STAGE(Tlo + 1, 1);
  asm volatile("s_waitcnt vmcnt(0)" ::: "memory");
  if (Tlo + 2 <= Thi) SW_STAGE(Tlo + 2, 2); if (Tlo + 3 <= Thi) SW_STAGE(Tlo + 3, 3);
  __syncthreads();
  int b0 = 0, b4 = 4;
  for (int T = Tlo; T <= Thi; ++T) {
    if (T + 4 <= Thi) SW_STAGE(T + 4, b4);
    const int dT = T - (u0 + wid);
    if (dT >= -2 && dT <= 2) {
      const ATT_LAS char* Kc = kb0 + b0 * SWK_B; const ATT_LAS char* Vc = vb0 + b0 * SWV_B;
      f32x4 S[4][4];
      { bf16x8 kf[4][2];
#pragma unroll
        for (int ks = 0; ks < 2; ++ks)
#pragma unroll
          for (int kb = 0; kb < 4; ++kb) kf[kb][ks] = *(const ATT_LAS bf16x8*)(Kc + ks * 4096 + kb * 1024);
#pragma unroll
        for (int ks = 0; ks < 2; ++ks)
#pragma unroll
          for (int kb = 0; kb < 4; ++kb)
#pragma unroll
            for (int qb = 0; qb < 4; ++qb) S[kb][qb] = __builtin_amdgcn_mfma_f32_16x16x32_bf16(kf[kb][ks], qf[qb][ks], ks == 0 ? negm[qb] : S[kb][qb], 0, 0, 0); }
      if (dT == -2 || dT == 2) {
        const int d0 = 64 * T + 4 * g - q0 - c;
#pragma unroll
        for (int kb = 0; kb < 4; ++kb)
#pragma unroll
          for (int qb = 0; qb < 4; ++qb)
#pragma unroll
            for (int r = 0; r < 4; ++r) { const int d = d0 + 16 * kb + r - 16 * qb; S[kb][qb][r] = (d >= -128 && d <= 128) ? S[kb][qb][r] : -1e30f; } }
      float pm[4];
#pragma unroll
      for (int qb = 0; qb < 4; ++qb) { float a = fmaxf(fmaxf(S[0][qb][0], S[0][qb][1]), S[0][qb][2]);
#pragma unroll
        for (int kb = 0; kb < 4; ++kb) { if (kb) a = fmaxf(fmaxf(a, S[kb][qb][0]), S[kb][qb][1]); a = fmaxf(fmaxf(a, S[kb][qb][kb ? 2 : 3]), S[kb][qb][3]); }
        pm[qb] = a; }
      if (__builtin_expect(__any(fmaxf(fmaxf(pm[0], pm[1]), fmaxf(pm[2], pm[3])) > THR), 0)) {
#pragma unroll
        for (int qb = 0; qb < 4; ++qb) { float pmx = fmaxf(pm[qb], __shfl_xor(pm[qb], 16)); pmx = fmaxf(pmx, __shfl_xor(pmx, 32));
          const float dl = fmaxf(pmx, 0.f); negm[qb] -= dl;
#pragma unroll
          for (int kb = 0; kb < 4; ++kb) S[kb][qb] -= dl;
          if (g == 0) al[16 * qb + c] = __builtin_amdgcn_exp2f(-dl); }
        asm volatile("s_waitcnt lgkmcnt(0)" ::: "memory");
#pragma unroll
        for (int qb = 0; qb < 4; ++qb)
#pragma unroll
          for (int r = 0; r < 4; ++r) { const float a = al[16 * qb + 4 * g + r]; lacc[qb][r] *= a;
#pragma unroll
            for (int db = 0; db < 4; ++db) o[qb][db][r] *= a; } }
      bf16x8 pa[4][2];
#pragma unroll
      for (int qb = 0; qb < 4; ++qb) {
#pragma unroll
        for (int kb = 0; kb < 4; ++kb)
#pragma unroll
          for (int r = 0; r < 4; ++r) S[kb][qb][r] = __builtin_amdgcn_exp2f(S[kb][qb][r]);
#pragma unroll
        for (int s2 = 0; s2 < 2; ++s2) { const u32x4 w = {cvtpk(S[2 * s2][qb][0], S[2 * s2][qb][1]), cvtpk(S[2 * s2][qb][2], S[2 * s2][qb][3]),
                                                         cvtpk(S[2 * s2 + 1][qb][0], S[2 * s2 + 1][qb][1]), cvtpk(S[2 * s2 + 1][qb][2], S[2 * s2 + 1][qb][3])};
          pa[qb][s2] = __builtin_bit_cast(bf16x8, w); }
        SBAR(); }
#pragma unroll
      for (int s2 = 0; s2 < 2; ++s2) { bf16x8 vf[4];
#pragma unroll
        for (int db = 0; db < 4; ++db) { const s16x4 lo = vtr(Vc + s2 * 32 * V16ST + db * 32), hi = vtr(Vc + (s2 * 32 + 16) * V16ST + db * 32);
          vf[db] = (bf16x8){lo[0], lo[1], lo[2], lo[3], hi[0], hi[1], hi[2], hi[3]}; }
#pragma unroll
        for (int db = 0; db < 4; ++db)
#pragma unroll
          for (int qb = 0; qb < 4; ++qb) o[qb][db] = __builtin_amdgcn_mfma_f32_16x16x32_bf16(pa[qb][s2], vf[db], o[qb][db], 0, 0, 0);
#pragma unroll
        for (int qb = 0; qb < 4; ++qb) lacc[qb] = __builtin_amdgcn_mfma_f32_16x16x32_bf16(pa[qb][s2], ones8, lacc[qb], 0, 0, 0); }
    }
    if (T + 4 <= Thi) { if (wid < 2) asm volatile("s_waitcnt vmcnt(9) lgkmcnt(0)" ::: "memory"); else asm volatile("s_waitcnt vmcnt(6) lgkmcnt(0)" ::: "memory"); }
    else asm volatile("s_waitcnt vmcnt(0) lgkmcnt(0)" ::: "memory");
    __builtin_amdgcn_s_barrier(); asm volatile("" ::: "memory");
    { const int t_ = b0; b0 = (b0 == SW_NB - 1) ? 0 : b0 + 1; b4 = t_; }
  }
#undef SW_DMA
#undef SW_STAGE
  { ATT_LAS char* stg = lds + SW_OFFO + wid * 9216;
#pragma unroll
    for (int qb = 0; qb < 4; ++qb)
#pragma unroll
      for (int r = 0; r < 4; ++r) { const int orow = 16 * qb + 4 * g + r; const float rl = __builtin_amdgcn_rcpf(lacc[qb][r]);
#pragma unroll
        for (int db = 0; db < 4; ++db) { const float val = o[qb][db][r] * rl; *(ATT_LAS bf16*)(stg + orow * 144 + (db * 16 + c) * 2) = (bf16)(cvtpk(val, val) & 0xffffu); } }
    asm volatile("s_waitcnt lgkmcnt(0)" ::: "memory");
#pragma unroll
    for (int i = 0; i < 8; ++i) { const int row = i * 8 + (lane >> 3), ch = lane & 7; const u32x4 v = *(const ATT_LAS u32x4*)(stg + row * 144 + ch * 16); *(ATT_GAS u32x4*)(op + (size_t)(q0 + row) * 1024 + ch * 8) = v; } }
  __syncthreads();
}
template <int NH>
__device__ __forceinline__ bool mla_block_fixed(AttnIO io, float km2, ATT_LAS char* lds, int& role) {
  float mrow; bool okw = mla_fixed_ref(io, km2, mrow);
  if constexpr (NH == 2) { io.q += (size_t)256 * io.ldq; okw = mla_fixed_ref(io, km2, mrow) && okw; }
  int tid_ = threadIdx.x; asm volatile("" : "+v"(tid_));
  const int wid = __builtin_amdgcn_readfirstlane(tid_ >> 6);
  const int simd = (int)__builtin_amdgcn_s_getreg((1 << 11) | (4 << 6) | 4);
  ATT_LAS int* fl = (ATT_LAS int*)(lds + OFF_FLAG);
  if ((tid_ & 63) == 0) fl[wid] = (okw ? 1 : 0) | (simd << 1);
  __syncthreads();
  int all = 1, rank = 0;
#pragma unroll
  for (int w = 0; w < 8; ++w) { const int f = __builtin_amdgcn_readfirstlane(fl[w]); all &= f; rank += (w < wid && (f >> 1) == simd) ? 1 : 0; }
  role = rank & 1;
  return (all & 1) != 0;
}
#undef SBAR
}
#ifndef PHMASK
#define PHMASK 0xffffffffu
#endif
#define PH(k) if (PHMASK & (1u << (k)))
#ifndef DUPMASK
#define DUPMASK 0u
#endif
#define DUP(k) for (int rep_ = 0; rep_ < (int)((DUPMASK >> (k)) & 1u) + 1; ++rep_)
constexpr int NWAVES = 8;
constexpr int DM = 1024, BATCH = 8, SEQ = 4096, TOK = BATCH * SEQ, DEPTH = 2;
constexpr int IN_W = 1952, IN_WP = 2048, NEXP = 16, EFF = 512, CAP = 512, PLE = 256;
constexpr int NSLOT = BATCH * NEXP * CAP;
constexpr float NORM_EPS = 1e-6f, LOG2E = 1.4426950408889634f;
constexpr float C2_NA = 0.125f * LOG2E, C2_SW = 0.125f * LOG2E, C2_MLA = 0.10206207261596575f * LOG2E;

constexpr size_t MiB = 1u << 20;
constexpr size_t WS_CTL = 0, CTL_ZERO_BYTES = 64 * 1024;
constexpr size_t WS_MISC = 1 * MiB;
constexpr size_t MO_COS16 = 0, MO_SIN16 = 256 * 1024, MO_COS32 = 512 * 1024, MO_SIN32 = 1024 * 1024;
constexpr size_t MO_PSSQ = 1536 * 1024;
constexpr size_t MO_GSSQ = MO_PSSQ + 2 * MiB;
constexpr size_t MO_RSF = MO_GSSQ + 2560 * 1024;
constexpr size_t MO_RSP = MO_RSF + 128 * 1024;
constexpr size_t MO_AFF = MO_RSP + 128 * 1024;
constexpr size_t MO_SIDX = MO_AFF + 2 * MiB;
constexpr size_t MO_SG = MO_SIDX + 256 * 1024;
constexpr size_t MO_SRS = MO_SG + 256 * 1024;
constexpr size_t MO_INV = MO_SRS + 256 * 1024;
constexpr size_t MO_RSA = MO_INV + 2 * MiB, MO_RSCQ = MO_RSA + 128 * 1024, MO_RSCKV = MO_RSCQ + 128 * 1024;
constexpr size_t MO_WR = MO_RSCKV + 128 * 1024;
static_assert(MO_WR + 128 * 1024 <= 16 * MiB, "misc map");
constexpr size_t WS_WPG = 17 * MiB;
constexpr size_t WS_W = 21 * MiB;
constexpr size_t WO_IN = 0, WO_QUP = 4 * MiB, WO_KVUP = 5 * MiB, WO_OUT = 6 * MiB, WO_PP = 8 * MiB, WO_GU = 9 * MiB, WO_DOWN = 41 * MiB;
constexpr size_t WS_HB = 79 * MiB, WS_PB = 143 * MiB, WS_OCAT = 159 * MiB, WS_PPO = WS_OCAT, WS_BIG = 223 * MiB, WS_END = 457 * MiB;
constexpr size_t BO_NAQKV = 0, BO_CQ = 48 * MiB, BO_CKV = 72 * MiB, BO_KR = 88 * MiB, BO_SWQ = 90 * MiB, BO_SWK = 106 * MiB, BO_SWV = 114 * MiB,
                 BO_QM = 122 * MiB, BO_KN = 170 * MiB, BO_VM = 202 * MiB, BO_ACT = 0, BO_Y = 64 * MiB;
constexpr size_t SLAB_B = 234 * MiB / 8;
#define BOX(BO, SZ_MIB) (F.xl ? (size_t)F.xb * (SLAB_B - (size_t)(SZ_MIB) * MiB / 8) + (size_t)(BO) / 8 : (size_t)(BO))
constexpr int CW_BAR = 4096;
static_assert((CW_BAR + 3456) * 4 <= 32768, "barrier words");
constexpr int CW_XL = 12544;
constexpr int CW_KMAX = 8192, CW_KRMAX = CW_KMAX + 128;

constexpr int RING_OFF = 0, RING_BYTES = 131072;
constexpr int LDSCTL_OFF = RING_BYTES, MISC_OFF = LDSCTL_OFF + 320, GTAB_OFF = RING_BYTES + 1024;
constexpr int LDS_BYTES = 147456;
static_assert(GTAB_OFF + 8192 <= LDS_BYTES && MISC_OFF + 128 <= GTAB_OFF, "LDS map");

#define GAS __attribute__((address_space(1)))
#define LAS __attribute__((address_space(3)))
typedef unsigned short bf16;
typedef unsigned v4u __attribute__((ext_vector_type(4)));
typedef unsigned v2u __attribute__((ext_vector_type(2)));
typedef int v4i __attribute__((ext_vector_type(4)));
typedef float f32x4 __attribute__((ext_vector_type(4)));
typedef float f32x2 __attribute__((ext_vector_type(2)));
typedef __bf16 bf16x2_t __attribute__((ext_vector_type(2)));
#define LDS_WAIT() asm volatile("s_waitcnt lgkmcnt(0)" ::: "memory")
#define VM_WAIT() asm volatile("s_waitcnt vmcnt(0)" ::: "memory")
__device__ __forceinline__ unsigned pk2(float lo, float hi) { f32x2 v = {lo, hi}; bf16x2_t b = __builtin_convertvector(v, bf16x2_t); return __builtin_bit_cast(unsigned, b); }
__device__ __forceinline__ v2u pk4(f32x4 v) { v2u r; r.x = pk2(v[0], v[1]); r.y = pk2(v[2], v[3]); return r; }
__device__ __forceinline__ float bf2f(unsigned short b) { return __uint_as_float((unsigned)b << 16); }
__device__ __forceinline__ float wave_sum(float v) {
#pragma unroll
    for (int o = 1; o < 64; o <<= 1) v += __shfl_xor(v, o);
    return v;
}

#define XB_TMO      128
#define XB_XCNT(j)  (256  + 64 * (j))
#define XB_XSUB(j)  (1280 + 64 * (j))
#define XB_XGEN(j)  (2304 + 64 * (j))
#define XB_TOP      3328
#define XB_TOPGEN   3392
#define XCD_BAR_WORDS 3456
#define XB_SPIN_CAP (1u << 22)
__device__ __forceinline__ unsigned xb_ld(unsigned* p)              { return __hip_atomic_load(p, __ATOMIC_RELAXED, __HIP_MEMORY_SCOPE_AGENT); }
__device__ __forceinline__ unsigned xb_add(unsigned* p, unsigned v) { return __hip_atomic_fetch_add(p, v, __ATOMIC_RELAXED, __HIP_MEMORY_SCOPE_AGENT); }
__device__ __forceinline__ unsigned xb_xcc_id() { return (unsigned)__builtin_amdgcn_s_getreg((3 << 11) | 20) & 0xFu; }
#define XB_SPIN(cond, bar) do { unsigned _sp = 0; while (cond) { __builtin_amdgcn_s_sleep(1); \
    if ((++_sp & 255u) == 0u) { if (xb_ld(&(bar)[XB_TMO])) break; if (_sp > XB_SPIN_CAP) { atomicAdd(&(bar)[XB_TMO], 1u); break; } } } } while (0)
struct XcdBarrier { unsigned* bar; unsigned x; volatile LAS unsigned* st; };
__device__ __forceinline__ XcdBarrier xcd_barrier_post(unsigned* bar, volatile LAS unsigned* st) {
    XcdBarrier b; b.bar = bar; b.x = xb_xcc_id(); b.st = st;
    if (threadIdx.x == 0) st[2] = xb_add(&bar[XB_XCNT(b.x)], 1u);
    return b;
}
__device__ __forceinline__ void xcd_barrier_complete(unsigned* bar, unsigned x, unsigned& nloc, unsigned& nx) {
    const unsigned G = gridDim.x * gridDim.y * gridDim.z;
    unsigned sum, cnt, mine, sp = 0u;
    for (;;) {
        sum = 0u; cnt = 0u; mine = 0u;
#pragma unroll
        for (unsigned j = 0; j < 16; ++j) { const unsigned c = xb_ld(&bar[XB_XCNT(j)]); sum += c; cnt += (c > 0u) ? 1u : 0u; mine = (j == x) ? c : mine; }
        if (sum == G) break;
        __builtin_amdgcn_s_sleep(1);
        if ((++sp & 255u) == 0u) { if (xb_ld(&bar[XB_TMO])) break; if (sp > XB_SPIN_CAP) { atomicAdd(&bar[XB_TMO], 1u); break; } }
    }
    nloc = mine > 0u ? mine : 1u; nx = cnt > 0u ? cnt : 1u;
}
__device__ __forceinline__ void xcd_local_barrier(unsigned* cnt, unsigned n, unsigned* bar) {
    asm volatile("s_waitcnt vmcnt(0)" ::: "memory");
    __syncthreads();
    if (threadIdx.x == 0) {
        const unsigned old = xb_add(cnt, 1u); const unsigned target = (old / n + 1u) * n;
        XB_SPIN(xb_ld(cnt) < target, bar);
        asm volatile("buffer_inv sc0\n\ts_waitcnt vmcnt(0)" ::: "memory");
    }
    __syncthreads();
}
__device__ __forceinline__ void xcd_barrier(const XcdBarrier& b, const bool flush = true) {
    asm volatile("s_waitcnt vmcnt(0)" ::: "memory");
    __syncthreads();
    if (threadIdx.x == 0) {
        unsigned* bar = b.bar;
        __builtin_amdgcn_s_waitcnt(0);
        unsigned nloc = b.st[0], nx = b.st[1];
        if (nloc == 0u) { xcd_barrier_complete(bar, b.x, nloc, nx); b.st[0] = nloc; b.st[1] = nx; }
        const unsigned old = xb_add(&bar[XB_XSUB(b.x)], 1u);
        const unsigned gen = old / nloc;
        if (old + 1u == (gen + 1u) * nloc) {
            if (flush) __builtin_amdgcn_fence(__ATOMIC_RELEASE, "agent");
            asm volatile("s_waitcnt vmcnt(0)" ::: "memory");
            const unsigned og = xb_add(&bar[XB_TOP], 1u);
            const unsigned tg = og / nx;
            if (og + 1u == (tg + 1u) * nx) xb_add(&bar[XB_TOPGEN], 1u);
            else XB_SPIN(xb_ld(&bar[XB_TOPGEN]) == tg, bar);
            if (flush) __builtin_amdgcn_fence(__ATOMIC_ACQUIRE, "agent"); else asm volatile("buffer_inv sc0" ::: "memory");
            xb_add(&bar[XB_XGEN(b.x)], 1u);
            asm volatile("s_waitcnt vmcnt(0)" ::: "memory");
        } else {
            XB_SPIN(xb_ld(&bar[XB_XGEN(b.x)]) == gen, bar);
            asm volatile("buffer_inv sc0\n\ts_waitcnt vmcnt(0)" ::: "memory");
        }
    }
    __syncthreads();
}

struct Args { const float* in[20]; float* out; unsigned char* ws; double inv16[16]; double inv32[32]; };
enum { I_X = 0, I_P, I_ATTN_NORM, I_W_IN, I_NA_RPB, I_MLA_Q_NORM, I_MLA_W_Q_UP, I_MLA_KV_NORM, I_MLA_W_KV_UP, I_SWA_SINK, I_W_OUT, I_FFN_NORM, I_W_ROUTER,
       I_W_GATE, I_W_UP, I_W_DOWN, I_PLE_NORM, I_W_PLE_GATE, I_W_PLE_PROJ, I_FINAL_NORM };

struct Frame {
    LAS unsigned char* lds;
    volatile LAS unsigned* MISC;
    int vcu, G;
    unsigned char* ws;
    float* out;
    bf16* hb;
    int xl, xb;
};
#define LAUNDER_LANES() int tid_ = threadIdx.x; asm volatile("" : "+v"(tid_)); const int tid = tid_, lane = tid & 63, wave = __builtin_amdgcn_readfirstlane(tid >> 6); (void)tid; (void)lane; (void)wave
#define WSP(T, off) ((T*)(F.ws + (off)))
#define MISCP(T, off) ((T*)(F.ws + WS_MISC + (off)))

template <class Src>
__device__ __forceinline__ void transpose_item(const Src& src, int K, bf16* WT, LAS float* scr, int item, int nblk, int lane) {
    const int kb = item / nblk, nb = item % nblk, k0 = 64 * kb, n0 = 32 * nb;
#pragma unroll 8
    for (int i = 0; i < 32; ++i) { const int kk = 2 * i + (lane >> 5); scr[kk * 33 + (lane & 31)] = src(k0 + kk, n0 + (lane & 31)); }
    LDS_WAIT(); asm volatile("" ::: "memory");
    const int c = lane & 7;
#pragma unroll
    for (int j = 0; j < 4; ++j) { const int n = (lane >> 3) + 8 * j; const LAS float* s = scr + (8 * c) * 33 + n;
        v4u o; o.x = pk2(s[0 * 33], s[1 * 33]); o.y = pk2(s[2 * 33], s[3 * 33]); o.z = pk2(s[4 * 33], s[5 * 33]); o.w = pk2(s[6 * 33], s[7 * 33]);
        *(GAS v4u*)(WT + (size_t)(n0 + n) * K + k0 + 8 * c) = o; }
    LDS_WAIT(); asm volatile("" ::: "memory");
}
__device__ __forceinline__ int pair16(int p) { return 16 * ((p >> 2) & 1) + 4 * (p >> 3) + (p & 3); }
struct SrcPlain { const float* W; int N; const float* g;
    __device__ __forceinline__ float operator()(int k, int n) const { const float w = __builtin_nontemporal_load((const GAS float*)(W + (size_t)k * N + n)); return g ? w * g[k] : w; } };
struct SrcIn { const float* W; const float* g;
    __device__ __forceinline__ float operator()(int k, int n) const {
        if (n >= IN_W) return 0.f;
        int c = n;
        if (n >= 1408 && n < 1440) c = 1408 + pair16(n - 1408);
        else if (n >= 1440 && n < 1824) { const int base = (n < 1696) ? 1440 : 1696; const int p = (n - base) & 63, hb = (n - base) & ~63, sub = p >> 5, q = p & 31;
            c = base + hb + 16 * sub + 32 * ((q >> 2) & 1) + 4 * (q >> 3) + (q & 3); }
        return __builtin_nontemporal_load((const GAS float*)(W + (size_t)k * IN_W + c)) * g[k]; } };
struct SrcQup { const float* W; const float* g;
    __device__ __forceinline__ float operator()(int k, int n) const { const int h = n / 96, r = n % 96; const int c = (r < 64) ? n : h * 96 + 64 + pair16(r - 64); return W[(size_t)k * 768 + c] * g[k]; } };
struct SrcGU { const float* Wg; const float* Wu; const float* g;
    __device__ __forceinline__ float operator()(int k, int n) const { const int grp = n >> 5, p = n & 31; const ptrdiff_t d = ((p >> 2) & 1) ? (Wu - Wg) : (ptrdiff_t)0; return __builtin_nontemporal_load((const GAS float*)(Wg + d + (ptrdiff_t)k * EFF + 16 * grp + 4 * (p >> 3) + (p & 3))) * g[k]; } };

__device__ __forceinline__ void convert_layer_weights(Frame& F, const Args& a, int l, bool with_pg_both, bf16* Wl) {
    LAUNDER_LANES();
    LAS float* scr = (LAS float*)(F.lds + RING_OFF + wave * 16384);
    const int gw = F.vcu * NWAVES + wave, NGW = F.G * NWAVES;
    constexpr int I_IN = 16 * 64, I_QUP = 6 * 24, I_KVUP = 4 * 32, I_OUT = 16 * 32, I_PPI = 4 * 32, I_GU1 = 16 * 32, I_DN1 = 8 * 32, I_PG = 16 * 32;
    constexpr int NITEMS = I_IN + I_QUP + I_KVUP + I_OUT + I_PPI + NEXP * I_GU1 + NEXP * I_DN1;
    const int total = NITEMS + (with_pg_both ? 2 * I_PG : 0);
    for (int it = gw; it < total; it += NGW) {
        int r = it;
        if (r < I_IN) { SrcIn s{a.in[I_W_IN] + (size_t)l * DM * IN_W, a.in[I_ATTN_NORM] + l * DM}; transpose_item(s, DM, (bf16*)((char*)Wl + WO_IN), scr, r, 64, lane); continue; } r -= I_IN;
        if (r < I_QUP) { SrcQup s{a.in[I_MLA_W_Q_UP] + (size_t)l * 384 * 768, a.in[I_MLA_Q_NORM] + l * 384}; transpose_item(s, 384, (bf16*)((char*)Wl + WO_QUP), scr, r, 24, lane); continue; } r -= I_QUP;
        if (r < I_KVUP) { SrcPlain s{a.in[I_MLA_W_KV_UP] + (size_t)l * 256 * 1024, 1024, a.in[I_MLA_KV_NORM] + l * 256}; transpose_item(s, 256, (bf16*)((char*)Wl + WO_KVUP), scr, r, 32, lane); continue; } r -= I_KVUP;
        if (r < I_OUT) { SrcPlain s{a.in[I_W_OUT] + (size_t)l * DM * DM, DM, nullptr}; transpose_item(s, DM, (bf16*)((char*)Wl + WO_OUT), scr, r, 32, lane); continue; } r -= I_OUT;
        if (r < I_PPI) { SrcPlain s{a.in[I_W_PLE_PROJ] + (size_t)l * PLE * DM, DM, nullptr}; transpose_item(s, PLE, (bf16*)((char*)Wl + WO_PP), scr, r, 32, lane); continue; } r -= I_PPI;
        if (r < NEXP * I_GU1) { const int e = r / I_GU1; const size_t eo = ((size_t)l * NEXP + e) * DM * EFF;
            SrcGU s{a.in[I_W_GATE] + eo, a.in[I_W_UP] + eo, a.in[I_FFN_NORM] + l * DM}; transpose_item(s, DM, (bf16*)((char*)Wl + WO_GU) + (size_t)e * DM * DM, scr, r % I_GU1, 32, lane); continue; } r -= NEXP * I_GU1;
        if (r < NEXP * I_DN1) { const int e = r / I_DN1; SrcPlain s{a.in[I_W_DOWN] + ((size_t)l * NEXP + e) * EFF * DM, DM, nullptr};
            transpose_item(s, EFF, (bf16*)((char*)Wl + WO_DOWN) + (size_t)e * DM * EFF, scr, r % I_DN1, 32, lane); continue; } r -= NEXP * I_DN1;
        { const int ll = r / I_PG; SrcPlain s{a.in[I_W_PLE_GATE] + (size_t)ll * DM * DM, DM, a.in[I_PLE_NORM] + ll * DM}; transpose_item(s, DM, WSP(bf16, WS_WPG) + (size_t)ll * DM * DM, scr, r % I_PG, 32, lane); }
    }
}
__device__ __forceinline__ void convert_p(Frame& F, const Args& a, int l, bf16* pb) {
    LAUNDER_LANES();
    const float* p = a.in[I_P] + (size_t)l * TOK * PLE;
    const size_t n8 = (size_t)TOK * PLE / 8, gt = (size_t)F.vcu * 512 + tid, NT = (size_t)F.G * 512;
    for (size_t i = gt; i < n8; i += NT) { const f32x4 x0 = __builtin_nontemporal_load((const GAS f32x4*)(p + i * 8)), x1 = __builtin_nontemporal_load((const GAS f32x4*)(p + i * 8 + 4));
        v4u o; o.x = pk2(x0[0], x0[1]); o.y = pk2(x0[2], x0[3]); o.z = pk2(x1[0], x1[1]); o.w = pk2(x1[2], x1[3]); *(GAS v4u*)(pb + i * 8) = o; }
}
__device__ __forceinline__ void rope_tables(Frame& F, const Args& a) {
    LAUNDER_LANES();
    float* c16 = MISCP(float, MO_COS16); float* s16 = MISCP(float, MO_SIN16); float* c32 = MISCP(float, MO_COS32); float* s32 = MISCP(float, MO_SIN32);
    const int gt = F.vcu * 512 + tid, NT = F.G * 512;
    for (int i = gt; i < SEQ * 48; i += NT) {
        const int pos = i / 48, f = i % 48; const double inv = (f < 16) ? a.inv16[f] : a.inv32[f - 16];
        const double ang = (double)pos * inv; const double k = __builtin_rint(ang * 0.15915494309189535); const double rr = ang - k * 6.283185307179586476925;
        const float r = (float)rr; const float cs = __cosf(r), sn = __sinf(r);
        if (f < 16) { c16[pos * 16 + f] = cs; s16[pos * 16 + f] = sn; } else { c32[pos * 32 + f - 16] = cs; s32[pos * 32 + f - 16] = sn; }
    }
}
__device__ __forceinline__ void router_weights(Frame& F, const Args& a) {
    LAUNDER_LANES();
    bf16* wr = MISCP(bf16, MO_WR);
    const int gt = F.vcu * 512 + tid, NT = F.G * 512;
    for (int i = gt; i < DEPTH * NEXP * DM; i += NT) { const int l = i / (NEXP * DM), e = (i / DM) % NEXP, k = i % DM;
        const float w = a.in[I_W_ROUTER][((size_t)l * DM + k) * NEXP + e] * a.in[I_FFN_NORM][l * DM + k];
        const unsigned hi = pk2(w, 0.f) & 0xffffu; const float wl = w - __uint_as_float(hi << 16); const unsigned lo = pk2(wl, 0.f) & 0xffffu;
        wr[((size_t)l * 32 + e) * DM + k] = (bf16)hi; wr[((size_t)l * 32 + 16 + e) * DM + k] = (bf16)lo; }
}
__device__ __forceinline__ void x_to_hb(Frame& F, const Args& a) {
    LAUNDER_LANES();
    const float* x = a.in[I_X]; bf16* hb = WSP(bf16, WS_HB);
    const int gw = F.vcu * NWAVES + wave, NGW = F.G * NWAVES;
    for (int m4 = gw; m4 < TOK / 4; m4 += NGW) {
        f32x4 v[4][4];
#pragma unroll
        for (int r = 0; r < 4; ++r) { const GAS f32x4* xr = (const GAS f32x4*)(x + (size_t)(m4 * 4 + r) * DM) + lane;
#pragma unroll
            for (int j = 0; j < 4; ++j) v[r][j] = __builtin_nontemporal_load(xr + 64 * j); }
#pragma unroll
        for (int r = 0; r < 4; ++r) { const int m = m4 * 4 + r; float s = 0.f;
#pragma unroll
            for (int j = 0; j < 4; ++j) s += (v[r][j][0] * v[r][j][0] + v[r][j][1] * v[r][j][1]) + (v[r][j][2] * v[r][j][2] + v[r][j][3] * v[r][j][3]);
            s = wave_sum(s);
            GAS v2u* o8 = (GAS v2u*)(hb + (size_t)m * DM) + lane;
#pragma unroll
            for (int j = 0; j < 4; ++j) o8[64 * j] = pk4(v[r][j]);
            if (lane < 16) MISCP(float, MO_PSSQ)[(size_t)m * 16 + lane] = (lane == 0) ? s : 0.f; }
    }
}
__device__ __forceinline__ void finalize_rstd(Frame& F, int mode) {
    LAUNDER_LANES();
    const int gt = F.vcu * 512 + tid, NT = F.G * 512;
    for (int m = gt; m < TOK; m += NT) {
        if (mode == 0) { const GAS f32x4* p = (const GAS f32x4*)(MISCP(float, MO_PSSQ) + (size_t)m * 16); const f32x4 a = p[0], b = p[1], c = p[2], d = p[3];
            const float s = ((a[0] + a[1]) + (a[2] + a[3])) + ((b[0] + b[1]) + (b[2] + b[3])) + ((c[0] + c[1]) + (c[2] + c[3])) + ((d[0] + d[1]) + (d[2] + d[3]));
            MISCP(float, MO_RSA)[m] = 1.0f / sqrtf(s * (1.f / DM) + NORM_EPS); }
        else { const GAS f32x4* p = (const GAS f32x4*)(MISCP(float, MO_GSSQ) + (size_t)m * 20); const f32x4 a = p[0], b = p[1], c = p[2], d = p[3], e = p[4];
            const float sq = ((a[0] + a[1]) + (a[2] + a[3])) + ((b[0] + b[1]) + (b[2] + b[3])) + ((c[0] + c[1]) + (c[2] + c[3])), sk = ((d[0] + d[1]) + (d[2] + d[3])) + ((e[0] + e[1]) + (e[2] + e[3]));
            MISCP(float, MO_RSCQ)[m] = 1.0f / sqrtf(sq * (1.f / 384.f) + NORM_EPS); MISCP(float, MO_RSCKV)[m] = 1.0f / sqrtf(sk * (1.f / 256.f) + NORM_EPS); }
    }
}
__device__ __forceinline__ void final_norm(Frame& F, const Args& a) {
    LAUNDER_LANES();
    const float* g = a.in[I_FINAL_NORM]; f32x4 gv[4];
#pragma unroll
    for (int j = 0; j < 4; ++j) gv[j] = *((const GAS f32x4*)g + lane + 64 * j);
    const GAS unsigned short* hb = (const GAS unsigned short*)F.hb;
    const int gw = F.vcu * NWAVES + wave, NGW = F.G * NWAVES;
    for (int m4 = gw; m4 < TOK / 4; m4 += NGW) {
        v2u w[4][4];
#pragma unroll
        for (int r = 0; r < 4; ++r) { const GAS v2u* xr = (const GAS v2u*)(hb + (size_t)(m4 * 4 + r) * DM) + lane;
#pragma unroll
            for (int j = 0; j < 4; ++j) w[r][j] = xr[64 * j]; }
#pragma unroll
        for (int r = 0; r < 4; ++r) { f32x4 v[4]; float s = 0.f;
#pragma unroll
            for (int j = 0; j < 4; ++j) { v[j][0] = __uint_as_float(w[r][j].x << 16); v[j][1] = __uint_as_float(w[r][j].x & 0xffff0000u); v[j][2] = __uint_as_float(w[r][j].y << 16); v[j][3] = __uint_as_float(w[r][j].y & 0xffff0000u);
                s += (v[j][0] * v[j][0] + v[j][1] * v[j][1]) + (v[j][2] * v[j][2] + v[j][3] * v[j][3]); }
            const float rs = 1.0f / sqrtf(wave_sum(s) * (1.f / DM) + NORM_EPS);
            GAS f32x4* o = (GAS f32x4*)(F.out + (size_t)(m4 * 4 + r) * DM) + lane;
#pragma unroll
            for (int j = 0; j < 4; ++j) __builtin_nontemporal_store(v[j] * rs * gv[j], o + 64 * j); }
    }
}
typedef pg8::Unit Unit;
typedef const f32x4 (&AccRef)[2][2][4][2];
#define EPI_ROW(u, ai, m) ((u).pm * 256 + (ai) * 128 + wr * 64 + (m) * 16 + fr)
#define EPI_GRP(u, bj) (((u).pn * 256 + (bj) * 128 + wc * 32) >> 5)
typedef GAS bf16 gbf16; typedef GAS float gf32; typedef const GAS float cgf32; typedef const GAS bf16 cgbf16;
__device__ __forceinline__ void st_bf4(gbf16* p, f32x4 v) { *(GAS v2u*)p = pk4(v); }
__device__ __forceinline__ void st_bf8(gbf16* p, f32x4 a, f32x4 b) { v4u w; w.x = pk2(a[0], a[1]); w.y = pk2(a[2], a[3]); w.z = pk2(b[0], b[1]); w.w = pk2(b[2], b[3]); *(GAS v4u*)p = w; }
__device__ __forceinline__ f32x4 ld_bf4(cgbf16* p) { const v2u w = *(const GAS v2u*)p; f32x4 r; r[0] = __uint_as_float(w.x << 16); r[1] = __uint_as_float(w.x & 0xffff0000u); r[2] = __uint_as_float(w.y << 16); r[3] = __uint_as_float(w.y & 0xffff0000u); return r; }
__device__ __forceinline__ f32x4 bflo(v4u w) { f32x4 r; r[0] = __uint_as_float(w.x << 16); r[1] = __uint_as_float(w.x & 0xffff0000u); r[2] = __uint_as_float(w.y << 16); r[3] = __uint_as_float(w.y & 0xffff0000u); return r; }
__device__ __forceinline__ f32x4 bfhi(v4u w) { f32x4 r; r[0] = __uint_as_float(w.z << 16); r[1] = __uint_as_float(w.z & 0xffff0000u); r[2] = __uint_as_float(w.w << 16); r[3] = __uint_as_float(w.w & 0xffff0000u); return r; }
#define EPI_LOAD_ROWS(arr, ptr, scale) float arr[2][4]; _Pragma("unroll") for (int ai = 0; ai < 2; ++ai) _Pragma("unroll") for (int m = 0; m < 4; ++m) arr[ai][m] = (ptr)[EPI_ROW(u, ai, m)] * (scale)
#define EPI_RSTD_ROWS(arr, ptr, STRIDE, OFF, N4, INVN, scale) float arr[2][4]; { f32x4 t_[2][4]; \
    _Pragma("unroll") for (int ai = 0; ai < 2; ++ai) _Pragma("unroll") for (int m = 0; m < 4; ++m) t_[ai][m] = (fq < (N4)) ? *(const GAS f32x4*)((ptr) + (size_t)EPI_ROW(u, ai, m) * (STRIDE) + (OFF) + 4 * fq) : (f32x4){0.f, 0.f, 0.f, 0.f}; \
    _Pragma("unroll") for (int ai = 0; ai < 2; ++ai) _Pragma("unroll") for (int m = 0; m < 4; ++m) { float s_ = (t_[ai][m][0] + t_[ai][m][1]) + (t_[ai][m][2] + t_[ai][m][3]); \
        s_ += __shfl_xor(s_, 16); s_ += __shfl_xor(s_, 32); arr[ai][m] = (scale) / sqrtf(s_ * (INVN) + NORM_EPS); } }

struct EpiIn {
    cgf32* rsa; gf32* gssq; gbf16 *naqkv, *cq, *ckv, *kr, *swq, *swk, *swv; cgf32 *c16, *s16, *c32, *s32; unsigned* krmax;
    __device__ __forceinline__ void operator()(AccRef acc, const Unit& u, int, int wr, int wc, int fr, int fq) const {
        EPI_RSTD_ROWS(rs, rsa, 16, 0, 4, 1.f / DM, 1.f);
#pragma unroll
        for (int bj = 0; bj < 2; ++bj) { const int g = EPI_GRP(u, bj);
            if (g >= 61) continue;
            float kmx = 0.f;
#pragma unroll
            for (int ai = 0; ai < 2; ++ai)
#pragma unroll
                for (int m = 0; m < 4; ++m) { const int row = EPI_ROW(u, ai, m); const int spos = row & (SEQ - 1);
                    const f32x4 v0 = acc[ai][bj][m][0] * rs[ai][m], v1 = acc[ai][bj][m][1] * rs[ai][m];
                    if (g < 24) { const float sc = (g < 8) ? C2_NA : 1.f; st_bf8(naqkv + (size_t)row * 768 + g * 32 + 8 * fq, v0 * sc, v1 * sc); }
                    else if (g < 44) { st_bf8((g < 36) ? cq + (size_t)row * 384 + (g - 24) * 32 + 8 * fq : ckv + (size_t)row * 256 + (g - 36) * 32 + 8 * fq, v0, v1);
                        float ss = ((v0[0] * v0[0] + v0[1] * v0[1]) + (v0[2] * v0[2] + v0[3] * v0[3])) + ((v1[0] * v1[0] + v1[1] * v1[1]) + (v1[2] * v1[2] + v1[3] * v1[3]));
                        ss += __shfl_xor(ss, 16); ss += __shfl_xor(ss, 32); if (fq == 0) gssq[(size_t)row * 20 + (g - 24)] = ss; }
                    else if (g == 44) { const f32x4 c = *(const GAS f32x4*)(c16 + spos * 16 + 4 * fq), sn = *(const GAS f32x4*)(s16 + spos * 16 + 4 * fq);
                        gbf16* d = kr + (size_t)row * 32 + 4 * fq; st_bf4(d, v0 * c - v1 * sn); st_bf4(d + 16, v1 * c + v0 * sn);
                        float ss = ((v0[0] * v0[0] + v0[1] * v0[1]) + (v0[2] * v0[2] + v0[3] * v0[3])) + ((v1[0] * v1[0] + v1[1] * v1[1]) + (v1[2] * v1[2] + v1[3] * v1[3]));
                        ss += __shfl_xor(ss, 16); ss += __shfl_xor(ss, 32); kmx = fmaxf(kmx, ss); }
                    else if (g < 57) { const bool isq = g < 53; const int gg = isq ? g - 45 : g - 53, head = gg >> 1, i0 = 16 * (gg & 1) + 4 * fq;
                        const f32x4 c = *(const GAS f32x4*)(c32 + spos * 32 + i0), sn = *(const GAS f32x4*)(s32 + spos * 32 + i0); const float sc = isq ? C2_SW : 1.f;
                        gbf16* d = (isq ? swq + (size_t)row * 256 : swk + (size_t)row * 128) + head * 64 + i0; st_bf4(d, (v0 * c - v1 * sn) * sc); st_bf4(d + 32, (v1 * c + v0 * sn) * sc); }
                    else st_bf8(swv + (size_t)row * 128 + (g - 57) * 32 + 8 * fq, v0, v1);
                }
            if (g == 44) { kmx = fmaxf(kmx, __shfl_xor(kmx, 1)); kmx = fmaxf(kmx, __shfl_xor(kmx, 2)); kmx = fmaxf(kmx, __shfl_xor(kmx, 4)); kmx = fmaxf(kmx, __shfl_xor(kmx, 8));
                if (fr == 0 && fq == 0) atomicMax(krmax + ((u.pm * 256) >> 12), __float_as_uint(kmx)); }
        }
    }
};
struct EpiQup {
    cgf32* rscq; gbf16* qm; cgf32 *c16, *s16;
    __device__ __forceinline__ void operator()(AccRef acc, const Unit& u, int, int wr, int wc, int fr, int fq) const {
        EPI_RSTD_ROWS(rs, rscq, 20, 0, 3, 1.f / 384.f, C2_MLA);
#pragma unroll
        for (int bj = 0; bj < 2; ++bj) { const int g = EPI_GRP(u, bj); const bool rope = (g % 3) == 2;
#pragma unroll
            for (int ai = 0; ai < 2; ++ai)
#pragma unroll
                for (int m = 0; m < 4; ++m) { const int row = EPI_ROW(u, ai, m); const f32x4 v0 = acc[ai][bj][m][0] * rs[ai][m], v1 = acc[ai][bj][m][1] * rs[ai][m];
                    if (rope) { const int sq = row & (SEQ - 1); const f32x4 c = *(const GAS f32x4*)(c16 + sq * 16 + 4 * fq), sn = *(const GAS f32x4*)(s16 + sq * 16 + 4 * fq);
                        gbf16* d = qm + (size_t)row * 768 + g * 32 + 4 * fq; st_bf4(d, v0 * c - v1 * sn); st_bf4(d + 16, v1 * c + v0 * sn); }
                    else st_bf8(qm + (size_t)row * 768 + g * 32 + 8 * fq, v0, v1); } }
    }
};
struct EpiKVup {
    cgf32* rsckv; gbf16 *kn, *vm; unsigned* kmax;
    __device__ __forceinline__ void operator()(AccRef acc, const Unit& u, int, int wr, int wc, int fr, int fq) const {
        EPI_RSTD_ROWS(rs, rsckv, 20, 12, 2, 1.f / 256.f, 1.f);
#pragma unroll
        for (int bj = 0; bj < 2; ++bj) { const int g = EPI_GRP(u, bj), h = g >> 2, part = g & 3; gbf16* base = ((part < 2) ? kn : vm) + h * 64 + (part & 1) * 32 + 8 * fq; float mx = 0.f;
#pragma unroll
            for (int ai = 0; ai < 2; ++ai)
#pragma unroll
                for (int m = 0; m < 4; ++m) { const f32x4 v0 = acc[ai][bj][m][0] * rs[ai][m], v1 = acc[ai][bj][m][1] * rs[ai][m]; st_bf8(base + (size_t)EPI_ROW(u, ai, m) * 512, v0, v1);
                    if (part < 2) { float ss = ((v0[0] * v0[0] + v0[1] * v0[1]) + (v0[2] * v0[2] + v0[3] * v0[3])) + ((v1[0] * v1[0] + v1[1] * v1[1]) + (v1[2] * v1[2] + v1[3] * v1[3]));
                        ss += __shfl_xor(ss, 16); ss += __shfl_xor(ss, 32); mx = fmaxf(mx, ss); } }
            if (part < 2) { mx = fmaxf(mx, __shfl_xor(mx, 1)); mx = fmaxf(mx, __shfl_xor(mx, 2)); mx = fmaxf(mx, __shfl_xor(mx, 4)); mx = fmaxf(mx, __shfl_xor(mx, 8));
                if (fr == 0 && fq == 0) atomicMax(kmax + (((u.pm * 256) >> 12) * 8 + h) * 2 + part, __float_as_uint(mx)); } }
    }
};
struct EpiBf {
    gbf16* o; int ldc;
    __device__ __forceinline__ void operator()(AccRef acc, const Unit& u, int, int wr, int wc, int fr, int fq) const {
#pragma unroll
        for (int bj = 0; bj < 2; ++bj) { gbf16* base = o + EPI_GRP(u, bj) * 32 + 8 * fq;
#pragma unroll
            for (int ai = 0; ai < 2; ++ai)
#pragma unroll
                for (int m = 0; m < 4; ++m) st_bf8(base + (size_t)EPI_ROW(u, ai, m) * ldc, acc[ai][bj][m][0], acc[ai][bj][m][1]); }
    }
};
struct EpiRes {
    gbf16* hb;
    __device__ __forceinline__ void operator()(AccRef acc, const Unit& u, int, int wr, int wc, int fr, int fq) const {
#pragma unroll
        for (int ai = 0; ai < 2; ++ai) { v4u hv[4][2];
#pragma unroll
            for (int m = 0; m < 4; ++m)
#pragma unroll
                for (int bj = 0; bj < 2; ++bj) hv[m][bj] = *(const GAS v4u*)(hb + (size_t)EPI_ROW(u, ai, m) * DM + EPI_GRP(u, bj) * 32 + 8 * fq);
#pragma unroll
            for (int m = 0; m < 4; ++m)
#pragma unroll
                for (int bj = 0; bj < 2; ++bj) st_bf8(hb + (size_t)EPI_ROW(u, ai, m) * DM + EPI_GRP(u, bj) * 32 + 8 * fq, bflo(hv[m][bj]) + acc[ai][bj][m][0], bfhi(hv[m][bj]) + acc[ai][bj][m][1]);
            asm volatile("" ::: "memory"); }
    }
};
struct EpiSwiglu {
    cgf32* srs; gbf16* act;
    __device__ __forceinline__ void operator()(AccRef acc, const Unit& u, int, int wr, int wc, int fr, int fq) const {
        EPI_LOAD_ROWS(rs, srs, 1.f);
#pragma unroll
        for (int ai = 0; ai < 2; ++ai)
#pragma unroll
            for (int m = 0; m < 4; ++m) { const int row = EPI_ROW(u, ai, m);
#pragma unroll
                for (int bj = 0; bj < 2; ++bj) { const f32x4 a = acc[ai][bj][m][0] * rs[ai][m], up = acc[ai][bj][m][1] * rs[ai][m]; f32x4 r;
#pragma unroll
                    for (int e = 0; e < 4; ++e) r[e] = a[e] * __builtin_amdgcn_rcpf(1.f + __builtin_amdgcn_exp2f(-a[e] * LOG2E)) * up[e];
                    st_bf4(act + (size_t)row * EFF + EPI_GRP(u, bj) * 16 + 4 * fq, r); } }
    }
};
struct EpiDown {
    cgf32* sg; gbf16* y;
    __device__ __forceinline__ void operator()(AccRef acc, const Unit& u, int, int wr, int wc, int fr, int fq) const {
        EPI_LOAD_ROWS(gw, sg, 1.f);
#pragma unroll
        for (int bj = 0; bj < 2; ++bj) { gbf16* base = y + EPI_GRP(u, bj) * 32 + 8 * fq;
#pragma unroll
            for (int ai = 0; ai < 2; ++ai)
#pragma unroll
                for (int m = 0; m < 4; ++m) st_bf8(base + (size_t)EPI_ROW(u, ai, m) * DM, acc[ai][bj][m][0] * gw[ai][m], acc[ai][bj][m][1] * gw[ai][m]); }
    }
};
struct EpiPle {
    cgf32* rsp; cgbf16* pp; cgbf16* hb; gbf16* hbo; gf32* pssq;
    __device__ __forceinline__ void operator()(AccRef acc, const Unit& u, int, int wr, int wc, int fr, int fq) const {
        EPI_LOAD_ROWS(rs, rsp, 1.f);
#pragma unroll
        for (int ai = 0; ai < 2; ++ai) { v4u hv[4][2], pv[4][2];
#pragma unroll
            for (int m = 0; m < 4; ++m)
#pragma unroll
                for (int bj = 0; bj < 2; ++bj) { const size_t off = (size_t)EPI_ROW(u, ai, m) * DM + EPI_GRP(u, bj) * 32 + 8 * fq; hv[m][bj] = *(const GAS v4u*)(hb + off); pv[m][bj] = __builtin_nontemporal_load((const GAS v4u*)(pp + off)); }
#pragma unroll
            for (int m = 0; m < 4; ++m) { float ss = 0.f; const int row = EPI_ROW(u, ai, m);
#pragma unroll
                for (int bj = 0; bj < 2; ++bj) { const f32x4 a0 = acc[ai][bj][m][0] * rs[ai][m], a1 = acc[ai][bj][m][1] * rs[ai][m]; const f32x4 h0 = bflo(hv[m][bj]), h1 = bfhi(hv[m][bj]), p0 = bflo(pv[m][bj]), p1 = bfhi(pv[m][bj]); f32x4 r0, r1;
#pragma unroll
                    for (int e = 0; e < 4; ++e) { r0[e] = h0[e] + __builtin_amdgcn_rcpf(1.f + __builtin_amdgcn_exp2f(-a0[e] * LOG2E)) * p0[e]; r1[e] = h1[e] + __builtin_amdgcn_rcpf(1.f + __builtin_amdgcn_exp2f(-a1[e] * LOG2E)) * p1[e]; }
                    st_bf8(hbo + (size_t)row * DM + EPI_GRP(u, bj) * 32 + 8 * fq, r0, r1);
                    ss += ((r0[0] * r0[0] + r0[1] * r0[1]) + (r0[2] * r0[2] + r0[3] * r0[3])) + ((r1[0] * r1[0] + r1[1] * r1[1]) + (r1[2] * r1[2] + r1[3] * r1[3])); }
                ss += __shfl_xor(ss, 16); ss += __shfl_xor(ss, 32);
                if (fq == 0) pssq[(size_t)row * 16 + u.pn * 4 + wc] = ss; }
            asm volatile("" ::: "memory"); }
    }
};

__device__ __forceinline__ void router_pass(Frame& F, const Args& a, int l) {
    LAUNDER_LANES();
    typedef short bf16x8_t __attribute__((ext_vector_type(8)));
    constexpr int WST = 2064;
    LAS char* WB = (LAS char*)(F.lds + RING_OFF);
    LAS float* sc = (LAS float*)(F.lds + RING_OFF + 32 * WST) + wave * 16;
    const GAS char* wsrc = (const GAS char*)(F.ws + WS_MISC + MO_WR) + (size_t)l * 32 * DM * 2;
    for (int c = tid; c < 32 * 128; c += 512) { const int r = c >> 7, ch = c & 127; *(LAS v4u*)(WB + r * WST + ch * 16) = *(const GAS v4u*)(wsrc + (size_t)r * 2048 + ch * 16); }
    __syncthreads();
    gf32* aff = (gf32*)MISCP(float, MO_AFF); gf32* rsf = (gf32*)MISCP(float, MO_RSF);
    const int gw = F.vcu * NWAVES + wave, NGW = F.G * NWAVES, fr = lane & 15, fq = lane >> 4;
    for (int grp = gw; grp < TOK / 16; grp += NGW) {
        const int row0 = grp * 16;
        const GAS char* ap = (const GAS char*)F.hb + ((size_t)(row0 + fr) * DM + fq * 8) * 2;
        const LAS char* bp = WB + fr * WST + fq * 16;
        f32x4 ah = {0.f, 0.f, 0.f, 0.f}, al = {0.f, 0.f, 0.f, 0.f}, as = {0.f, 0.f, 0.f, 0.f};
#pragma unroll 8
        for (int ks = 0; ks < 32; ++ks) { const bf16x8_t av = *(const GAS bf16x8_t*)(ap + ks * 64);
            const bf16x8_t bh = *(const LAS bf16x8_t*)(bp + ks * 64), bl = *(const LAS bf16x8_t*)(bp + 16 * WST + ks * 64);
            ah = __builtin_amdgcn_mfma_f32_16x16x32_bf16(av, bh, ah, 0, 0, 0); al = __builtin_amdgcn_mfma_f32_16x16x32_bf16(av, bl, al, 0, 0, 0);
            as = __builtin_amdgcn_mfma_f32_16x16x32_bf16(av, av, as, 0, 0, 0); }
        { const float d = (fr & 3) == 0 ? as[0] : (fr & 3) == 1 ? as[1] : (fr & 3) == 2 ? as[2] : as[3]; if ((fr >> 2) == fq) sc[fr] = d; }
        LDS_WAIT();
        const f32x4 ssq = *(const LAS f32x4*)(sc + 4 * fq);
#pragma unroll
        for (int r = 0; r < 4; ++r) { const float rs = 1.0f / sqrtf(ssq[r] * (1.f / DM) + NORM_EPS); const float lg = (ah[r] + al[r]) * rs;
            float mx = lg; mx = fmaxf(mx, __shfl_xor(mx, 1)); mx = fmaxf(mx, __shfl_xor(mx, 2)); mx = fmaxf(mx, __shfl_xor(mx, 4)); mx = fmaxf(mx, __shfl_xor(mx, 8));
            const float ex = __expf(lg - mx); float sm = ex; sm += __shfl_xor(sm, 1); sm += __shfl_xor(sm, 2); sm += __shfl_xor(sm, 4); sm += __shfl_xor(sm, 8);
            const int m = row0 + 4 * fq + r;
            aff[((size_t)(m >> 12) * NEXP + fr) * SEQ + (m & (SEQ - 1))] = ex / sm;
            if (fr == 0) rsf[m] = rs; }
        LDS_WAIT(); asm volatile("" ::: "memory");
    }
}
__device__ __forceinline__ unsigned block_excl_scan(unsigned v, LAS unsigned* wsum, int lane, int wave) {
    unsigned s = v;
#pragma unroll
    for (int d = 1; d < 64; d <<= 1) { const unsigned t = __shfl_up(s, d); if (lane >= d) s += t; }
    if (lane == 63) wsum[wave] = s;
    __syncthreads();
    unsigned base = 0;
    for (int w = 0; w < wave; ++w) base += wsum[w];
    __syncthreads();
    return base + s - v;
}
__device__ __forceinline__ void topk_block(Frame& F, int be) {
    LAUNDER_LANES();
    LAS unsigned* hist = (LAS unsigned*)(F.lds + RING_OFF); LAS unsigned* ctl = hist + 256; LAS unsigned* wsum = hist + 272;
    const float* aff = MISCP(float, MO_AFF) + (size_t)be * SEQ; const float* rsf = MISCP(float, MO_RSF);
    unsigned* sidx = MISCP(unsigned, MO_SIDX) + be * CAP; float* sg = MISCP(float, MO_SG) + be * CAP; float* srs = MISCP(float, MO_SRS) + be * CAP; int* inv = MISCP(int, MO_INV);
    const int b = be >> 4, e = be & 15;
    unsigned key[8];
    { const v4u k0 = *(const GAS v4u*)(aff + tid * 8), k1 = *(const GAS v4u*)(aff + tid * 8 + 4); key[0] = k0.x; key[1] = k0.y; key[2] = k0.z; key[3] = k0.w; key[4] = k1.x; key[5] = k1.y; key[6] = k1.z; key[7] = k1.w; }
    unsigned prefix = 0, need = CAP;
#pragma unroll
    for (int pass = 0; pass < 4; ++pass) { const int shift = 24 - 8 * pass;
        if (tid < 256) hist[tid] = 0u;
        __syncthreads();
#pragma unroll
        for (int i = 0; i < 8; ++i) { const bool match = (pass == 0) ? true : ((key[i] >> ((shift + 8) & 31)) == prefix); if (match) (void)__hip_atomic_fetch_add(&hist[(key[i] >> shift) & 255u], 1u, __ATOMIC_RELAXED, __HIP_MEMORY_SCOPE_WORKGROUP); }
        __syncthreads();
        if (wave == 0) { const unsigned h0 = hist[255 - 4 * lane], h1 = hist[254 - 4 * lane], h2 = hist[253 - 4 * lane], h3 = hist[252 - 4 * lane]; const unsigned c = h0 + h1 + h2 + h3; unsigned s = c;
#pragma unroll
            for (int d = 1; d < 64; d <<= 1) { const unsigned t = __shfl_up(s, d); if (lane >= d) s += t; }
            const unsigned excl = s - c;
            if (excl < need && need <= s) { const unsigned r = need - excl; unsigned bin, above;
                if (r <= h0) { bin = 255 - 4 * lane; above = 0; } else if (r <= h0 + h1) { bin = 254 - 4 * lane; above = h0; } else if (r <= h0 + h1 + h2) { bin = 253 - 4 * lane; above = h0 + h1; } else { bin = 252 - 4 * lane; above = h0 + h1 + h2; }
                ctl[0] = (prefix << 8) | bin; ctl[1] = r - above; } }
        __syncthreads();
        prefix = ctl[0]; need = ctl[1];
    }
    const unsigned T = prefix;
    unsigned cgt = 0, ceq = 0;
#pragma unroll
    for (int i = 0; i < 8; ++i) { cgt += key[i] > T ? 1u : 0u; ceq += key[i] == T ? 1u : 0u; }
    const unsigned eqb = block_excl_scan(ceq, wsum, lane, wave);
    const unsigned take = (eqb >= need) ? 0u : ((need - eqb) < ceq ? (need - eqb) : ceq);
    unsigned pos = block_excl_scan(cgt + take, wsum, lane, wave);
    unsigned eqr = 0;
#pragma unroll
    for (int i = 0; i < 8; ++i) { const int s = tid * 8 + i; bool sel = key[i] > T; if (key[i] == T) { sel = eqr < take; ++eqr; }
        const int grow = b * SEQ + s;
        if (sel) { sidx[pos] = (unsigned)grow; sg[pos] = __uint_as_float(key[i]); srs[pos] = rsf[grow]; inv[(size_t)grow * NEXP + e] = (int)pos; ++pos; }
        else inv[(size_t)grow * NEXP + e] = -1; }
    __syncthreads();
}
__device__ __forceinline__ void combine_pass(Frame& F) {
    LAUNDER_LANES();
    const GAS int* inv = (const GAS int*)MISCP(int, MO_INV); cgbf16* Y = (cgbf16*)(F.ws + WS_BIG + BOX(BO_Y, 128)); gbf16* hb = (gbf16*)F.hb; gf32* rsp = (gf32*)MISCP(float, MO_RSP);
    const bool loc = (F.G == 256); const int NGW = loc ? 256 : F.G * NWAVES, gw = loc ? (F.vcu >> 5) * SEQ + (F.vcu & 31) * NWAVES + wave : F.vcu * NWAVES + wave, mend = loc ? ((F.vcu >> 5) + 1) * SEQ : TOK;
    v2u hn[4]; int ivn = -1;
    if (gw < mend) { const GAS v2u* hr = (const GAS v2u*)(hb + (size_t)gw * DM) + lane;
#pragma unroll
        for (int j = 0; j < 4; ++j) hn[j] = hr[64 * j];
        ivn = (lane < 16) ? inv[(size_t)gw * NEXP + lane] : -1; }
    for (int m = gw; m < mend; m += NGW) {
        f32x4 v[4]; const int ivl = ivn;
#pragma unroll
        for (int j = 0; j < 4; ++j) { v[j][0] = __uint_as_float(hn[j].x << 16); v[j][1] = __uint_as_float(hn[j].x & 0xffff0000u); v[j][2] = __uint_as_float(hn[j].y << 16); v[j][3] = __uint_as_float(hn[j].y & 0xffff0000u); }
        const int mn = m + NGW;
        if (mn < mend) { const GAS v2u* hr = (const GAS v2u*)(hb + (size_t)mn * DM) + lane;
#pragma unroll
            for (int j = 0; j < 4; ++j) hn[j] = hr[64 * j];
            ivn = (lane < 16) ? inv[(size_t)mn * NEXP + lane] : -1; }
        unsigned mk = (unsigned)__ballot(ivl >= 0) & 0xffffu;
        cgbf16* ybase = Y + (size_t)(m >> 12) * NEXP * CAP * DM + 4 * lane;
        while (mk) {
            v2u y[4][4]; bool has[4];
#pragma unroll
            for (int g = 0; g < 4; ++g) { has[g] = mk != 0u; const int e = has[g] ? (__builtin_ctz(mk)) : 0; if (has[g]) mk &= mk - 1u;
                const int pos = __builtin_amdgcn_readlane(ivl, e);
                if (has[g]) { const GAS v2u* yr = (const GAS v2u*)(ybase + ((size_t)e * CAP + pos) * DM);
#pragma unroll
                    for (int j = 0; j < 4; ++j) y[g][j] = __builtin_nontemporal_load(yr + 64 * j); } }
#pragma unroll
            for (int g = 0; g < 4; ++g) if (has[g]) {
#pragma unroll
                for (int j = 0; j < 4; ++j) { v[j][0] += __uint_as_float(y[g][j].x << 16); v[j][1] += __uint_as_float(y[g][j].x & 0xffff0000u); v[j][2] += __uint_as_float(y[g][j].y << 16); v[j][3] += __uint_as_float(y[g][j].y & 0xffff0000u); } }
        }
        gbf16* ho = hb + (size_t)m * DM + 4 * lane; float s = 0.f;
#pragma unroll
        for (int j = 0; j < 4; ++j) { st_bf4(ho + 256 * j, v[j]); s += (v[j][0] * v[j][0] + v[j][1] * v[j][1]) + (v[j][2] * v[j][2] + v[j][3] * v[j][3]); }
        const float rs = 1.0f / sqrtf(wave_sum(s) * (1.f / DM) + NORM_EPS);
        if (lane == 0) rsp[m] = rs;
    }
}

__device__ __forceinline__ void attention_phase(Frame& F, const Args& a, int l) {
    const GAS bf16* big = (const GAS bf16*)(F.ws + WS_BIG); GAS bf16* ocat = (GAS bf16*)(F.ws + WS_OCAT);
    const GAS bf16* naqkv = (const GAS bf16*)((const GAS char*)big + BOX(BO_NAQKV, 48)); const GAS bf16* krp = (const GAS bf16*)((const GAS char*)big + BOX(BO_KR, 2));
    const GAS bf16* swq = (const GAS bf16*)((const GAS char*)big + BOX(BO_SWQ, 16)); const GAS bf16* swk = (const GAS bf16*)((const GAS char*)big + BOX(BO_SWK, 8)); const GAS bf16* swv = (const GAS bf16*)((const GAS char*)big + BOX(BO_SWV, 8));
    const GAS bf16* qm = (const GAS bf16*)((const GAS char*)big + BOX(BO_QM, 48)); const GAS bf16* kn = (const GAS bf16*)((const GAS char*)big + BOX(BO_KN, 32)); const GAS bf16* vm = (const GAS bf16*)((const GAS char*)big + BOX(BO_VM, 32));
    LAS char* lds = (LAS char*)(F.lds + RING_OFF);
    DUP(15) PH(15) for (int i = 0; i < 2 * 256; i += 1) {
        int uidx;
        if (F.G == 256) { if (i >= 2) break; const int x = F.vcu >> 5, v = F.vcu & 31; uidx = ((x * 8 + 4 * i + (v >> 3)) << 3) | (v & 7); }
        else { uidx = F.vcu + i * F.G; if (uidx >= 512) break; }
        const int bh = uidx >> 3, qb = uidx & 7, b = bh >> 3, h = bh & 7; const size_t r0 = (size_t)b * SEQ;
        att::AttnIO io; io.q = qm + (r0 + qb * 512) * 768 + h * 96; io.ldq = 768; io.k = kn + r0 * 512 + h * 64; io.ldk = 512; io.k2 = krp + r0 * 32; io.ldk2 = 32;
        io.v = vm + r0 * 512 + h * 64; io.ldv = 512; io.o = ocat + (r0 + qb * 512) * DM + 256 + h * 64; io.ldo = DM;
        const unsigned* km = (const unsigned*)(F.ws + WS_CTL) + CW_KMAX; const float km2 = __uint_as_float(__hip_atomic_load(km + bh * 2, __ATOMIC_RELAXED, __HIP_MEMORY_SCOPE_AGENT)) + __uint_as_float(__hip_atomic_load(km + bh * 2 + 1, __ATOMIC_RELAXED, __HIP_MEMORY_SCOPE_AGENT)) + __uint_as_float(__hip_atomic_load(km + 128 + b, __ATOMIC_RELAXED, __HIP_MEMORY_SCOPE_AGENT));
        int role; if (att::mla_block_fixed<2>(io, km2, lds, role)) att::attn_unit16<4>(io, role, lds);
        else { att::attn_unit<0, false>(io, 0, 0.f, nullptr, lds); io.q += (size_t)256 * io.ldq; io.o += (size_t)256 * io.ldo; att::attn_unit<0, false>(io, 0, 0.f, nullptr, lds); }
    }
    DUP(16) PH(16) for (int uq = F.vcu; uq < 512; uq += F.G) { const int uidx = (F.G == 256) ? ((F.vcu >> 5) << 6) | ((uq >> 8) << 5) | (F.vcu & 31) : uq;
        const int r4 = uidx & 15, h = (uidx >> 4) & 3, b = uidx >> 6; const size_t r0 = (size_t)b * SEQ;
        att::AttnIO io; io.q = naqkv + (r0 + r4 * 256) * 768 + h * 64; io.ldq = 768; io.k = naqkv + r0 * 768 + 256 + h * 64; io.ldk = 768; io.k2 = nullptr; io.ldk2 = 0;
        io.v = naqkv + r0 * 768 + 512 + h * 64; io.ldv = 768; io.o = ocat + (r0 + r4 * 256) * DM + h * 64; io.ldo = DM;
        att::attn_unit<1>(io, r4, 0.f, (const GAS float*)(a.in[I_NA_RPB] + ((size_t)l * 4 + h) * 465), lds);
    }
    DUP(17) PH(17) { int tid3_ = threadIdx.x; asm volatile("" : "+v"(tid3_)); const int wv = __builtin_amdgcn_readfirstlane(tid3_ >> 6);
      __syncthreads();
      for (int wt = F.vcu * 8 + wv; wt < 2048; wt += F.G * 8) {
#pragma unroll 1
        for (int k2 = 0; k2 < 2; ++k2) { const int tsk = wt * 2 + k2, jb = tsk & 127, h = (tsk >> 7) & 3, b = tsk >> 9; const size_t r0 = (size_t)b * SEQ;
          att::swa_wave_task(swq + r0 * 256 + h * 64, swk + r0 * 128 + (h >> 1) * 64, swv + r0 * 128 + (h >> 1) * 64, ocat + r0 * DM + 768 + h * 64, jb * 32,
                             a.in[I_SWA_SINK][l * 4 + h] * LOG2E, lds + wv * att::SWW_LDS); } }
      __syncthreads(); }
}

__global__ void __launch_bounds__(NWAVES * 64, 2) enc_fwd(Args args) {
    extern __shared__ __attribute__((aligned(16))) unsigned char lds[];
    Frame F;
    F.lds = (LAS unsigned char*)lds;
    F.MISC = (volatile LAS unsigned*)(F.lds + MISC_OFF);
    F.G = gridDim.x; { const int bx = blockIdx.x; F.vcu = (F.G % 8 == 0) ? (bx % 8) * (F.G / 8) + bx / 8 : bx; }
    F.ws = args.ws; F.out = args.out; F.xl = 0; F.xb = 0;
    for (int u = threadIdx.x; u < (GTAB_OFF - LDSCTL_OFF) / 4; u += NWAVES * 64) ((LAS unsigned*)(F.lds + LDSCTL_OFF))[u] = 0u;
    __syncthreads();
    XcdBarrier bar = xcd_barrier_post((unsigned*)(F.ws + WS_CTL) + CW_BAR, F.MISC + 8);
#define BAR_REFRESH() do { unsigned char* ws_ = args.ws; asm volatile("" : "+s"(ws_)); F.ws = ws_; bar.bar = (unsigned*)(ws_ + WS_CTL) + CW_BAR; Wl = lcur ? (bf16*)((char*)F.out + ((size_t)64 << 20)) : WSP(bf16, WS_W); hb = hb_in_out ? (bf16*)F.out : WSP(bf16, WS_HB); F.hb = hb; big = F.ws + WS_BIG; } while (0)
#define GRID_BAR() do { { unsigned x_ = bar.x; asm volatile("" : "+s"(x_)); bar.x = x_; } xcd_barrier(bar); BAR_REFRESH(); } while (0)
#define LAYER_BAR() do { if (xl_ok) { { unsigned x_ = bar.x; asm volatile("" : "+s"(x_)); bar.x = x_; } xcd_barrier(bar, false); } else { { unsigned x_ = bar.x; asm volatile("" : "+s"(x_)); bar.x = x_; } xcd_barrier(bar); } BAR_REFRESH(); } while (0)
    int lcur = 0;
    bool hb_in_out = false;
    bf16* Wl = WSP(bf16, WS_W); bf16* hb = WSP(bf16, WS_HB); unsigned char* big = F.ws + WS_BIG; F.hb = hb;
    const int bx = (int)blockIdx.x;

    DUP(0) PH(0) { convert_layer_weights(F, args, 0, true, WSP(bf16, WS_W));
    rope_tables(F, args);
    router_weights(F, args);
    x_to_hb(F, args);
    convert_p(F, args, 0, WSP(bf16, WS_PB));
    if (DEPTH > 1) { convert_layer_weights(F, args, 1, false, (bf16*)((char*)F.out + ((size_t)64 << 20))); convert_p(F, args, 1, (bf16*)(F.ws + WS_END)); } }
    static_assert(DEPTH <= 2, "weight regions");
    GRID_BAR();
    int cid = bx; bool xl_ok = false;
    { if (threadIdx.x == 0) { unsigned* bw = (unsigned*)(F.ws + WS_CTL) + CW_BAR; unsigned n32 = 0, sum = 0;
          for (unsigned j = 0; j < 16; ++j) { const unsigned c = xb_ld(&bw[XB_XCNT(j)]); sum += c; n32 += (c == 32u) ? 1u : 0u; }
          F.MISC[8 + 3] = (n32 == 8u && sum == 256u && F.G == 256) ? 1u : 0u; }
      __syncthreads();
      xl_ok = F.MISC[8 + 3] != 0u; const int rank = (int)F.MISC[8 + 2], xcc = (int)bar.x;
      if (xl_ok) { cid = __builtin_amdgcn_readfirstlane(rank * 8 + xcc); F.vcu = __builtin_amdgcn_readfirstlane(xcc * 32 + rank); F.xl = 1; F.xb = __builtin_amdgcn_readfirstlane(xcc); } }

    int done_layers = 0;
#pragma unroll 1
    for (int l = 0; l < DEPTH; ++l) {
        if (STOP_AFTER <= 10 * l) break;
        lcur = l; Wl = lcur ? (bf16*)((char*)F.out + ((size_t)64 << 20)) : WSP(bf16, WS_W);
        DUP(1) PH(1) { pg8::ProbPlain g{hb, (const bf16*)((char*)Wl + WO_IN), DM}; pg8::StaticOrder S; S.init(TOK, IN_WP, F.G, cid);
          EpiIn E{(cgf32*)MISCP(float, MO_PSSQ), (gf32*)MISCP(float, MO_GSSQ), (gbf16*)(big + BOX(BO_NAQKV, 48)), (gbf16*)(big + BOX(BO_CQ, 24)), (gbf16*)(big + BOX(BO_CKV, 16)), (gbf16*)(big + BOX(BO_KR, 2)), (gbf16*)(big + BOX(BO_SWQ, 16)), (gbf16*)(big + BOX(BO_SWK, 8)), (gbf16*)(big + BOX(BO_SWV, 8)),
                  (cgf32*)MISCP(float, MO_COS16), (cgf32*)MISCP(float, MO_SIN16), (cgf32*)MISCP(float, MO_COS32), (cgf32*)MISCP(float, MO_SIN32), (unsigned*)(F.ws + WS_CTL) + CW_KRMAX};
          pg8::gemm_phase<pg8::ProbPlain, EpiIn, pg8::StaticOrder, true>(F.lds + RING_OFF, g, S, E); }
        LAYER_BAR();
        const bool p2split = (F.G == 256);
        DUP(2) PH(2) if (!p2split || cid < 128) { pg8::ProbPlain g{(const bf16*)(big + BOX(BO_CQ, 24)), (const bf16*)((char*)Wl + WO_QUP), 384}; pg8::StaticOrder S; S.init(TOK, 768, p2split ? 128 : F.G, cid);
          EpiQup E{(cgf32*)MISCP(float, MO_GSSQ), (gbf16*)(big + BOX(BO_QM, 48)), (cgf32*)MISCP(float, MO_COS16), (cgf32*)MISCP(float, MO_SIN16)};
          pg8::gemm_phase<pg8::ProbPlain, EpiQup, pg8::StaticOrder, true>(F.lds + RING_OFF, g, S, E); }
        DUP(2) PH(3) if (!p2split || cid >= 128) { pg8::ProbPlain g{(const bf16*)(big + BOX(BO_CKV, 16)), (const bf16*)((char*)Wl + WO_KVUP), 256}; pg8::StaticOrder S; S.init(TOK, 1024, p2split ? 128 : F.G, p2split ? cid - 128 : cid);
          EpiKVup E{(cgf32*)MISCP(float, MO_GSSQ), (gbf16*)(big + BOX(BO_KN, 32)), (gbf16*)(big + BOX(BO_VM, 32)), (unsigned*)(F.ws + WS_CTL) + CW_KMAX};
          pg8::gemm_phase<pg8::ProbPlain, EpiKVup, pg8::StaticOrder, true>(F.lds + RING_OFF, g, S, E); }
        LAYER_BAR();
        DUP(4) PH(4) attention_phase(F, args, l);
        LAYER_BAR();
        PH(5) { pg8::ProbPlain g{WSP(bf16, WS_OCAT), (const bf16*)((char*)Wl + WO_OUT), DM}; pg8::StaticOrder S; S.init(TOK, DM, F.G, cid);
          EpiRes E{(gbf16*)hb};
          pg8::gemm_phase<pg8::ProbPlain, EpiRes, pg8::StaticOrder, true>(F.lds + RING_OFF, g, S, E); }
        LAYER_BAR();
        done_layers = l + 1;
        if (STOP_AFTER <= 10 * l + 1) break;
        DUP(6) PH(6) router_pass(F, args, l);
        LAYER_BAR();
        DUP(7) PH(7) { if (F.G == 256) { if (cid < 128) topk_block(F, (cid & 7) * NEXP + (cid >> 3)); }
                       else for (int be = bx; be < BATCH * NEXP; be += F.G) topk_block(F, be); }
        DUP(8) PH(8) { pg8::ProbPlain g{lcur ? (const bf16*)(F.ws + WS_END) : WSP(bf16, WS_PB), (const bf16*)((char*)Wl + WO_PP), PLE}; pg8::StaticOrder S; S.init(TOK, DM, (F.G == 256) ? (cid < 128 ? 512 : 128) : F.G, cid);
          EpiBf E{(gbf16*)WSP(bf16, WS_PPO), DM};
          pg8::gemm_phase<pg8::ProbPlain, EpiBf, pg8::StaticOrder, true>(F.lds + RING_OFF, g, S, E); }
        LAYER_BAR();
        DUP(9) PH(9) { pg8::StaticOrder S; S.init(NSLOT, DM, F.G, cid);
          LAS unsigned* gtab = (LAS unsigned*)(F.lds + GTAB_OFF); const unsigned* sidx = MISCP(unsigned, MO_SIDX);
          { LAUNDER_LANES(); Unit u; for (int i = 0; i < 8; ++i) if (S.next(i, u) && tid < 256) gtab[i * 256 + tid] = sidx[u.pm * 256 + tid]; }
          __syncthreads();
          pg8::ProbGather g{hb, (const bf16*)((char*)Wl + WO_GU), DM, (size_t)DM * DM, gtab};
          EpiSwiglu E{(cgf32*)MISCP(float, MO_SRS), (gbf16*)(big + BOX(BO_ACT, 64))};
          pg8::gemm_phase<pg8::ProbGather, EpiSwiglu, pg8::StaticOrder, true>(F.lds + RING_OFF, g, S, E); }
        LAYER_BAR();
        DUP(10) PH(10) { pg8::ProbExpert g{(const bf16*)(big + BOX(BO_ACT, 64)), (const bf16*)((char*)Wl + WO_DOWN), EFF, (size_t)DM * EFF}; pg8::StaticOrder S; S.init(NSLOT, DM, F.G, cid);
          EpiDown E{(cgf32*)MISCP(float, MO_SG), (gbf16*)(big + BOX(BO_Y, 128))};
          pg8::gemm_phase<pg8::ProbExpert, EpiDown, pg8::StaticOrder, true>(F.lds + RING_OFF, g, S, E); }
        LAYER_BAR();
        PH(11) combine_pass(F);
        if (STOP_AFTER <= 10 * l + 2) { GRID_BAR(); break; }
        LAYER_BAR();
        DUP(13) PH(13) { pg8::ProbPlain g{hb, WSP(bf16, WS_WPG) + (size_t)l * DM * DM, DM}; pg8::StaticOrder S; S.init(TOK, DM, F.G, cid);
          EpiPle E{(cgf32*)MISCP(float, MO_RSP), (cgbf16*)WSP(bf16, WS_PPO), (cgbf16*)hb, (gbf16*)(hb_in_out ? WSP(bf16, WS_HB) : (bf16*)F.out), (gf32*)MISCP(float, MO_PSSQ)};
          pg8::gemm_phase<pg8::ProbPlain, EpiPle, pg8::StaticOrder, true>(F.lds + RING_OFF, g, S, E); }
        hb_in_out = !hb_in_out;
        if (l == DEPTH - 1) GRID_BAR(); else LAYER_BAR();
    }
    DUP(14) PH(14) final_norm(F, args);
    if (bx == 0 && threadIdx.x == 0) { unsigned* b = (unsigned*)(F.ws + WS_CTL) + CW_BAR; if (xb_ld(&b[XB_TMO]) != 0u) { const float q = __builtin_nanf(""); F.out[0] = q; } }
#undef GRID_BAR
}

extern "C" void kernel_launch(void* const* d_in, const int* in_sizes, int n_in, void* d_out, int out_size, void* d_ws, size_t ws_size, hipStream_t stream) {
    static int grid = 0;
    if (grid == 0) {
        if (n_in != 20 || in_sizes[0] != TOK * DM || out_size != TOK * DM || ws_size < WS_END + (size_t)TOK * PLE * 2) {
            fprintf(stderr, "kernel_launch: unexpected shapes: n_in %d in0 %d out %d ws %zu (need %zu)\n", n_in, n_in > 0 ? in_sizes[0] : -1, out_size, ws_size, (size_t)WS_END); grid = -1; return; }
        int dev = 0, cus = 0, per_cu = 0;
        if (hipGetDevice(&dev) != hipSuccess || hipDeviceGetAttribute(&cus, hipDeviceAttributeMultiprocessorCount, dev) != hipSuccess) { grid = -1; return; }
        if (hipFuncSetAttribute((const void*)enc_fwd, hipFuncAttributeMaxDynamicSharedMemorySize, LDS_BYTES) != hipSuccess) { fprintf(stderr, "kernel_launch: hipFuncSetAttribute failed\n"); grid = -1; return; }
        if (hipOccupancyMaxActiveBlocksPerMultiprocessor(&per_cu, (const void*)enc_fwd, NWAVES * 64, LDS_BYTES) != hipSuccess || per_cu < 1) {
            fprintf(stderr, "kernel_launch: occupancy query reports %d workgroups per CU\n", per_cu); (void)hipGetLastError(); grid = -1; return; }
        if (cus < 128) { fprintf(stderr, "kernel_launch: needs >= 128 CUs\n"); grid = -1; return; }
        grid = cus;
    }
    if (grid < 0) return;
    if (hipMemsetAsync((char*)d_ws + WS_CTL, 0, CTL_ZERO_BYTES, stream) != hipSuccess) { fprintf(stderr, "kernel_launch: memset failed\n"); return; }
    Args a{};
    for (int i = 0; i < 20; ++i) a.in[i] = (const float*)d_in[i];
    a.out = (float*)d_out; a.ws = (unsigned char*)d_ws;
    for (int i = 0; i < 16; ++i) a.inv16[i] = 1.0 / pow(10000.0, (double)(2 * i) / 32.0);
    for (int i = 0; i < 32; ++i) a.inv32[i] = 1.0 / pow(10000.0, (double)(2 * i) / 64.0);
    void* kargs[] = {&a};
    const hipError_t le = hipLaunchCooperativeKernel((const void*)enc_fwd, dim3(grid), dim3(NWAVES * 64), kargs, LDS_BYTES, stream);
    if (le != hipSuccess) fprintf(stderr, "kernel_launch: launch failed: %s (grid %d)\n", hipGetErrorName(le), grid);
}
```

```cpp
#include <hip/hip_runtime.h>
#include <hip/hip_bf16.h>
#include <cstdio>
#include <cstdint>
#include <cmath>

#ifndef STOP_AFTER
#define STOP_AFTER 99
#endif

namespace pg8 {
#define PG8_LAS __attribute__((address_space(3)))
typedef unsigned short bf16_t;
typedef short bf16x8 __attribute__((ext_vector_type(8)));
typedef float f32x4 __attribute__((ext_vector_type(4)));
typedef unsigned u32x4 __attribute__((ext_vector_type(4)));
typedef unsigned u32x2 __attribute__((ext_vector_type(2)));
constexpr int BM = 256, BK = 64, HALF = 128, HTB = HALF * BK * 2  , STAGE_BYTES = 8 * HTB, NXCD = 8, WGM = 8;

__host__ __device__ __forceinline__ int lds_byte(int r, int c) { const int st = (r >> 4) * 2 + (c >> 5), rr = r & 15, cc = c & 31, ob = rr * 64 + cc * 2; return st * 1024 + (ob ^ (((ob >> 9) & 1) << 5)); }
__host__ __device__ __forceinline__ int perm32(int rho) { const int n = rho >> 4, i = rho & 15; return 8 * (i >> 2) + 4 * n + (i & 3); }
__host__ __device__ __forceinline__ void stage_rc(int b, int& R, int& C) { const int st = b / 1024, sb = b % 1024, swz = sb ^ (((sb >> 9) & 1) << 5); R = (st >> 1) * 16 + swz / 64; C = (st & 1) * 32 + (swz % 64) / 2; }

struct Unit { int pm, pn; };

struct StaticOrder {
    int nM, nN, nwg, G, c;
    __host__ __device__ __forceinline__ void init(int M, int N, int G_, int c_) { nM = M / BM; nN = N / BM; nwg = nM * nN; G = G_; c = c_; }
    __host__ __device__ __forceinline__ bool next(int i, Unit& u) const {
        const long L = (long)i * G + c; if (L >= nwg) return false;
        int wgid = (int)L; { const int q = nwg / NXCD, r = nwg % NXCD, xcd = wgid % NXCD, off = wgid / NXCD; wgid = (xcd < r ? xcd * (q + 1) : r * (q + 1) + (xcd - r) * q) + off; }
        const int nig = WGM * nN, gid = wgid / nig, fm = gid * WGM, gsz = (nM - fm) < WGM ? (nM - fm) : WGM;
        u.pm = fm + ((wgid % nig) % gsz); u.pn = (wgid % nig) / gsz; return true;
    }
};

struct ExpertOrder : StaticOrder {
    __host__ __device__ __forceinline__ bool next(int i, Unit& u) const { if (!StaticOrder::next(i, u)) return false; const int q = u.pm; u.pm = ((((q >> 1) & 7) * 16 + (q >> 4)) << 1) | (q & 1); return true; }
};

struct ProbPlain {
    static constexpr bool GATHER = false;
    const bf16_t* A; const bf16_t* Bt; int K;
    __device__ __forceinline__ const char* a_tile(const Unit& u) const { return (const char*)A + (size_t)u.pm * BM * K * 2; }
    __device__ __forceinline__ const char* a_base() const { return (const char*)A; }
    __device__ __forceinline__ unsigned a_off(int, const Unit& u, int r, int C) const { return (unsigned)(((u.pm * BM + r) * K + C) * 2); }
    __device__ __forceinline__ const char* b_tile(const Unit& u) const { return (const char*)Bt + (size_t)u.pn * BM * K * 2; }
};
struct ProbExpert {
    static constexpr bool GATHER = false;
    const bf16_t* A; const bf16_t* Bt; int K; size_t estride;
    __device__ __forceinline__ const char* a_tile(const Unit& u) const { return (const char*)A + (size_t)u.pm * BM * K * 2; }
    __device__ __forceinline__ const char* a_base() const { return (const char*)A; }
    __device__ __forceinline__ unsigned a_off(int, const Unit& u, int r, int C) const { return (unsigned)(((u.pm * BM + r) * K + C) * 2); }
    __device__ __forceinline__ const char* b_tile(const Unit& u) const { return (const char*)Bt + ((size_t)((u.pm >> 1) & 15) * estride + (size_t)u.pn * BM * K) * 2; }
};
struct ProbGather {
    static constexpr bool GATHER = true;
    const bf16_t* A; const bf16_t* Bt; int K; size_t estride; const PG8_LAS unsigned* gtab;
    __device__ __forceinline__ const char* a_tile(const Unit&) const { return (const char*)A; }
    __device__ __forceinline__ const char* a_base() const { return (const char*)A; }
    __device__ __forceinline__ unsigned a_off(int ui, const Unit&, int r, int C) const { return (unsigned)((gtab[ui * BM + r] * (unsigned)K + (unsigned)C) * 2u); }
    __device__ __forceinline__ const char* b_tile(const Unit& u) const { return (const char*)Bt + ((size_t)((u.pm >> 1) & 15) * estride + (size_t)u.pn * BM * K) * 2; }
};

template <class Prob, class Epi, class Sched, bool ALIGN_EPI>
__device__ __forceinline__ void gemm_phase(PG8_LAS unsigned char* lds, const Prob& g, const Sched& S, const Epi& E) {
    int tid_ = threadIdx.x; asm volatile("" : "+v"(tid_));
    const int tid = tid_, wid = __builtin_amdgcn_readfirstlane(tid >> 6), lane = tid & 63, wr = wid >> 2, wc = wid & 3, fr = lane & 15, fq = lane >> 4;
    const int K = g.K, nt = K / BK;
    int RA[2], CA[2]; unsigned voffB[2], voffA[2];
#pragma unroll
    for (int i = 0; i < 2; ++i) { int R, C; stage_rc(tid * 16 + i * 8192, R, C); RA[i] = R; CA[i] = C; voffA[i] = (unsigned)(R * K + C) * 2u; voffB[i] = (unsigned)(((R & ~31) + perm32(R & 31)) * K + C) * 2u; }
    constexpr bool GATHER = Prob::GATHER;
    const size_t kstep = (size_t)(BK * 2);
    const size_t hstep = (size_t)HALF * K * 2;
    const unsigned ldsw = (unsigned)wid * 1024u;
    const int aoff = lds_byte(wr * 64 + fr, fq * 8), boff = lds_byte(wc * 32 + fr, fq * 8);
#define PG8_SA(b, h) (((b) * 2 + (h)) * HTB)
#define PG8_SB(b, h) ((4 + (b) * 2 + (h)) * HTB)
#define PG8_STAGE_B(bufoff, gbase) do { _Pragma("unroll") for (int _i = 0; _i < 2; ++_i) \
        __builtin_amdgcn_global_load_lds((const unsigned*)((const char*)(gbase) + voffB[_i]), (PG8_LAS unsigned*)(lds + (bufoff) + ldsw + _i * 8192), 16, 0, 0); } while (0)
#define PG8_STAGE_A(bufoff, PT, kb, OFF, h) do { _Pragma("unroll") for (int _i = 0; _i < 2; ++_i) { \
        if constexpr (GATHER) __builtin_amdgcn_global_load_lds((const unsigned*)(Ab + (size_t)(kb) + (size_t)(OFF)[h][_i]), (PG8_LAS unsigned*)(lds + (bufoff) + ldsw + _i * 8192), 16, 0, 0); \
        else __builtin_amdgcn_global_load_lds((const unsigned*)((PT) + (size_t)(kb) + (size_t)(h) * hstep + voffA[_i]), (PG8_LAS unsigned*)(lds + (bufoff) + ldsw + _i * 8192), 16, 0, 0); } } while (0)
#define PG8_LDA(dst, b, h) do { _Pragma("unroll") for (int m = 0; m < 4; ++m) _Pragma("unroll") for (int k = 0; k < 2; ++k) dst[m][k] = *(const PG8_LAS bf16x8*)(lds + PG8_SA(b, h) + aoff + m * 2048 + k * 1024); } while (0)
#define PG8_LDB(dst, b, h) do { _Pragma("unroll") for (int n = 0; n < 2; ++n) _Pragma("unroll") for (int k = 0; k < 2; ++k) dst[n][k] = *(const PG8_LAS bf16x8*)(lds + PG8_SB(b, h) + boff + n * 2048 + k * 1024); } while (0)
#define PG8_MMA(ai, bj, At, Bt) do { __builtin_amdgcn_s_setprio(1); _Pragma("unroll") for (int m = 0; m < 4; ++m) _Pragma("unroll") for (int n = 0; n < 2; ++n) _Pragma("unroll") for (int k = 0; k < 2; ++k) \
        acc[ai][bj][m][n] = __builtin_amdgcn_mfma_f32_16x16x32_bf16(Bt[n][k], At[m][k], acc[ai][bj][m][n], 0, 0, 0); __builtin_amdgcn_s_setprio(0); } while (0)
#define PG8_WAIT_V(n) asm volatile("s_waitcnt vmcnt(" #n ")" ::: "memory")
#define PG8_WAIT_L(n) asm volatile("s_waitcnt lgkmcnt(" #n ")" ::: "memory")
#define PG8_BAR __builtin_amdgcn_s_barrier()
#define PG8_SCHED __builtin_amdgcn_sched_barrier(0)
    Unit cur, nxt; int ui = 0;
    if (!S.next(0, cur)) return;
    f32x4 acc[2][2][4][2];
#pragma unroll
    for (int a = 0; a < 2; ++a)
#pragma unroll
        for (int b = 0; b < 2; ++b)
#pragma unroll
            for (int m = 0; m < 4; ++m)
#pragma unroll
                for (int n = 0; n < 2; ++n) acc[a][b][m][n] = (f32x4){0.f, 0.f, 0.f, 0.f};
    bf16x8 At[4][2], B0[2][2], B1[2][2];
    unsigned aC[2][2], aN[2][2];
    if constexpr (GATHER) {
#pragma unroll
    for (int h = 0; h < 2; ++h)
#pragma unroll
        for (int i = 0; i < 2; ++i) aC[h][i] = g.a_off(0, cur, h * HALF + RA[i], CA[i]);
    }
    const char* const Ab = g.a_base(); const char* cB = g.b_tile(cur); const char* cA = g.a_tile(cur);
    PG8_STAGE_B(PG8_SB(0, 0), cB); PG8_STAGE_B(PG8_SB(0, 1), cB + hstep); PG8_STAGE_A(PG8_SA(0, 0), cA, 0, aC, 0); PG8_STAGE_A(PG8_SA(0, 1), cA, 0, aC, 1);
    if (wr == 1) PG8_BAR;
    PG8_WAIT_V(2); PG8_BAR;
    PG8_STAGE_B(PG8_SB(1, 0), cB + kstep); PG8_STAGE_A(PG8_SA(1, 0), cA, kstep, aC, 0); PG8_STAGE_B(PG8_SB(1, 1), cB + hstep + kstep);
    PG8_WAIT_V(6); PG8_BAR;
    for (;;) {
        const bool has_next = S.next(ui + 1, nxt);
        const char* nB = cB; const char* nA = cA;
        if (has_next) {
            if constexpr (GATHER) {
#pragma unroll
            for (int h = 0; h < 2; ++h)
#pragma unroll
                for (int i = 0; i < 2; ++i) aN[h][i] = g.a_off(ui + 1, nxt, h * HALF + RA[i], CA[i]);
            }
            nB = g.b_tile(nxt); nA = g.a_tile(nxt);
        } else {
            if constexpr (GATHER) {
#pragma unroll
            for (int h = 0; h < 2; ++h)
#pragma unroll
                for (int i = 0; i < 2; ++i) aN[h][i] = aC[h][i];
            }
        }
        for (int t = 0; t < nt; t += 2) {
            const bool last = (t == nt - 2);
            const size_t k1 = (size_t)(t + 1) * kstep;
            const size_t k2 = last ? (size_t)0 : (size_t)(t + 2) * kstep, k3 = k2 + kstep;
            const char* b2 = last ? nB : cB + (size_t)(t + 2) * kstep; const char* b3 = b2 + kstep;
            const char* a2p = last ? nA : cA;
            unsigned a2[2][2];
            if constexpr (GATHER) {
#pragma unroll
            for (int h = 0; h < 2; ++h)
#pragma unroll
                for (int i = 0; i < 2; ++i) a2[h][i] = last ? aN[h][i] : aC[h][i];
            }
            PG8_LDB(B0, 0, 0); PG8_LDB(B1, 0, 1); PG8_SCHED; PG8_LDA(At, 0, 0); PG8_STAGE_A(PG8_SA(1, 1), cA, k1, aC, 1);
            PG8_WAIT_V(8); PG8_WAIT_L(0); PG8_BAR; PG8_MMA(0, 0, At, B0); PG8_MMA(0, 1, At, B1); PG8_BAR; PG8_SCHED;
            PG8_LDA(At, 0, 1); PG8_STAGE_B(PG8_SB(0, 0), b2); PG8_STAGE_B(PG8_SB(0, 1), b2 + hstep); PG8_STAGE_A(PG8_SA(0, 0), a2p, k2, a2, 0);
            PG8_WAIT_V(8); PG8_WAIT_L(0); PG8_BAR; PG8_MMA(1, 0, At, B0); PG8_MMA(1, 1, At, B1); PG8_BAR; PG8_SCHED;
            PG8_LDB(B0, 1, 0); PG8_LDB(B1, 1, 1); PG8_SCHED; PG8_LDA(At, 1, 0); PG8_STAGE_A(PG8_SA(0, 1), a2p, k2, a2, 1);
            PG8_WAIT_V(8); PG8_WAIT_L(0); PG8_BAR; PG8_MMA(0, 0, At, B0); PG8_MMA(0, 1, At, B1); PG8_BAR; PG8_SCHED;
            PG8_LDA(At, 1, 1); PG8_STAGE_B(PG8_SB(1, 0), b3); PG8_STAGE_B(PG8_SB(1, 1), b3 + hstep); PG8_STAGE_A(PG8_SA(1, 0), a2p, k3, a2, 0);
            PG8_WAIT_V(8); PG8_WAIT_L(0); PG8_BAR; PG8_MMA(1, 0, At, B0); PG8_MMA(1, 1, At, B1); PG8_BAR; PG8_SCHED;
        }
        if constexpr (ALIGN_EPI) { if (wr == 0) PG8_BAR; }
        E(acc, cur, ui, wr, wc, fr, fq);
        if (!has_next) break;
#pragma unroll
        for (int a = 0; a < 2; ++a)
#pragma unroll
            for (int b = 0; b < 2; ++b)
#pragma unroll
                for (int m = 0; m < 4; ++m)
#pragma unroll
                    for (int n = 0; n < 2; ++n) acc[a][b][m][n] = (f32x4){0.f, 0.f, 0.f, 0.f};
        cur = nxt; cB = nB; cA = nA; ++ui;
        if constexpr (GATHER) {
#pragma unroll
        for (int h = 0; h < 2; ++h)
#pragma unroll
            for (int i = 0; i < 2; ++i) aC[h][i] = aN[h][i];
        }
        if constexpr (ALIGN_EPI) { if (wr == 1) PG8_BAR; }
    }
    PG8_WAIT_V(0);
    if constexpr (!ALIGN_EPI) { if (wr == 0) PG8_BAR; }
    PG8_BAR;
#undef PG8_SA
#undef PG8_SB
#undef PG8_STAGE_A
#undef PG8_STAGE_B
#undef PG8_LDA
#undef PG8_LDB
#undef PG8_MMA
#undef PG8_WAIT_V
#undef PG8_WAIT_L
#undef PG8_BAR
#undef PG8_SCHED
}
}
namespace att {
#define ATT_LAS __attribute__((address_space(3)))
#define ATT_GAS __attribute__((address_space(1)))
typedef unsigned short bf16;
using bf16x8 = __attribute__((ext_vector_type(8))) short;
using s16x4  = __attribute__((ext_vector_type(4))) short;
using f32x16 = __attribute__((ext_vector_type(16))) float;
using u32x4  = __attribute__((ext_vector_type(4))) unsigned;
constexpr int NW = 8, QBLK = 32, KVBLK = 64;
constexpr float THR = 8.f;
constexpr int SHM_V = 8192, KBUF = 13312, OFF_K = 3 * SHM_V, OFF_WS = OFF_K + 3 * KBUF, OFF_BT = OFF_WS + NW * 64 * 4, OFF_OST = OFF_BT + 8192, LDS_BYTES = OFF_OST + NW * 4608;
#define SBAR() __builtin_amdgcn_sched_barrier(0)
__device__ __forceinline__ int crow(int r, int hi) { return (r & 3) + 8 * (r >> 2) + 4 * hi; }
__device__ __forceinline__ unsigned cvtpk(float lo, float hi) { unsigned r; asm volatile("v_cvt_pk_bf16_f32 %0, %1, %2" : "=v"(r) : "v"(lo), "v"(hi)); return r; }
__device__ __forceinline__ int clampi(int v, int lo, int hi) { return v < lo ? lo : (v > hi ? hi : v); }

template <bool TWO>
__device__ __forceinline__ void partialSM(f32x16& p0, f32x16& p1, float& m_reg, f32x16& negm, f32x16& negm2, float& alpha, bool& have_ref) {
  float pmax = fmaxf(fmaxf(p0[0], p0[1]), p1[0]);
#pragma unroll
  for (int r = 2; r < 16; r += 2) pmax = fmaxf(fmaxf(pmax, p0[r]), p0[r + 1]);
#pragma unroll
  for (int r = 1; r < 15; r += 2) pmax = fmaxf(fmaxf(pmax, p1[r]), p1[r + 1]);
  pmax = fmaxf(pmax, p1[15]);
  { auto rr = __builtin_amdgcn_permlane32_swap(__float_as_uint(pmax), __float_as_uint(pmax), false, false);
    pmax = fmaxf(__uint_as_float(rr[0]), __uint_as_float(rr[1])); }
  alpha = 1.f;
  if (__builtin_expect(!have_ref || !__all(pmax <= THR), 0)) { const float dl = have_ref ? fmaxf(pmax, 0.f) : pmax; have_ref = true; m_reg += dl; alpha = __builtin_amdgcn_exp2f(-dl);
#pragma unroll
    for (int r = 0; r < 16; ++r) { p0[r] -= dl; p1[r] -= dl; }
#pragma unroll
    for (int r = 0; r < 16; ++r) negm[r] -= dl;
    asm volatile("" : "+v"(negm));
    if constexpr (TWO) {
#pragma unroll
      for (int r = 0; r < 16; ++r) negm2[r] -= dl;
      asm volatile("" : "+v"(negm2)); } }
#pragma unroll
  for (int r = 0; r < 16; ++r) p0[r] = __builtin_amdgcn_exp2f(p0[r]);
}
__device__ __forceinline__ float psm_max(const f32x16& p0, const f32x16& p1) {
  float pmax = fmaxf(fmaxf(p0[0], p0[1]), p1[0]);
#pragma unroll
  for (int r = 2; r < 16; r += 2) pmax = fmaxf(fmaxf(pmax, p0[r]), p0[r + 1]);
#pragma unroll
  for (int r = 1; r < 15; r += 2) pmax = fmaxf(fmaxf(pmax, p1[r]), p1[r + 1]);
  pmax = fmaxf(pmax, p1[15]);
  auto rr = __builtin_amdgcn_permlane32_swap(__float_as_uint(pmax), __float_as_uint(pmax), false, false);
  return fmaxf(__uint_as_float(rr[0]), __uint_as_float(rr[1]));
}
__device__ __forceinline__ void psm_decide(f32x16& p0, f32x16& p1, float pmax, float& m_reg, f32x16& negm, float& alpha, bool& have_ref) {
  alpha = 1.f;
  if (__builtin_expect(!have_ref || !__all(pmax <= THR), 0)) { const float dl = have_ref ? fmaxf(pmax, 0.f) : pmax; have_ref = true; m_reg += dl; alpha = __builtin_amdgcn_exp2f(-dl);
#pragma unroll
    for (int r = 0; r < 16; ++r) { p0[r] -= dl; p1[r] -= dl; }
#pragma unroll
    for (int r = 0; r < 16; ++r) negm[r] -= dl;
    asm volatile("" : "+v"(negm)); }
}
__device__ __forceinline__ void psm_exp(f32x16& p0) {
#pragma unroll
  for (int r = 0; r < 16; ++r) p0[r] = __builtin_amdgcn_exp2f(p0[r]);
}
__device__ __forceinline__ void finishSM(f32x16& p0, f32x16& p1, float alpha, float& l_reg, bf16x8& pa0, bf16x8& pa1, bf16x8& pa2, bf16x8& pa3) {
#pragma unroll
  for (int r = 0; r < 16; ++r) p1[r] = __builtin_amdgcn_exp2f(p1[r]);
  float ps;
  { typedef float f8 __attribute__((ext_vector_type(8))); typedef float f4 __attribute__((ext_vector_type(4))); typedef float f2 __attribute__((ext_vector_type(2)));
    const f32x16 t16 = p0 + p1; const f8 t8 = t16.lo + t16.hi; const f4 t4 = t8.lo + t8.hi; const f2 t2 = t4.lo + t4.hi; ps = t2.x + t2.y; }
  { auto rr = __builtin_amdgcn_permlane32_swap(__float_as_uint(ps), __float_as_uint(ps), false, false);
    ps = __uint_as_float(rr[0]) + __uint_as_float(rr[1]); }
  l_reg = l_reg * alpha + ps;
#define PK4(P, BASE, OUT) do { unsigned a0 = cvtpk(P[BASE + 0], P[BASE + 1]), a1 = cvtpk(P[BASE + 2], P[BASE + 3]);   \
    unsigned b0 = cvtpk(P[BASE + 4], P[BASE + 5]), b1 = cvtpk(P[BASE + 6], P[BASE + 7]);                              \
    auto r0 = __builtin_amdgcn_permlane32_swap(a0, b0, false, false); auto r1 = __builtin_amdgcn_permlane32_swap(a1, b1, false, false); \
    u32x4 w = {r0[0], r1[0], r0[1], r1[1]}; OUT = __builtin_bit_cast(bf16x8, w); } while (0)
  PK4(p0, 0, pa0); PK4(p0, 8, pa1); PK4(p1, 0, pa2); PK4(p1, 8, pa3);
#undef PK4
}
template <int DQK, int H> __device__ __forceinline__ void kload(bf16x8* kf, const ATT_LAS char* Ks, int r32, int hi) {
  constexpr int KST = DQK * 2 + 16, NH = DQK / 32;
#pragma unroll
  for (int i = 0; i < NH; ++i) { const int d0 = H * NH + i; const int cb = (d0 * 16 + hi * 8) * 2;
    kf[2 * i] = *(const ATT_LAS bf16x8*)(Ks + r32 * KST + cb);
    kf[2 * i + 1] = *(const ATT_LAS bf16x8*)(Ks + (32 + r32) * KST + cb); }
}
template <int DQK, int H> __device__ __forceinline__ void qk_mma(f32x16& p0, f32x16& p1, const bf16x8* kf, const bf16x8* qr, const f32x16& negm, const f32x16& negm2) {
  constexpr int NH = DQK / 32;
  if (H == 0) { p0 = negm; p1 = negm2; }
#pragma unroll
  for (int i = 0; i < NH; ++i) { const int d0 = H * NH + i;
    p0 = __builtin_amdgcn_mfma_f32_32x32x16_bf16(kf[2 * i], qr[d0], p0, 0, 0, 0);
    p1 = __builtin_amdgcn_mfma_f32_32x32x16_bf16(kf[2 * i + 1], qr[d0], p1, 0, 0, 0); }
}
__device__ __forceinline__ int v_st(int k, int c) { const int kk = (k & ~0xC) | ((k & 4) << 1) | ((k & 8) >> 1); return ((kk >> 3) * 2 + (c >> 5)) * 512 + ((kk & 7) * 32 + (c & 31)) * 2; }
__device__ __forceinline__ int v_rd_base(int lane) { return ((lane & 3) << 3) | (((lane >> 2) & 3) << 6) | (((lane >> 4) & 1) << 5) | (((lane >> 5) & 1) << 8); }
constexpr int v_rd_off(int d0, int ks, int half) { return d0 * 512 + ks * 2048 + half * 1024; }
typedef short v4i16_t __attribute__((ext_vector_type(4)));
__device__ __forceinline__ s16x4 vtr(const ATT_LAS char* p) { return __builtin_bit_cast(s16x4, __builtin_amdgcn_ds_read_tr16_b64_v4i16((ATT_LAS v4i16_t*)p)); }
__device__ __forceinline__ void vload(s16x4* vf, const ATT_LAS char* vp) {
#pragma unroll
  for (int d0 = 0; d0 < 2; ++d0)
#pragma unroll
    for (int ks = 0; ks < 4; ++ks) { vf[d0 * 8 + ks * 2] = vtr(vp + v_rd_off(d0, ks, 0)); vf[d0 * 8 + ks * 2 + 1] = vtr(vp + v_rd_off(d0, ks, 1)); }
}
template <int D0> __device__ __forceinline__ void pv_mma1(f32x16& od, const s16x4* vf, bf16x8 pa0, bf16x8 pa1, bf16x8 pa2, bf16x8 pa3) {
#define PKV(i) (bf16x8){vf[i][0], vf[i][1], vf[i][2], vf[i][3], vf[(i) + 1][0], vf[(i) + 1][1], vf[(i) + 1][2], vf[(i) + 1][3]}
  od = __builtin_amdgcn_mfma_f32_32x32x16_bf16(pa0, PKV(D0 * 8 + 0), od, 0, 0, 0);
  od = __builtin_amdgcn_mfma_f32_32x32x16_bf16(pa1, PKV(D0 * 8 + 2), od, 0, 0, 0);
  od = __builtin_amdgcn_mfma_f32_32x32x16_bf16(pa2, PKV(D0 * 8 + 4), od, 0, 0, 0);
  od = __builtin_amdgcn_mfma_f32_32x32x16_bf16(pa3, PKV(D0 * 8 + 6), od, 0, 0, 0);
#undef PKV
}
__device__ __forceinline__ void pv_mma(f32x16* o, const s16x4* vf, bf16x8 pa0, bf16x8 pa1, bf16x8 pa2, bf16x8 pa3) {
#define PKV(i) (bf16x8){vf[i][0], vf[i][1], vf[i][2], vf[i][3], vf[(i) + 1][0], vf[(i) + 1][1], vf[(i) + 1][2], vf[(i) + 1][3]}
#pragma unroll
  for (int d0 = 0; d0 < 2; ++d0) {
    o[d0] = __builtin_amdgcn_mfma_f32_32x32x16_bf16(pa0, PKV(d0 * 8 + 0), o[d0], 0, 0, 0);
    o[d0] = __builtin_amdgcn_mfma_f32_32x32x16_bf16(pa1, PKV(d0 * 8 + 2), o[d0], 0, 0, 0);
    o[d0] = __builtin_amdgcn_mfma_f32_32x32x16_bf16(pa2, PKV(d0 * 8 + 4), o[d0], 0, 0, 0);
    o[d0] = __builtin_amdgcn_mfma_f32_32x32x16_bf16(pa3, PKV(d0 * 8 + 6), o[d0], 0, 0, 0); }
#undef PKV
}

struct AttnIO { const ATT_GAS bf16* q; const ATT_GAS bf16* k; const ATT_GAS bf16* k2; const ATT_GAS bf16* v; ATT_GAS bf16* o; int ldq, ldk, ldk2, ldv, ldo; };

__device__ __forceinline__ bool mla_fixed_ref(const AttnIO io, float km2, float& mrow) {
  int tid_ = threadIdx.x; asm volatile("" : "+v"(tid_));
  const int wid = __builtin_amdgcn_readfirstlane(tid_ >> 6), lane = tid_ & 63, r32 = lane & 31, hi = lane >> 5;
  const ATT_GAS bf16* Qw = io.q + (size_t)(wid * QBLK + r32) * io.ldq + hi * 8; float q2 = 0.f;
#pragma unroll
  for (int d0 = 0; d0 < 6; ++d0) { const bf16x8 v = *(const ATT_GAS bf16x8*)(Qw + d0 * 16);
#pragma unroll
    for (int e = 0; e < 8; ++e) { const float x = __uint_as_float((unsigned)(unsigned short)v[e] << 16); q2 += x * x; } }
  { auto rr = __builtin_amdgcn_permlane32_swap(__float_as_uint(q2), __float_as_uint(q2), false, false); q2 = __uint_as_float(rr[0]) + __uint_as_float(rr[1]); }
  mrow = sqrtf(q2 * km2) * 1.02f;
  return __all(mrow <= 64.f);
}
template <int MODE, bool FIXED = false>
__device__ __forceinline__ void attn_unit(const AttnIO io, const int par, const float sinkl2, const ATT_GAS float* rpb_h, ATT_LAS char* lds) {
  constexpr int DQK = (MODE == 0) ? 96 : 64, ND0 = DQK / 16, KST = DQK * 2 + 16;
  int tid_ = threadIdx.x; asm volatile("" : "+v"(tid_));
  const int tid = tid_, wid = __builtin_amdgcn_readfirstlane(tid >> 6), lane = tid & 63, r32 = lane & 31, hi = lane >> 5;
  ATT_LAS char* V_lds = lds; ATT_LAS char* K_lds = lds + OFF_K;
  ATT_LAS float* ws = (ATT_LAS float*)(lds + OFF_WS) + wid * 64; ATT_LAS float* li_l = ws; ATT_LAS float* al_l = ws + 32;
  ATT_LAS float* btab = (ATT_LAS float*)(lds + OFF_BT);
  int NT, t0, r0w = 0, rq = 0;
  if constexpr (MODE == 0) { NT = 64; t0 = 0; }
  else if constexpr (MODE == 1) { const int rq0 = 4 * par; const int klo = clampi(rq0 - 4, 0, 56), khi = clampi(rq0 - 1, 0, 56) + 7; NT = (khi - klo + 2) & ~1; t0 = klo;
    rq = rq0 + (wid >> 1); r0w = clampi(rq - 4, 0, 56);
    for (int i = tid; i < 15 * 128; i += 512) { const int dc = (i & 127) - 63; btab[i] = (dc >= -15 && dc <= 15) ? rpb_h[(i >> 7) * 31 + dc + 15] * 1.4426950408889634f : 0.f; } }
  else { NT = 8; t0 = 4 * par - 2; }
#define ACTIVE(j) ((MODE == 0) ? true : (MODE == 1) ? (((t0 + (j)) >= r0w) && ((t0 + (j)) < r0w + 8)) : \
                   (((t0 + (j)) >= 0) && ((t0 + (j)) <= 63) && (64 * (j) + 63 >= 32 * wid) && (64 * (j) <= 32 * wid + 287)))
  float m_reg = (MODE == 2) ? sinkl2 : 0.f, l_reg = (MODE == 2) ? 1.f : 0.f; f32x16 o[2] = {}; bf16x8 qr[ND0];
  { const ATT_GAS bf16* Qw = io.q + (size_t)(wid * QBLK + r32) * io.ldq + hi * 8;
#pragma unroll
    for (int d0 = 0; d0 < ND0; ++d0) qr[d0] = *(const ATT_GAS bf16x8*)(Qw + d0 * 16); }
  constexpr bool fixed = FIXED;
  if constexpr (FIXED) m_reg = sinkl2;
  f32x16 negm;
#pragma unroll
  for (int r = 0; r < 16; ++r) negm[r] = -m_reg;
  f32x16 negm2v;
  if constexpr (MODE == 1) { const int qc_ = 32 * (wid & 1) + r32; const int c0_ = clampi(qc_ - 8, 0, 48);
#pragma unroll
    for (int r = 0; r < 16; ++r) { const int ka_ = crow(r, hi), kb_ = ka_ + 32; negm2v[r] = ((kb_ >= c0_) && (kb_ < c0_ + 16)) ? 0.f : -1e30f; negm[r] = ((ka_ >= c0_) && (ka_ < c0_ + 16)) ? 0.f : -1e30f; }
    asm volatile("" : "+v"(negm2v)); }
  asm volatile("" : "+v"(negm));
#define NEGM2 (*((MODE == 1) ? &negm2v : &negm))
  const int sr = tid >> 3, sc = (tid & 7) * 8, vst0 = v_st(sr, sc), kst0 = sr * KST + sc * 2;
  const int sr2 = (tid & 255) >> 2, sc2 = (tid & 3) * 8, kst2 = sr2 * KST + (64 + sc2) * 2;
  const ATT_LAS char* vb0 = V_lds + v_rd_base(lane);
  bf16x8 st_v, st_k, st_k2;
#define TOK(j) (64 * clampi(t0 + (j), 0, 63))
#define SLOAD(j) do { const int tk_ = TOK(j); st_v = *(const ATT_GAS bf16x8*)(io.v + (size_t)(tk_ + sr) * io.ldv + sc); \
    st_k = *(const ATT_GAS bf16x8*)(io.k + (size_t)(tk_ + sr) * io.ldk + sc); \
    if constexpr (MODE == 0) { if (wid < 4) st_k2 = *(const ATT_GAS bf16x8*)(io.k2 + (size_t)(tk_ + sr2) * io.ldk2 + sc2); } } while (0)
#define SWRITE(b) do { *(ATT_LAS bf16x8*)(V_lds + (b) * SHM_V + vst0) = st_v; *(ATT_LAS bf16x8*)(K_lds + (b) * KBUF + kst0) = st_k; \
    if constexpr (MODE == 0) { if (wid < 4) *(ATT_LAS bf16x8*)(K_lds + (b) * KBUF + kst2) = st_k2; } } while (0)
#define RESC(a) do { if (__any((a) < 1.f)) { if (hi == 0) al_l[r32] = (a); asm volatile("s_waitcnt lgkmcnt(0)" ::: "memory"); \
    _Pragma("unroll") for (int d = 0; d < 2; ++d) _Pragma("unroll") for (int r = 0; r < 16; ++r) o[d][r] *= al_l[crow(r, hi)]; } } while (0)
#define MASK(P0, P1, j) do { \
    if constexpr (MODE == 1) { const ATT_LAS float* bt_ = btab + ((t0 + (j)) - rq + 7) * 128 + (4 * hi - (32 * (wid & 1) + r32) + 63); \
      _Pragma("unroll") for (int r = 0; r < 16; ++r) { P0[r] += bt_[(r & 3) + 8 * (r >> 2)]; P1[r] += bt_[(r & 3) + 8 * (r >> 2) + 32]; } } \
    else if constexpr (MODE == 2) { if (!((64 * (j) - 32 * wid - 31 >= 0) && (64 * (j) - 32 * wid <= 193))) { const int rel_ = 64 * (j) - 128 - 32 * wid - r32; \
      _Pragma("unroll") for (int r = 0; r < 16; ++r) { const int da_ = rel_ + crow(r, hi), db_ = da_ + 32; \
        P0[r] = (da_ >= -128 && da_ <= 128) ? P0[r] : -1e30f; P1[r] = (db_ >= -128 && db_ <= 128) ? P1[r] : -1e30f; } } } } while (0)
  f32x16 pA0, pA1, pB0, pB1; float alA = 1.f, alB = 1.f; bf16x8 pa0, pa1, pa2, pa3;
  bool actA = false, actB = false, have_ref = (MODE == 2) || fixed;
  int bc = 0, bp = 2, bn = 1;
#define ROT() do { const int t_ = bp; bp = bc; bc = bn; bn = t_; } while (0)
#define QKALL(P0, P1, Kp) do { bf16x8 kf0_[ND0], kf1_[ND0]; kload<DQK, 0>(kf0_, Kp, r32, hi); kload<DQK, 1>(kf1_, Kp, r32, hi); SBAR(); \
      qk_mma<DQK, 0>(P0, P1, kf0_, qr, negm, NEGM2); qk_mma<DQK, 1>(P0, P1, kf1_, qr, negm, NEGM2); } while (0)
#define SGB(mask, n) __builtin_amdgcn_sched_group_barrier(mask, n, 0)
#define STEP(PX0, PX1, alX, actX, PY0, PY1, alY, actY, j) do { \
    if ((j) + 1 < NT) SWRITE(bn); \
    if ((j) + 2 < NT) SLOAD((j) + 2); \
    actX = ACTIVE(j); \
    const ATT_LAS char* Kc_ = K_lds + bc * KBUF; const ATT_LAS char* vp_ = vb0 + bp * SHM_V; \
    SBAR(); \
    if constexpr (MODE == 0) { \
        \
      { bf16x8 kf0_[ND0], kf1_[ND0]; kload<DQK, 0>(kf0_, Kc_, r32, hi); kload<DQK, 1>(kf1_, Kc_, r32, hi); \
        qk_mma<DQK, 0>(PX0, PX1, kf0_, qr, negm, negm); qk_mma<DQK, 1>(PX0, PX1, kf1_, qr, negm, negm); \
        finishSM(PY0, PY1, alY, l_reg, pa0, pa1, pa2, pa3); \
        SGB(0x100, 12); \
        _Pragma("unroll") for (int g_ = 0; g_ < 12; ++g_) { SGB(0x008, 1); SGB(0x402, 6); } } \
      SBAR(); \
      { s16x4 vf_[16]; vload(vf_, vp_); \
        pv_mma1<0>(o[0], vf_, pa0, pa1, pa2, pa3); \
        const float pm_ = psm_max(PX0, PX1); \
        SGB(0x100, 16); \
        _Pragma("unroll") for (int g_ = 0; g_ < 4; ++g_) { SGB(0x008, 1); SGB(0x402, 10); } \
        SBAR(); \
        psm_decide(PX0, PX1, pm_, m_reg, negm, alX, have_ref); \
        SBAR(); \
        pv_mma1<1>(o[1], vf_, pa0, pa1, pa2, pa3); \
        psm_exp(PX0); \
        _Pragma("unroll") for (int g_ = 0; g_ < 4; ++g_) { SGB(0x008, 1); SGB(0x402, 4); } } \
      SBAR(); \
      RESC(alX); \
    } else { \
      if (actX) { QKALL(PX0, PX1, Kc_); MASK(PX0, PX1, j); } SBAR(); \
      if (actY) { s16x4 vf_[16]; vload(vf_, vp_); SBAR(); finishSM(PY0, PY1, alY, l_reg, pa0, pa1, pa2, pa3); SBAR(); pv_mma(o, vf_, pa0, pa1, pa2, pa3); } SBAR(); \
      if (actX) { partialSM<MODE == 1>(PX0, PX1, m_reg, negm, NEGM2, alX, have_ref); RESC(alX); } \
    } \
    ROT(); \
    __syncthreads(); } while (0)
#define STEPF(PX0, PX1, PY0, PY1, j) do { \
    if ((j) + 1 < NT) SWRITE(bn); \
    if ((j) + 2 < NT) SLOAD((j) + 2); \
    const ATT_LAS char* Kc_ = K_lds + bc * KBUF; const ATT_LAS char* vp_ = vb0 + bp * SHM_V; \
    SBAR(); \
    { bf16x8 kf0_[ND0], kf1_[ND0]; kload<DQK, 0>(kf0_, Kc_, r32, hi); kload<DQK, 1>(kf1_, Kc_, r32, hi); \
      qk_mma<DQK, 0>(PX0, PX1, kf0_, qr, negm, negm); qk_mma<DQK, 1>(PX0, PX1, kf1_, qr, negm, negm); \
      finishSM(PY0, PY1, 1.f, l_reg, pa0, pa1, pa2, pa3); \
      SGB(0x100, 12); \
      _Pragma("unroll") for (int g_ = 0; g_ < 12; ++g_) { SGB(0x008, 1); SGB(0x402, 6); } } \
    SBAR(); \
    { s16x4 vf_[16]; vload(vf_, vp_); \
      pv_mma(o, vf_, pa0, pa1, pa2, pa3); \
      psm_exp(PX0); \
      SGB(0x100, 16); \
      _Pragma("unroll") for (int g_ = 0; g_ < 8; ++g_) { SGB(0x008, 1); SGB(0x402, 2); } } \
    SBAR(); \
    ROT(); \
    __syncthreads(); } while (0)
  SLOAD(0); SWRITE(0); SLOAD(1); __syncthreads();
  actA = ACTIVE(0);
  SWRITE(1); if (2 < NT) SLOAD(2);
  if (actA) { QKALL(pA0, pA1, K_lds); MASK(pA0, pA1, 0); if (MODE == 0 && fixed) psm_exp(pA0); else partialSM<MODE == 1>(pA0, pA1, m_reg, negm, NEGM2, alA, have_ref); }
  ROT(); __syncthreads();
  if constexpr (MODE == 0 && FIXED) {
    actB = true;
    for (int j = 1; j + 1 < NT; j += 2) {
      STEPF(pB0, pB1, pA0, pA1, j);
      STEPF(pA0, pA1, pB0, pB1, j + 1);
    }
    STEPF(pB0, pB1, pA0, pA1, NT - 1);
  } else {
  for (int j = 1; j + 1 < NT; j += 2) {
    STEP(pB0, pB1, alB, actB, pA0, pA1, alA, actA, j);
    STEP(pA0, pA1, alA, actA, pB0, pB1, alB, actB, j + 1);
  }
  STEP(pB0, pB1, alB, actB, pA0, pA1, alA, actA, NT - 1);
  }
  if (actB) { s16x4 vf_[16]; vload(vf_, vb0 + bp * SHM_V); finishSM(pB0, pB1, alB, l_reg, pa0, pa1, pa2, pa3); SBAR(); pv_mma(o, vf_, pa0, pa1, pa2, pa3); }
#undef STEP
#undef STEPF
#undef SGB
#undef QKALL
#undef NEGM2
#undef ROT
  if (hi == 0) li_l[r32] = l_reg; asm volatile("s_waitcnt lgkmcnt(0)" ::: "memory");
  float rli[16];
#pragma unroll
  for (int r = 0; r < 16; ++r) rli[r] = __builtin_amdgcn_rcpf(li_l[crow(r, hi)]);
  ATT_GAS bf16* Ow = io.o + (size_t)(wid * QBLK) * io.ldo;
  { ATT_LAS char* stg = lds + OFF_OST + wid * 4608;
#pragma unroll
    for (int r = 0; r < 16; ++r) { const int orow = crow(r, hi);
#pragma unroll
      for (int d0 = 0; d0 < 2; ++d0) { const float val = o[d0][r] * rli[r]; *(ATT_LAS bf16*)(stg + orow * 144 + (d0 * 32 + r32) * 2) = (bf16)(cvtpk(val, val) & 0xffffu); } }
    asm volatile("s_waitcnt lgkmcnt(0)" ::: "memory");
#pragma unroll
    for (int i = 0; i < 4; ++i) { const int row = i * 8 + (lane >> 3), ch = lane & 7; const u32x4 v = *(const ATT_LAS u32x4*)(stg + row * 144 + ch * 16); *(ATT_GAS u32x4*)(Ow + (size_t)row * io.ldo + ch * 8) = v; } }
  __syncthreads();
#undef ACTIVE
#undef TOK
#undef SLOAD
#undef SWRITE
#undef RESC
#undef MASK
}

constexpr int K16B = 12288, V16B = 10240, V16ST = 160, OFF16_V = 3 * K16B, OFF16_WS = OFF16_V + 3 * V16B, OFF16_OST = OFF16_WS + NW * 256, OFF_FLAG = 122880;
static_assert(OFF16_OST + NW * 4608 <= OFF_FLAG && LDS_BYTES <= OFF_FLAG, "attention LDS map");
__device__ __forceinline__ int fkey(int k) { return (4 - ((k >> 2) & 3)) & 3; }
template <int NQB>
__device__ __forceinline__ void attn_unit16(const AttnIO io, const int role, ATT_LAS char* lds) {
  typedef float f32x4 __attribute__((ext_vector_type(4)));
  int tid_ = threadIdx.x; asm volatile("" : "+v"(tid_));
  const int tid = tid_, wid = __builtin_amdgcn_readfirstlane(tid >> 6), lane = tid & 63, c = lane & 15, g = lane >> 4;
  ATT_LAS char* K_lds = lds; ATT_LAS char* V_lds = lds + OFF16_V;
  ATT_LAS float* li_l = (ATT_LAS float*)(lds + OFF16_WS) + wid * 64;
  constexpr int NT = 64, WQ = 16 * NQB;
  bf16x8 qf[NQB][3];
  { const ATT_GAS bf16* Qw = io.q + (size_t)(wid * WQ + c) * io.ldq + g * 8;
#pragma unroll
    for (int qb = 0; qb < NQB; ++qb)
#pragma unroll
      for (int ks = 0; ks < 3; ++ks) qf[qb][ks] = *(const ATT_GAS bf16x8*)(Qw + (size_t)(16 * qb) * io.ldq + ks * 32); }
  const int gch = (lane & 3) ^ ((4 - g) & 3);
  const unsigned koff = (unsigned)((16 * (wid & 3) + (lane >> 2)) * io.ldk + 32 * (wid >> 2) + 8 * gch) * 2u;
  const unsigned k2off = (unsigned)((16 * (wid & 3) + (lane >> 2)) * io.ldk2 + 8 * gch) * 2u;
  const int vsA = 64 * ((wid + 4) & 7) + lane, vsB = 64 * ((wid < 4 ? wid : wid + 4) + (wid < 4 ? 4 : 0)) + lane;
  const unsigned voffA = (unsigned)((vsA / 10) * io.ldv + 8 * ((vsA % 10) > 7 ? 7 : (vsA % 10))) * 2u, voffB = (unsigned)((vsB / 10) * io.ldv + 8 * ((vsB % 10) > 7 ? 7 : (vsB % 10))) * 2u;
  const ATT_LAS char* kb0 = K_lds + c * 64 + ((g ^ fkey(c)) * 16);
  const ATT_LAS char* vb0 = V_lds + (4 * g + ((lane >> 2) & 3)) * V16ST + (lane & 3) * 8;
#define DMA16(src, dst) do { const ATT_GAS char* s_ = (const ATT_GAS char*)(src); const unsigned d_ = (unsigned)__builtin_amdgcn_readfirstlane((int)(unsigned)(size_t)(dst)); \
    asm volatile("s_mov_b32 m0, %1\n\ts_nop 0\n\tglobal_load_lds_dwordx4 %0, off" :: "v"(s_), "s"(d_) : "memory", "m0"); } while (0)
#define STAGEK(j, b) do { DMA16((const ATT_GAS char*)(io.k + (size_t)(64 * (j)) * io.ldk) + koff, K_lds + (b) * K16B + wid * 1024); \
    if (wid < 4) DMA16((const ATT_GAS char*)(io.k2 + (size_t)(64 * (j)) * io.ldk2) + k2off, K_lds + (b) * K16B + (8 + wid) * 1024); } while (0)
#define STAGEV(j, b) do { DMA16((const ATT_GAS char*)(io.v + (size_t)(64 * (j)) * io.ldv) + voffA, V_lds + (b) * V16B + ((wid + 4) & 7) * 1024); \
    if (wid == 4 || wid == 5) DMA16((const ATT_GAS char*)(io.v + (size_t)(64 * (j)) * io.ldv) + voffB, V_lds + (b) * V16B + (wid + 4) * 1024); } while (0)
#define BAR16() do { asm volatile("s_waitcnt lgkmcnt(0)" ::: "memory"); __builtin_amdgcn_s_barrier(); asm volatile("" ::: "memory"); } while (0)
#define BAR16V() do { asm volatile("s_waitcnt vmcnt(0) lgkmcnt(0)" ::: "memory"); __builtin_amdgcn_s_barrier(); asm volatile("" ::: "memory"); } while (0)
#define KREAD(KF, Kc, ks, kp) do { _Pragma("unroll") for (int kb_ = 0; kb_ < 2; ++kb_) KF[kb_] = *(const ATT_LAS bf16x8*)((Kc) + (ks) * 4096 + (2 * (kp) + kb_) * 1024); } while (0)
#define VREAD(VF, Vc, s, dp) do { _Pragma("unroll") for (int db_ = 0; db_ < 2; ++db_) { const s16x4 lo_ = vtr((Vc) + (s) * 32 * V16ST + (2 * (dp) + db_) * 32), hi_ = vtr((Vc) + ((s) * 32 + 16) * V16ST + (2 * (dp) + db_) * 32); \
      VF[db_] = (bf16x8){lo_[0], lo_[1], lo_[2], lo_[3], hi_[0], hi_[1], hi_[2], hi_[3]}; } } while (0)
#define QKMMA(KF, ks, kp) do { _Pragma("unroll") for (int kb_ = 0; kb_ < 2; ++kb_) _Pragma("unroll") for (int qb_ = 0; qb_ < NQB; ++qb_) \
      S[2 * (kp) + kb_][qb_] = __builtin_amdgcn_mfma_f32_16x16x32_bf16(KF[kb_], qf[qb_][ks], ((ks) == 0) ? (f32x4){0.f, 0.f, 0.f, 0.f} : S[2 * (kp) + kb_][qb_], 0, 0, 0); } while (0)
#define PVMMA(VF, s, dp) do { _Pragma("unroll") for (int db_ = 0; db_ < 2; ++db_) _Pragma("unroll") for (int qb_ = 0; qb_ < NQB; ++qb_) \
      o[qb_][2 * (dp) + db_] = __builtin_amdgcn_mfma_f32_16x16x32_bf16(pa[qb_][s], VF[db_], o[qb_][2 * (dp) + db_], 0, 0, 0); } while (0)
#define QKALL16(Kc, KFA, KFB) do { KREAD(KFB, Kc, 1, 0); QKMMA(KFA, 0, 0); SBAR(); KREAD(KFA, Kc, 2, 0); QKMMA(KFB, 1, 0); SBAR(); KREAD(KFB, Kc, 0, 1); QKMMA(KFA, 2, 0); SBAR(); \
      KREAD(KFA, Kc, 1, 1); QKMMA(KFB, 0, 1); SBAR(); KREAD(KFB, Kc, 2, 1); QKMMA(KFA, 1, 1); SBAR(); QKMMA(KFB, 2, 1); } while (0)
  f32x4 o[NQB][4];
#pragma unroll
  for (int qb = 0; qb < NQB; ++qb)
#pragma unroll
    for (int db = 0; db < 4; ++db) o[qb][db] = (f32x4){0.f, 0.f, 0.f, 0.f};
  f32x4 lacc[NQB];
#pragma unroll
  for (int qb = 0; qb < NQB; ++qb) lacc[qb] = (f32x4){0.f, 0.f, 0.f, 0.f};
  bf16x8 ones8; { const u32x4 w1 = {0x3F803F80u, 0x3F803F80u, 0x3F803F80u, 0x3F803F80u}; ones8 = __builtin_bit_cast(bf16x8, w1); asm volatile("" : "+v"(ones8)); }
  f32x4 S[4][NQB];
  STAGEK(0, 0); STAGEV(0, 0); STAGEK(1, 1);
  asm volatile("s_waitcnt vmcnt(0)" ::: "memory"); __syncthreads();
  { bf16x8 kfA[2], kfB[2]; KREAD(kfA, kb0, 0, 0); QKALL16(kb0, kfA, kfB); }
  if (role) BAR16();
  int i0 = 0, i1 = 1, i2 = 2;
  for (int t = 0; t < NT; ++t) {
    if (t + 2 < NT) STAGEK(t + 2, i2);
    if (t + 1 < NT) STAGEV(t + 1, i1);
    const ATT_LAS char* Vc = vb0 + i0 * V16B; const ATT_LAS char* Kc = kb0 + i1 * K16B;
    bf16x8 vfA[2], vfB[2];
    bf16x8 pa[NQB][2];
#pragma unroll
    for (int qb = 0; qb < NQB; ++qb) {
#pragma unroll
      for (int kb = 0; kb < 4; ++kb)
#pragma unroll
        for (int r = 0; r < 4; ++r) S[kb][qb][r] = __builtin_amdgcn_exp2f(S[kb][qb][r]);
#pragma unroll
      for (int s = 0; s < 2; ++s) { const u32x4 w = {cvtpk(S[2 * s][qb][0], S[2 * s][qb][1]), cvtpk(S[2 * s][qb][2], S[2 * s][qb][3]),
                                                     cvtpk(S[2 * s + 1][qb][0], S[2 * s + 1][qb][1]), cvtpk(S[2 * s + 1][qb][2], S[2 * s + 1][qb][3])};
        pa[qb][s] = __builtin_bit_cast(bf16x8, w); }
      SBAR();
      if (qb == NQB / 2 - 1) { VREAD(vfA, Vc, 0, 0); SBAR(); } }
    BAR16V();
    { bf16x8 fC[2];
#define ONES16() do { _Pragma("unroll") for (int s_ = 0; s_ < 2; ++s_) _Pragma("unroll") for (int qb_ = 0; qb_ < NQB; ++qb_) lacc[qb_] = __builtin_amdgcn_mfma_f32_16x16x32_bf16(pa[qb_][s_], ones8, lacc[qb_], 0, 0, 0); } while (0)
      const bool nx = (t + 1 < NT);
      VREAD(vfB, Vc, 0, 1); VREAD(fC, Vc, 1, 0); SBAR();
      PVMMA(vfA, 0, 0); SBAR(); VREAD(vfA, Vc, 1, 1); SBAR();
      PVMMA(vfB, 0, 1); SBAR(); if (nx) KREAD(vfB, Kc, 0, 0); SBAR();
      PVMMA(fC, 1, 0); SBAR(); if (nx) KREAD(fC, Kc, 1, 0); SBAR();
      PVMMA(vfA, 1, 1); SBAR(); if (nx) KREAD(vfA, Kc, 2, 0); SBAR();
      ONES16(); SBAR();
      if (nx) {
        QKMMA(vfB, 0, 0); SBAR(); KREAD(vfB, Kc, 0, 1); SBAR();
        QKMMA(fC, 1, 0); SBAR(); KREAD(fC, Kc, 1, 1); SBAR();
        QKMMA(vfA, 2, 0); SBAR(); KREAD(vfA, Kc, 2, 1); SBAR();
        QKMMA(vfB, 0, 1); SBAR(); QKMMA(fC, 1, 1); SBAR(); QKMMA(vfA, 2, 1); }
#undef ONES16
    }
    BAR16();
    { const int t_ = i0; i0 = i1; i1 = i2; i2 = t_; }
  }
  if (!role) BAR16();
#undef STAGEK
#undef STAGEV
#undef DMA16
#undef KREAD
#undef VREAD
#undef QKMMA
#undef PVMMA
#undef QKALL16
  ATT_GAS bf16* Ow = io.o + (size_t)(wid * WQ) * io.ldo;
  { ATT_LAS char* stg = lds + OFF16_OST + wid * 4608;
#pragma unroll
    for (int hp = 0; hp < NQB / 2; ++hp) {
#pragma unroll
      for (int q2 = 0; q2 < 2; ++q2)
#pragma unroll
        for (int r = 0; r < 4; ++r) { const int qb = 2 * hp + q2, orow = 16 * q2 + 4 * g + r; const float rl = __builtin_amdgcn_rcpf(lacc[qb][r]);
#pragma unroll
          for (int db = 0; db < 4; ++db) { const float val = o[qb][db][r] * rl; *(ATT_LAS bf16*)(stg + orow * 144 + (db * 16 + c) * 2) = (bf16)(cvtpk(val, val) & 0xffffu); } }
      asm volatile("s_waitcnt lgkmcnt(0)" ::: "memory");
#pragma unroll
      for (int i = 0; i < 4; ++i) { const int row = i * 8 + (lane >> 3), ch = lane & 7; const u32x4 v = *(const ATT_LAS u32x4*)(stg + row * 144 + ch * 16); *(ATT_GAS u32x4*)(Ow + (size_t)(32 * hp + row) * io.ldo + ch * 8) = v; }
      asm volatile("s_waitcnt lgkmcnt(0)" ::: "memory"); } }
#undef BAR16
#undef BAR16V
  __syncthreads();
}
constexpr int SWW_LDS = 10240 + 256;
__device__ __forceinline__ void swa_wave_task(const ATT_GAS bf16* qp, const ATT_GAS bf16* kp, const ATT_GAS bf16* vp, ATT_GAS bf16* op, const int q0, const float sinkl2, ATT_LAS char* wl) {
  typedef float f32x4 __attribute__((ext_vector_type(4)));
  int tid_ = threadIdx.x; asm volatile("" : "+v"(tid_));
  const int lane = tid_ & 63, c = lane & 15, g = lane >> 4;
  ATT_LAS float* al = (ATT_LAS float*)(wl + 10240);
  bf16x8 qf[2][2];
#pragma unroll
  for (int qb = 0; qb < 2; ++qb)
#pragma unroll
    for (int ks = 0; ks < 2; ++ks) qf[qb][ks] = *(const ATT_GAS bf16x8*)(qp + (size_t)(q0 + 16 * qb + c) * 256 + 32 * ks + 8 * g);
  f32x4 o[2][4], lacc[2], negm[2]; float m[2];
#pragma unroll
  for (int qb = 0; qb < 2; ++qb) { m[qb] = sinkl2; negm[qb] = (f32x4){-sinkl2, -sinkl2, -sinkl2, -sinkl2}; lacc[qb] = (f32x4){1.f, 1.f, 1.f, 1.f};
#pragma unroll
    for (int db = 0; db < 4; ++db) o[qb][db] = (f32x4){0.f, 0.f, 0.f, 0.f}; }
  bf16x8 ones8; { const u32x4 w1 = {0x3F803F80u, 0x3F803F80u, 0x3F803F80u, 0x3F803F80u}; ones8 = __builtin_bit_cast(bf16x8, w1); }
  const int jt = q0 >> 6, tlo = (jt - 2 < 0) ? 0 : jt - 2, thi = (jt + 2 > 63) ? 63 : jt + 2;
  const ATT_GAS bf16* kl = kp + (size_t)c * 128 + 8 * g;
  const ATT_GAS bf16* vl = vp + (size_t)(lane >> 3) * 128 + (lane & 7) * 8;
  ATT_LAS char* vw = wl + (lane >> 3) * V16ST + (lane & 7) * 16;
  const ATT_LAS char* vb0 = wl + (4 * g + ((lane >> 2) & 3)) * V16ST + (lane & 3) * 8;
  bf16x8 kf[4][2], vs[8];
#define SW_KLOAD(t) do { _Pragma("unroll") for (int kb_ = 0; kb_ < 4; ++kb_) _Pragma("unroll") for (int ks_ = 0; ks_ < 2; ++ks_) \
    kf[kb_][ks_] = *(const ATT_GAS bf16x8*)(kl + (size_t)(64 * (t) + 16 * kb_) * 128 + 32 * ks_); } while (0)
#define SW_VLOAD(t) do { _Pragma("unroll") for (int i_ = 0; i_ < 8; ++i_) vs[i_] = *(const ATT_GAS bf16x8*)(vl + (size_t)(64 * (t) + 8 * i_) * 128); } while (0)
  SW_KLOAD(tlo); SW_VLOAD(tlo);
  for (int t = tlo; t <= thi; ++t) {
    f32x4 S[4][2];
#pragma unroll
    for (int kb = 0; kb < 4; ++kb)
#pragma unroll
      for (int qb = 0; qb < 2; ++qb) { S[kb][qb] = __builtin_amdgcn_mfma_f32_16x16x32_bf16(kf[kb][0], qf[qb][0], negm[qb], 0, 0, 0);
        S[kb][qb] = __builtin_amdgcn_mfma_f32_16x16x32_bf16(kf[kb][1], qf[qb][1], S[kb][qb], 0, 0, 0); }
    if (t < thi) SW_KLOAD(t + 1);
    if (t == jt - 2 || t == jt + 2) {
      const int d0 = 64 * t + 4 * g - q0 - c;
#pragma unroll
      for (int kb = 0; kb < 4; ++kb)
#pragma unroll
        for (int qb = 0; qb < 2; ++qb)
#pragma unroll
          for (int r = 0; r < 4; ++r) { const int d = d0 + 16 * kb + r - 16 * qb; S[kb][qb][r] = (d >= -128 && d <= 128) ? S[kb][qb][r] : -1e30f; } }
    float pm[2];
#pragma unroll
    for (int qb = 0; qb < 2; ++qb) { float a = fmaxf(fmaxf(S[0][qb][0], S[0][qb][1]), S[0][qb][2]);
#pragma unroll
      for (int kb = 0; kb < 4; ++kb) { if (kb) a = fmaxf(fmaxf(a, S[kb][qb][0]), S[kb][qb][1]); a = fmaxf(fmaxf(a, S[kb][qb][kb ? 2 : 3]), S[kb][qb][3]); }
      pm[qb] = a; }
    if (__builtin_expect(__any(fmaxf(pm[0], pm[1]) > THR), 0)) {
#pragma unroll
      for (int qb = 0; qb < 2; ++qb) { float pmx = fmaxf(pm[qb], __shfl_xor(pm[qb], 16)); pmx = fmaxf(pmx, __shfl_xor(pmx, 32));
        const float dl = fmaxf(pmx, 0.f); m[qb] += dl; negm[qb] -= dl;
#pragma unroll
        for (int kb = 0; kb < 4; ++kb) S[kb][qb] -= dl;
        if (g == 0) al[16 * qb + c] = __builtin_amdgcn_exp2f(-dl); }
      asm volatile("s_waitcnt lgkmcnt(0)" ::: "memory");
#pragma unroll
      for (int qb = 0; qb < 2; ++qb)
#pragma unroll
        for (int r = 0; r < 4; ++r) { const float a = al[16 * qb + 4 * g + r]; lacc[qb][r] *= a;
#pragma unroll
          for (int db = 0; db < 4; ++db) o[qb][db][r] *= a; } }
    bf16x8 pa[2][2];
#pragma unroll
    for (int qb = 0; qb < 2; ++qb) {
#pragma unroll
      for (int kb = 0; kb < 4; ++kb)
#pragma unroll
        for (int r = 0; r < 4; ++r) S[kb][qb][r] = __builtin_amdgcn_exp2f(S[kb][qb][r]);
#pragma unroll
      for (int s2 = 0; s2 < 2; ++s2) { const u32x4 w = {cvtpk(S[2 * s2][qb][0], S[2 * s2][qb][1]), cvtpk(S[2 * s2][qb][2], S[2 * s2][qb][3]),
                                                       cvtpk(S[2 * s2 + 1][qb][0], S[2 * s2 + 1][qb][1]), cvtpk(S[2 * s2 + 1][qb][2], S[2 * s2 + 1][qb][3])};
        pa[qb][s2] = __builtin_bit_cast(bf16x8, w); } }
#pragma unroll
    for (int i = 0; i < 8; ++i) *(ATT_LAS bf16x8*)(vw + 8 * i * V16ST) = vs[i];
    if (t < thi) SW_VLOAD(t + 1);
#pragma unroll
    for (int s2 = 0; s2 < 2; ++s2) { bf16x8 vf[4];
#pragma unroll
      for (int db = 0; db < 4; ++db) { const s16x4 lo = vtr(vb0 + s2 * 32 * V16ST + db * 32), hi = vtr(vb0 + (s2 * 32 + 16) * V16ST + db * 32);
        vf[db] = (bf16x8){lo[0], lo[1], lo[2], lo[3], hi[0], hi[1], hi[2], hi[3]}; }
#pragma unroll
      for (int db = 0; db < 4; ++db)
#pragma unroll
        for (int qb = 0; qb < 2; ++qb) o[qb][db] = __builtin_amdgcn_mfma_f32_16x16x32_bf16(pa[qb][s2], vf[db], o[qb][db], 0, 0, 0);
#pragma unroll
      for (int qb = 0; qb < 2; ++qb) lacc[qb] = __builtin_amdgcn_mfma_f32_16x16x32_bf16(pa[qb][s2], ones8, lacc[qb], 0, 0, 0); }
  }
#undef SW_KLOAD
#undef SW_VLOAD
#pragma unroll
  for (int qb = 0; qb < 2; ++qb)
#pragma unroll
    for (int r = 0; r < 4; ++r) { const int orow = 16 * qb + 4 * g + r; const float rl = __builtin_amdgcn_rcpf(lacc[qb][r]);
#pragma unroll
      for (int db = 0; db < 4; ++db) { const float val = o[qb][db][r] * rl; *(ATT_LAS bf16*)(wl + orow * 144 + (db * 16 + c) * 2) = (bf16)(cvtpk(val, val) & 0xffffu); } }
  asm volatile("s_waitcnt lgkmcnt(0)" ::: "memory");
#pragma unroll
  for (int i = 0; i < 4; ++i) { const int row = i * 8 + (lane >> 3), ch = lane & 7; const u32x4 v = *(const ATT_LAS u32x4*)(wl + row * 144 + ch * 16); *(ATT_GAS u32x4*)(op + (size_t)(q0 + row) * 1024 + ch * 8) = v; }
  asm volatile("s_waitcnt lgkmcnt(0)" ::: "memory");
}
constexpr int SW_NB = 5, SWK_B = 8192, SWV_B = 10240, SW_OFFV = SW_NB * SWK_B, SW_OFFAL = SW_OFFV + SW_NB * SWV_B, SW_OFFO = 0;
static_assert(SW_OFFAL + NW * 256 <= 131072 && NW * 9216 <= SW_OFFAL, "SWA LDS map");
__device__ __forceinline__ void swa_unit(const ATT_GAS bf16* qp, const ATT_GAS bf16* kp, const ATT_GAS bf16* vp, ATT_GAS bf16* op, const int u0, const float sinkl2, ATT_LAS char* lds) {
  typedef float f32x4 __attribute__((ext_vector_type(4)));
  int tid_ = threadIdx.x; asm volatile("" : "+v"(tid_));
  const int tid = tid_, wid = __builtin_amdgcn_readfirstlane(tid >> 6), lane = tid & 63, c = lane & 15, g = lane >> 4;
  ATT_LAS char* K_lds = lds; ATT_LAS char* V_lds = lds + SW_OFFV;
  ATT_LAS float* al = (ATT_LAS float*)(lds + SW_OFFAL) + wid * 64;
  const int q0 = 64 * (u0 + wid);
  bf16x8 qf[4][2];
#pragma unroll
  for (int qb = 0; qb < 4; ++qb)
#pragma unroll
    for (int ks = 0; ks < 2; ++ks) qf[qb][ks] = *(const ATT_GAS bf16x8*)(qp + (size_t)(q0 + 16 * qb + c) * 256 + 32 * ks + 8 * g);
  f32x4 o[4][4], lacc[4], negm[4];
#pragma unroll
  for (int qb = 0; qb < 4; ++qb) { negm[qb] = (f32x4){-sinkl2, -sinkl2, -sinkl2, -sinkl2}; lacc[qb] = (f32x4){1.f, 1.f, 1.f, 1.f};
#pragma unroll
    for (int db = 0; db < 4; ++db) o[qb][db] = (f32x4){0.f, 0.f, 0.f, 0.f}; }
  bf16x8 ones8; { const u32x4 w1 = {0x3F803F80u, 0x3F803F80u, 0x3F803F80u, 0x3F803F80u}; ones8 = __builtin_bit_cast(bf16x8, w1); asm volatile("" : "+v"(ones8)); }
  const int gch = (lane & 3) ^ ((4 - g) & 3);
  const unsigned koff = (unsigned)((16 * (wid & 3) + (lane >> 2)) * 128 + 32 * (wid >> 2) + 8 * gch) * 2u;
  const int vsA = 64 * wid + lane, vsB = 64 * (8 + (wid & 1)) + lane;
  const unsigned voffA = (unsigned)((vsA / 10) * 128 + 8 * ((vsA % 10) > 7 ? 7 : (vsA % 10))) * 2u, voffB = (unsigned)((vsB / 10) * 128 + 8 * ((vsB % 10) > 7 ? 7 : (vsB % 10))) * 2u;
#define SW_DMA(src, dst) do { const ATT_GAS char* s_ = (const ATT_GAS char*)(src); const unsigned d_ = (unsigned)__builtin_amdgcn_readfirstlane((int)(unsigned)(size_t)(dst)); \
    asm volatile("s_mov_b32 m0, %1\n\ts_nop 0\n\tglobal_load_lds_dwordx4 %0, off" :: "v"(s_), "s"(d_) : "memory", "m0"); } while (0)
#define SW_STAGE(T, b) do { SW_DMA((const ATT_GAS char*)(kp + (size_t)(64 * (T)) * 128) + koff, K_lds + (b) * SWK_B + wid * 1024); \
    SW_DMA((const ATT_GAS char*)(vp + (size_t)(64 * (T)) * 128) + voffA, V_lds + (b) * SWV_B + wid * 1024); \
    if (wid < 2) SW_DMA((const ATT_GAS char*)(vp + (size_t)(64 * (T)) * 128) + voffB, V_lds + (b) * SWV_B + (8 + wid) * 1024); } while (0)
  const ATT_LAS char* kb0 = K_lds + c * 64 + ((g ^ fkey(c)) * 16);
  const ATT_LAS char* vb0 = V_lds + (4 * g + ((lane >> 2) & 3)) * V16ST + (lane & 3) * 8;
  const int Tlo = (u0 - 2 < 0) ? 0 : u0 - 2, Thi = (u0 + 9 > 63) ? 63 : u0 + 9;
  SW_STAGE(Tlo, 0); if (Tlo + 1 <= Thi) SW_STAGE(Tlo + 1, 1);
  asm volatile("s_waitcnt vmcnt(0)" ::: "memory");
  if (Tlo + 2 <= Thi) SW_STAGE(Tlo + 2, 2); if (Tlo + 3 <= Thi) SW_STAGE(Tlo + 3, 3);
  __syncthreads();
  int b0 = 0, b4 = 4;
  for (int T = Tlo; T <= Thi; ++T) {
    if (T + 4 <= Thi) SW_STAGE(T + 4, b4);
    const int dT = T - (u0 + wid);
    if (dT >= -2 && dT <= 2) {
      const ATT_LAS char* Kc = kb0 + b0 * SWK_B; const ATT_LAS char* Vc = vb0 + b0 * SWV_B;
      f32x4 S[4][4];
      { bf16x8 kf[4][2];
#pragma unroll
        for (int ks = 0; ks < 2; ++ks)
#pragma unroll
          for (int kb = 0; kb < 4; ++kb) kf[kb][ks] = *(const ATT_LAS bf16x8*)(Kc + ks * 4096 + kb * 1024);
#pragma unroll
        for (int ks = 0; ks < 2; ++ks)
#pragma unroll
          for (int kb = 0; kb < 4; ++kb)
#pragma unroll
            for (int qb = 0; qb < 4; ++qb) S[kb][qb] = __builtin_amdgcn_mfma_f32_16x16x32_bf16(kf[kb][ks], qf[qb][ks], ks == 0 ? negm[qb] : S[kb][qb], 0, 0, 0); }
      if (dT == -2 || dT == 2) {
        const int d0 = 64 * T + 4 * g - q0 - c;
#pragma unroll
        for (int kb = 0; kb < 4; ++kb)
#pragma unroll
          for (int qb = 0; qb < 4; ++qb)
#pragma unroll
            for (int r = 0; r < 4; ++r) { const int d = d0 + 16 * kb + r - 16 * qb; S[kb][qb][r] = (d >= -128 && d <= 128) ? S[kb][qb][r] : -1e30f; } }
      float pm[4];
#pragma unroll
      for (int qb = 0; qb < 4; ++qb) { float a = fmaxf(fmaxf(S[0][qb][0], S[0][qb][1]), S[0][qb][2]);
#pragma unroll
        for (int kb = 0; kb < 4; ++kb) { if (kb) a = fmaxf(fmaxf(a, S[kb][qb][0]), S[kb][qb][1]); a = fmaxf(fmaxf(a, S[kb][qb][kb ? 2 : 3]), S[kb][qb][3]); }
        pm[qb] = a; }
      if (__builtin_expect(__any(fmaxf(fmaxf(pm[0], pm[1]), fmaxf(pm[2], pm[3])) > THR), 0)) {
#pragma unroll
        for (int qb = 0; qb < 4; ++qb) { float pmx = fmaxf(pm[qb], __shfl_xor(pm[qb], 16)); pmx = fmaxf(pmx, __shfl_xor(pmx, 32));
          const float dl = fmaxf(pmx, 0.f); negm[qb] -= dl;
#pragma unroll
          for (int kb = 0; kb < 4; ++kb) S[kb][qb] -= dl;
          if (g == 0) al[16 * qb + c] = __builtin_amdgcn_exp2f(-dl); }
        asm volatile("s_waitcnt lgkmcnt(0)" ::: "memory");
#pragma unroll
        for (int qb = 0; qb < 4; ++qb)
#pragma unroll
          for (int r = 0; r < 4; ++r) { const float a = al[16 * qb + 4 * g + r]; lacc[qb][r] *= a;
#pragma unroll
            for (int db = 0; db < 4; ++db) o[qb][db][r] *= a; } }
      bf16x8 pa[4][2];
#pragma unroll
      for (int qb = 0; qb < 4; ++qb) {
#pragma unroll
        for (int kb = 0; kb < 4; ++kb)
#pragma unroll
          for (int r = 0; r < 4; ++r) S[kb][qb][r] = __builtin_amdgcn_exp2f(S[kb][qb][r]);
#pragma unroll
        for (int s2 = 0; s2 < 2; ++s2) { const u32x4 w = {cvtpk(S[2 * s2][qb][0], S[2 * s2][qb][1]), cvtpk(S[2 * s2][qb][2], S[2 * s2][qb][3]),
                                                         cvtpk(S[2 * s2 + 1][qb][0], S[2 * s2 + 1][qb][1]), cvtpk(S[2 * s2 + 1][qb][2], S[2 * s2 + 1][qb][3])};
          pa[qb][s2] = __builtin_bit_cast(bf16x8, w); }
        SBAR(); }
#pragma unroll
      for (int s2 = 0; s2 < 2; ++s2) { bf16x8 vf[4];
#pragma unroll
        for (int db = 0; db < 4; ++db) { const s16x4 lo = vtr(Vc + s2 * 32 * V16ST + db * 32), hi = vtr(Vc + (s2 * 32 + 16) * V16ST + db * 32);
          vf[db] = (bf16x8){lo[0], lo[1], lo[2], lo[3], hi[0], hi[1], hi[2], hi[3]}; }
#pragma unroll
        for (int db = 0; db < 4; ++db)
#pragma unroll
          for (int qb = 0; qb < 4; ++qb) o[qb][db] = __builtin_amdgcn_mfma_f32_16x16x32_bf16(pa[qb][s2], vf[db], o[qb][db], 0, 0, 0);
#pragma unroll
        for (int qb = 0; qb < 4; ++qb) lacc[qb] = __builtin_amdgcn_mfma_f32_16x16x32_bf16(pa[qb][s2], ones8, lacc[qb], 0, 0, 0); }
    }
    if (T + 4 <= Thi) { if (wid < 2) asm volatile("s_waitcnt vmcnt(9) lgkmcnt(0)" ::: "memory"); else asm volatile("s_waitcnt vmcnt(6) lgkmcnt(0)" ::: "memory"); }
    else asm volatile("s_waitcnt vmcnt(0) lgkmcnt(0)" ::: "memory");
    __builtin_amdgcn_s_barrier(); asm volatile("" ::: "memory");
    { const int t_ = b0; b0 = (b0 == SW_NB - 1) ? 0 : b0 + 1; b4 = t_; }
  }
#undef SW_DMA
#undef SW_STAGE
  { ATT_LAS char* stg = lds + SW_OFFO + wid * 9216;
#pragma unroll
    for (int qb = 0; qb < 4; ++qb)
#pragma unroll
      for (int r = 0; r < 4; ++r) { const int orow = 16 * qb + 4 * g + r; const float rl = __builtin_amdgcn_rcpf(lacc[qb][r]);
#pragma unroll
        for (int db = 0; db < 4; ++db) { const float val = o[qb][db][r] * rl; *(ATT_LAS bf16*)(stg + orow * 144 + (db * 16 + c) * 2) = (bf16)(cvtpk(val, val) & 0xffffu); } }
    asm volatile("s_waitcnt lgkmcnt(0)" ::: "memory");
#pragma unroll
    for (int i = 0; i < 8; ++i) { const int row = i * 8 + (lane >> 3), ch = lane & 7; const u32x4 v = *(const ATT_LAS u32x4*)(stg + row * 144 + ch * 16); *(ATT_GAS u32x4*)(op + (size_t)(q0 + row) * 1024 + ch * 8) = v; } }
  __syncthreads();
}
template <int NH>
__device__ __forceinline__ bool mla_block_fixed(AttnIO io, float km2, ATT_LAS char* lds, int& role) {
  float mrow; bool okw = mla_fixed_ref(io, km2, mrow);
  if constexpr (NH == 2) { io.q += (size_t)256 * io.ldq; okw = mla_fixed_ref(io, km2, mrow) && okw; }
  int tid_ = threadIdx.x; asm volatile("" : "+v"(tid_));
  const int wid = __builtin_amdgcn_readfirstlane(tid_ >> 6);
  const int simd = (int)__builtin_amdgcn_s_getreg((1 << 11) | (4 << 6) | 4);
  ATT_LAS int* fl = (ATT_LAS int*)(lds + OFF_FLAG);
  if ((tid_ & 63) == 0) fl[wid] = (okw ? 1 : 0) | (simd << 1);
  __syncthreads();
  int all = 1, rank = 0;
#pragma unroll
  for (int w = 0; w < 8; ++w) { const int f = __builtin_amdgcn_readfirstlane(fl[w]); all &= f; rank += (w < wid && (f >> 1) == simd) ? 1 : 0; }
  role = rank & 1;
  return (all & 1) != 0;
}
#undef SBAR
}
#ifndef PHMASK
#define PHMASK 0xffffffffu
#endif
#define PH(k) if (PHMASK & (1u << (k)))
#ifndef DUPMASK
#define DUPMASK 0u
#endif
#define DUP(k) for (int rep_ = 0; rep_ < (int)((DUPMASK >> (k)) & 1u) + 1; ++rep_)
constexpr int NWAVES = 8;
constexpr int DM = 1024, BATCH = 8, SEQ = 4096, TOK = BATCH * SEQ, DEPTH = 2;
constexpr int IN_W = 1952, IN_WP = 2048, NEXP = 16, EFF = 512, CAP = 512, PLE = 256;
constexpr int NSLOT = BATCH * NEXP * CAP;
constexpr float NORM_EPS = 1e-6f, LOG2E = 1.4426950408889634f;
constexpr float C2_NA = 0.125f * LOG2E, C2_SW = 0.125f * LOG2E, C2_MLA = 0.10206207261596575f * LOG2E;

constexpr size_t MiB = 1u << 20;
constexpr size_t WS_CTL = 0, CTL_ZERO_BYTES = 64 * 1024;
constexpr size_t WS_MISC = 1 * MiB;
constexpr size_t MO_COS16 = 0, MO_SIN16 = 256 * 1024, MO_COS32 = 512 * 1024, MO_SIN32 = 1024 * 1024;
constexpr size_t MO_PSSQ = 1536 * 1024;
constexpr size_t MO_GSSQ = MO_PSSQ + 2 * MiB;
constexpr size_t MO_RSF = MO_GSSQ + 2560 * 1024;
constexpr size_t MO_RSP = MO_RSF + 128 * 1024;
constexpr size_t MO_AFF = MO_RSP + 128 * 1024;
constexpr size_t MO_SIDX = MO_AFF + 2 * MiB;
constexpr size_t MO_SG = MO_SIDX + 256 * 1024;
constexpr size_t MO_SRS = MO_SG + 256 * 1024;
constexpr size_t MO_INV = MO_SRS + 256 * 1024;
constexpr size_t MO_RSA = MO_INV + 2 * MiB, MO_RSCQ = MO_RSA + 128 * 1024, MO_RSCKV = MO_RSCQ + 128 * 1024;
constexpr size_t MO_WR = MO_RSCKV + 128 * 1024;
static_assert(MO_WR + 128 * 1024 <= 16 * MiB, "misc map");
constexpr size_t WS_WPG = 17 * MiB;
constexpr size_t WS_W = 21 * MiB;
constexpr size_t WO_IN = 0, WO_QUP = 4 * MiB, WO_KVUP = 5 * MiB, WO_OUT = 6 * MiB, WO_PP = 8 * MiB, WO_GU = 9 * MiB, WO_DOWN = 41 * MiB;
constexpr size_t WS_HB = 79 * MiB, WS_PB = 143 * MiB, WS_OCAT = 159 * MiB, WS_PPO = WS_OCAT, WS_BIG = 223 * MiB, WS_END = 457 * MiB;
constexpr size_t BO_NAQKV = 0, BO_CQ = 48 * MiB, BO_CKV = 72 * MiB, BO_KR = 88 * MiB, BO_SWQ = 90 * MiB, BO_SWK = 106 * MiB, BO_SWV = 114 * MiB,
                 BO_QM = 122 * MiB, BO_KN = 170 * MiB, BO_VM = 202 * MiB, BO_ACT = 0, BO_Y = 64 * MiB;
constexpr int CW_BAR = 4096;
static_assert((CW_BAR + 3456) * 4 <= 32768, "barrier words");
constexpr int CW_XL = 12544;
constexpr int CW_KMAX = 8192, CW_KRMAX = CW_KMAX + 128;

constexpr int RING_OFF = 0, RING_BYTES = 131072;
constexpr int LDSCTL_OFF = RING_BYTES, MISC_OFF = LDSCTL_OFF + 320, GTAB_OFF = RING_BYTES + 1024;
constexpr int LDS_BYTES = 147456;
static_assert(GTAB_OFF + 8192 <= LDS_BYTES && MISC_OFF + 128 <= GTAB_OFF, "LDS map");

#define GAS __attribute__((address_space(1)))
#define LAS __attribute__((address_space(3)))
typedef unsigned short bf16;
typedef unsigned v4u __attribute__((ext_vector_type(4)));
typedef unsigned v2u __attribute__((ext_vector_type(2)));
typedef int v4i __attribute__((ext_vector_type(4)));
typedef float f32x4 __attribute__((ext_vector_type(4)));
typedef float f32x2 __attribute__((ext_vector_type(2)));
typedef __bf16 bf16x2_t __attribute__((ext_vector_type(2)));
#define LDS_WAIT() asm volatile("s_waitcnt lgkmcnt(0)" ::: "memory")
#define VM_WAIT() asm volatile("s_waitcnt vmcnt(0)" ::: "memory")
__device__ __forceinline__ unsigned pk2(float lo, float hi) { f32x2 v = {lo, hi}; bf16x2_t b = __builtin_convertvector(v, bf16x2_t); return __builtin_bit_cast(unsigned, b); }
__device__ __forceinline__ v2u pk4(f32x4 v) { v2u r; r.x = pk2(v[0], v[1]); r.y = pk2(v[2], v[3]); return r; }
__device__ __forceinline__ float bf2f(unsigned short b) { return __uint_as_float((unsigned)b << 16); }
__device__ __forceinline__ float wave_sum(float v) {
#pragma unroll
    for (int o = 1; o < 64; o <<= 1) v += __shfl_xor(v, o);
    return v;
}

#define XB_TMO      128
#define XB_XCNT(j)  (256  + 64 * (j))
#define XB_XSUB(j)  (1280 + 64 * (j))
#define XB_XGEN(j)  (2304 + 64 * (j))
#define XB_TOP      3328
#define XB_TOPGEN   3392
#define XCD_BAR_WORDS 3456
#define XB_SPIN_CAP (1u << 22)
__device__ __forceinline__ unsigned xb_ld(unsigned* p)              { return __hip_atomic_load(p, __ATOMIC_RELAXED, __HIP_MEMORY_SCOPE_AGENT); }
__device__ __forceinline__ unsigned xb_add(unsigned* p, unsigned v) { return __hip_atomic_fetch_add(p, v, __ATOMIC_RELAXED, __HIP_MEMORY_SCOPE_AGENT); }
__device__ __forceinline__ unsigned xb_xcc_id() { return (unsigned)__builtin_amdgcn_s_getreg((3 << 11) | 20) & 0xFu; }
#define XB_SPIN(cond, bar) do { unsigned _sp = 0; while (cond) { __builtin_amdgcn_s_sleep(1); \
    if ((++_sp & 255u) == 0u) { if (xb_ld(&(bar)[XB_TMO])) break; if (_sp > XB_SPIN_CAP) { atomicAdd(&(bar)[XB_TMO], 1u); break; } } } } while (0)
struct XcdBarrier { unsigned* bar; unsigned x; volatile LAS unsigned* st; };
__device__ __forceinline__ XcdBarrier xcd_barrier_post(unsigned* bar, volatile LAS unsigned* st) {
    XcdBarrier b; b.bar = bar; b.x = xb_xcc_id(); b.st = st;
    if (threadIdx.x == 0) st[2] = xb_add(&bar[XB_XCNT(b.x)], 1u);
    return b;
}
__device__ __forceinline__ void xcd_barrier_complete(unsigned* bar, unsigned x, unsigned& nloc, unsigned& nx) {
    const unsigned G = gridDim.x * gridDim.y * gridDim.z;
    unsigned sum, cnt, mine, sp = 0u;
    for (;;) {
        sum = 0u; cnt = 0u; mine = 0u;
#pragma unroll
        for (unsigned j = 0; j < 16; ++j) { const unsigned c = xb_ld(&bar[XB_XCNT(j)]); sum += c; cnt += (c > 0u) ? 1u : 0u; mine = (j == x) ? c : mine; }
        if (sum == G) break;
        __builtin_amdgcn_s_sleep(1);
        if ((++sp & 255u) == 0u) { if (xb_ld(&bar[XB_TMO])) break; if (sp > XB_SPIN_CAP) { atomicAdd(&bar[XB_TMO], 1u); break; } }
    }
    nloc = mine > 0u ? mine : 1u; nx = cnt > 0u ? cnt : 1u;
}
__device__ __forceinline__ void xcd_local_barrier(unsigned* cnt, unsigned n, unsigned* bar) {
    asm volatile("s_waitcnt vmcnt(0)" ::: "memory");
    __syncthreads();
    if (threadIdx.x == 0) {
        const unsigned old = xb_add(cnt, 1u); const unsigned target = (old / n + 1u) * n;
        XB_SPIN(xb_ld(cnt) < target, bar);
        asm volatile("buffer_inv sc0\n\ts_waitcnt vmcnt(0)" ::: "memory");
    }
    __syncthreads();
}
__device__ __forceinline__ void xcd_barrier(const XcdBarrier& b) {
    asm volatile("s_waitcnt vmcnt(0)" ::: "memory");
    __syncthreads();
    if (threadIdx.x == 0) {
        unsigned* bar = b.bar;
        __builtin_amdgcn_s_waitcnt(0);
        unsigned nloc = b.st[0], nx = b.st[1];
        if (nloc == 0u) { xcd_barrier_complete(bar, b.x, nloc, nx); b.st[0] = nloc; b.st[1] = nx; }
        const unsigned old = xb_add(&bar[XB_XSUB(b.x)], 1u);
        const unsigned gen = old / nloc;
        if (old + 1u == (gen + 1u) * nloc) {
            __builtin_amdgcn_fence(__ATOMIC_RELEASE, "agent");
            asm volatile("s_waitcnt vmcnt(0)" ::: "memory");
            const unsigned og = xb_add(&bar[XB_TOP], 1u);
            const unsigned tg = og / nx;
            if (og + 1u == (tg + 1u) * nx) xb_add(&bar[XB_TOPGEN], 1u);
            else XB_SPIN(xb_ld(&bar[XB_TOPGEN]) == tg, bar);
            __builtin_amdgcn_fence(__ATOMIC_ACQUIRE, "agent");
            xb_add(&bar[XB_XGEN(b.x)], 1u);
            asm volatile("s_waitcnt vmcnt(0)" ::: "memory");
        } else {
            XB_SPIN(xb_ld(&bar[XB_XGEN(b.x)]) == gen, bar);
            asm volatile("buffer_inv sc0\n\ts_waitcnt vmcnt(0)" ::: "memory");
        }
    }
    __syncthreads();
}

struct Args { const float* in[20]; float* out; unsigned char* ws; double inv16[16]; double inv32[32]; };
enum { I_X = 0, I_P, I_ATTN_NORM, I_W_IN, I_NA_RPB, I_MLA_Q_NORM, I_MLA_W_Q_UP, I_MLA_KV_NORM, I_MLA_W_KV_UP, I_SWA_SINK, I_W_OUT, I_FFN_NORM, I_W_ROUTER,
       I_W_GATE, I_W_UP, I_W_DOWN, I_PLE_NORM, I_W_PLE_GATE, I_W_PLE_PROJ, I_FINAL_NORM };

struct Frame {
    LAS unsigned char* lds;
    volatile LAS unsigned* MISC;
    int vcu, G;
    unsigned char* ws;
    float* out;
    bf16* hb;
};
#define LAUNDER_LANES() int tid_ = threadIdx.x; asm volatile("" : "+v"(tid_)); const int tid = tid_, lane = tid & 63, wave = __builtin_amdgcn_readfirstlane(tid >> 6); (void)tid; (void)lane; (void)wave
#define WSP(T, off) ((T*)(F.ws + (off)))
#define MISCP(T, off) ((T*)(F.ws + WS_MISC + (off)))

template <class Src>
__device__ __forceinline__ void transpose_item(const Src& src, int K, bf16* WT, LAS float* scr, int item, int nblk, int lane) {
    const int kb = item / nblk, nb = item % nblk, k0 = 64 * kb, n0 = 32 * nb;
#pragma unroll 8
    for (int i = 0; i < 32; ++i) { const int kk = 2 * i + (lane >> 5); scr[kk * 33 + (lane & 31)] = src(k0 + kk, n0 + (lane & 31)); }
    LDS_WAIT(); asm volatile("" ::: "memory");
    const int c = lane & 7;
#pragma unroll
    for (int j = 0; j < 4; ++j) { const int n = (lane >> 3) + 8 * j; const LAS float* s = scr + (8 * c) * 33 + n;
        v4u o; o.x = pk2(s[0 * 33], s[1 * 33]); o.y = pk2(s[2 * 33], s[3 * 33]); o.z = pk2(s[4 * 33], s[5 * 33]); o.w = pk2(s[6 * 33], s[7 * 33]);
        *(GAS v4u*)(WT + (size_t)(n0 + n) * K + k0 + 8 * c) = o; }
    LDS_WAIT(); asm volatile("" ::: "memory");
}
__device__ __forceinline__ int pair16(int p) { return 16 * ((p >> 2) & 1) + 4 * (p >> 3) + (p & 3); }
struct SrcPlain { const float* W; int N; const float* g;
    __device__ __forceinline__ float operator()(int k, int n) const { const float w = __builtin_nontemporal_load((const GAS float*)(W + (size_t)k * N + n)); return g ? w * g[k] : w; } };
struct SrcIn { const float* W; const float* g;
    __device__ __forceinline__ float operator()(int k, int n) const {
        if (n >= IN_W) return 0.f;
        int c = n;
        if (n >= 1408 && n < 1440) c = 1408 + pair16(n - 1408);
        else if (n >= 1440 && n < 1824) { const int base = (n < 1696) ? 1440 : 1696; const int p = (n - base) & 63, hb = (n - base) & ~63, sub = p >> 5, q = p & 31;
            c = base + hb + 16 * sub + 32 * ((q >> 2) & 1) + 4 * (q >> 3) + (q & 3); }
        return __builtin_nontemporal_load((const GAS float*)(W + (size_t)k * IN_W + c)) * g[k]; } };
struct SrcQup { const float* W; const float* g;
    __device__ __forceinline__ float operator()(int k, int n) const { const int h = n / 96, r = n % 96; const int c = (r < 64) ? n : h * 96 + 64 + pair16(r - 64); return W[(size_t)k * 768 + c] * g[k]; } };
struct SrcGU { const float* Wg; const float* Wu; const float* g;
    __device__ __forceinline__ float operator()(int k, int n) const { const int grp = n >> 5, p = n & 31; const ptrdiff_t d = ((p >> 2) & 1) ? (Wu - Wg) : (ptrdiff_t)0; return __builtin_nontemporal_load((const GAS float*)(Wg + d + (ptrdiff_t)k * EFF + 16 * grp + 4 * (p >> 3) + (p & 3))) * g[k]; } };

__device__ __forceinline__ void convert_layer_weights(Frame& F, const Args& a, int l, bool with_pg_both, bf16* Wl) {
    LAUNDER_LANES();
    LAS float* scr = (LAS float*)(F.lds + RING_OFF + wave * 16384);
    const int gw = F.vcu * NWAVES + wave, NGW = F.G * NWAVES;
    constexpr int I_IN = 16 * 64, I_QUP = 6 * 24, I_KVUP = 4 * 32, I_OUT = 16 * 32, I_PPI = 4 * 32, I_GU1 = 16 * 32, I_DN1 = 8 * 32, I_PG = 16 * 32;
    constexpr int NITEMS = I_IN + I_QUP + I_KVUP + I_OUT + I_PPI + NEXP * I_GU1 + NEXP * I_DN1;
    const int total = NITEMS + (with_pg_both ? 2 * I_PG : 0);
    for (int it = gw; it < total; it += NGW) {
        int r = it;
        if (r < I_IN) { SrcIn s{a.in[I_W_IN] + (size_t)l * DM * IN_W, a.in[I_ATTN_NORM] + l * DM}; transpose_item(s, DM, (bf16*)((char*)Wl + WO_IN), scr, r, 64, lane); continue; } r -= I_IN;
        if (r < I_QUP) { SrcQup s{a.in[I_MLA_W_Q_UP] + (size_t)l * 384 * 768, a.in[I_MLA_Q_NORM] + l * 384}; transpose_item(s, 384, (bf16*)((char*)Wl + WO_QUP), scr, r, 24, lane); continue; } r -= I_QUP;
        if (r < I_KVUP) { SrcPlain s{a.in[I_MLA_W_KV_UP] + (size_t)l * 256 * 1024, 1024, a.in[I_MLA_KV_NORM] + l * 256}; transpose_item(s, 256, (bf16*)((char*)Wl + WO_KVUP), scr, r, 32, lane); continue; } r -= I_KVUP;
        if (r < I_OUT) { SrcPlain s{a.in[I_W_OUT] + (size_t)l * DM * DM, DM, nullptr}; transpose_item(s, DM, (bf16*)((char*)Wl + WO_OUT), scr, r, 32, lane); continue; } r -= I_OUT;
        if (r < I_PPI) { SrcPlain s{a.in[I_W_PLE_PROJ] + (size_t)l * PLE * DM, DM, nullptr}; transpose_item(s, PLE, (bf16*)((char*)Wl + WO_PP), scr, r, 32, lane); continue; } r -= I_PPI;
        if (r < NEXP * I_GU1) { const int e = r / I_GU1; const size_t eo = ((size_t)l * NEXP + e) * DM * EFF;
            SrcGU s{a.in[I_W_GATE] + eo, a.in[I_W_UP] + eo, a.in[I_FFN_NORM] + l * DM}; transpose_item(s, DM, (bf16*)((char*)Wl + WO_GU) + (size_t)e * DM * DM, scr, r % I_GU1, 32, lane); continue; } r -= NEXP * I_GU1;
        if (r < NEXP * I_DN1) { const int e = r / I_DN1; SrcPlain s{a.in[I_W_DOWN] + ((size_t)l * NEXP + e) * EFF * DM, DM, nullptr};
            transpose_item(s, EFF, (bf16*)((char*)Wl + WO_DOWN) + (size_t)e * DM * EFF, scr, r % I_DN1, 32, lane); continue; } r -= NEXP * I_DN1;
        { const int ll = r / I_PG; SrcPlain s{a.in[I_W_PLE_GATE] + (size_t)ll * DM * DM, DM, a.in[I_PLE_NORM] + ll * DM}; transpose_item(s, DM, WSP(bf16, WS_WPG) + (size_t)ll * DM * DM, scr, r % I_PG, 32, lane); }
    }
}
__device__ __forceinline__ void convert_p(Frame& F, const Args& a, int l, bf16* pb) {
    LAUNDER_LANES();
    const float* p = a.in[I_P] + (size_t)l * TOK * PLE;
    const size_t n8 = (size_t)TOK * PLE / 8, gt = (size_t)F.vcu * 512 + tid, NT = (size_t)F.G * 512;
    for (size_t i = gt; i < n8; i += NT) { const f32x4 x0 = __builtin_nontemporal_load((const GAS f32x4*)(p + i * 8)), x1 = __builtin_nontemporal_load((const GAS f32x4*)(p + i * 8 + 4));
        v4u o; o.x = pk2(x0[0], x0[1]); o.y = pk2(x0[2], x0[3]); o.z = pk2(x1[0], x1[1]); o.w = pk2(x1[2], x1[3]); *(GAS v4u*)(pb + i * 8) = o; }
}
__device__ __forceinline__ void rope_tables(Frame& F, const Args& a) {
    LAUNDER_LANES();
    float* c16 = MISCP(float, MO_COS16); float* s16 = MISCP(float, MO_SIN16); float* c32 = MISCP(float, MO_COS32); float* s32 = MISCP(float, MO_SIN32);
    const int gt = F.vcu * 512 + tid, NT = F.G * 512;
    for (int i = gt; i < SEQ * 48; i += NT) {
        const int pos = i / 48, f = i % 48; const double inv = (f < 16) ? a.inv16[f] : a.inv32[f - 16];
        const double ang = (double)pos * inv; const double k = __builtin_rint(ang * 0.15915494309189535); const double rr = ang - k * 6.283185307179586476925;
        const float r = (float)rr; const float cs = __cosf(r), sn = __sinf(r);
        if (f < 16) { c16[pos * 16 + f] = cs; s16[pos * 16 + f] = sn; } else { c32[pos * 32 + f - 16] = cs; s32[pos * 32 + f - 16] = sn; }
    }
}
__device__ __forceinline__ void router_weights(Frame& F, const Args& a) {
    LAUNDER_LANES();
    bf16* wr = MISCP(bf16, MO_WR);
    const int gt = F.vcu * 512 + tid, NT = F.G * 512;
    for (int i = gt; i < DEPTH * NEXP * DM; i += NT) { const int l = i / (NEXP * DM), e = (i / DM) % NEXP, k = i % DM;
        const float w = a.in[I_W_ROUTER][((size_t)l * DM + k) * NEXP + e] * a.in[I_FFN_NORM][l * DM + k];
        const unsigned hi = pk2(w, 0.f) & 0xffffu; const float wl = w - __uint_as_float(hi << 16); const unsigned lo = pk2(wl, 0.f) & 0xffffu;
        wr[((size_t)l * 32 + e) * DM + k] = (bf16)hi; wr[((size_t)l * 32 + 16 + e) * DM + k] = (bf16)lo; }
}
__device__ __forceinline__ void x_to_hb(Frame& F, const Args& a) {
    LAUNDER_LANES();
    const float* x = a.in[I_X]; bf16* hb = WSP(bf16, WS_HB);
    const int gw = F.vcu * NWAVES + wave, NGW = F.G * NWAVES;
    for (int m4 = gw; m4 < TOK / 4; m4 += NGW) {
        f32x4 v[4][4];
#pragma unroll
        for (int r = 0; r < 4; ++r) { const GAS f32x4* xr = (const GAS f32x4*)(x + (size_t)(m4 * 4 + r) * DM) + lane;
#pragma unroll
            for (int j = 0; j < 4; ++j) v[r][j] = __builtin_nontemporal_load(xr + 64 * j); }
#pragma unroll
        for (int r = 0; r < 4; ++r) { const int m = m4 * 4 + r; float s = 0.f;
#pragma unroll
            for (int j = 0; j < 4; ++j) s += (v[r][j][0] * v[r][j][0] + v[r][j][1] * v[r][j][1]) + (v[r][j][2] * v[r][j][2] + v[r][j][3] * v[r][j][3]);
            s = wave_sum(s);
            GAS v2u* o8 = (GAS v2u*)(hb + (size_t)m * DM) + lane;
#pragma unroll
            for (int j = 0; j < 4; ++j) o8[64 * j] = pk4(v[r][j]);
            if (lane < 16) MISCP(float, MO_PSSQ)[(size_t)m * 16 + lane] = (lane == 0) ? s : 0.f; }
    }
}
__device__ __forceinline__ void finalize_rstd(Frame& F, int mode) {
    LAUNDER_LANES();
    const int gt = F.vcu * 512 + tid, NT = F.G * 512;
    for (int m = gt; m < TOK; m += NT) {
        if (mode == 0) { const GAS f32x4* p = (const GAS f32x4*)(MISCP(float, MO_PSSQ) + (size_t)m * 16); const f32x4 a = p[0], b = p[1], c = p[2], d = p[3];
            const float s = ((a[0] + a[1]) + (a[2] + a[3])) + ((b[0] + b[1]) + (b[2] + b[3])) + ((c[0] + c[1]) + (c[2] + c[3])) + ((d[0] + d[1]) + (d[2] + d[3]));
            MISCP(float, MO_RSA)[m] = 1.0f / sqrtf(s * (1.f / DM) + NORM_EPS); }
        else { const GAS f32x4* p = (const GAS f32x4*)(MISCP(float, MO_GSSQ) + (size_t)m * 20); const f32x4 a = p[0], b = p[1], c = p[2], d = p[3], e = p[4];
            const float sq = ((a[0] + a[1]) + (a[2] + a[3])) + ((b[0] + b[1]) + (b[2] + b[3])) + ((c[0] + c[1]) + (c[2] + c[3])), sk = ((d[0] + d[1]) + (d[2] + d[3])) + ((e[0] + e[1]) + (e[2] + e[3]));
            MISCP(float, MO_RSCQ)[m] = 1.0f / sqrtf(sq * (1.f / 384.f) + NORM_EPS); MISCP(float, MO_RSCKV)[m] = 1.0f / sqrtf(sk * (1.f / 256.f) + NORM_EPS); }
    }
}
__device__ __forceinline__ void final_norm(Frame& F, const Args& a) {
    LAUNDER_LANES();
    const float* g = a.in[I_FINAL_NORM]; f32x4 gv[4];
#pragma unroll
    for (int j = 0; j < 4; ++j) gv[j] = *((const GAS f32x4*)g + lane + 64 * j);
    const GAS unsigned short* hb = (const GAS unsigned short*)F.hb;
    const int gw = F.vcu * NWAVES + wave, NGW = F.G * NWAVES;
    for (int m4 = gw; m4 < TOK / 4; m4 += NGW) {
        v2u w[4][4];
#pragma unroll
        for (int r = 0; r < 4; ++r) { const GAS v2u* xr = (const GAS v2u*)(hb + (size_t)(m4 * 4 + r) * DM) + lane;
#pragma unroll
            for (int j = 0; j < 4; ++j) w[r][j] = xr[64 * j]; }
#pragma unroll
        for (int r = 0; r < 4; ++r) { f32x4 v[4]; float s = 0.f;
#pragma unroll
            for (int j = 0; j < 4; ++j) { v[j][0] = __uint_as_float(w[r][j].x << 16); v[j][1] = __uint_as_float(w[r][j].x & 0xffff0000u); v[j][2] = __uint_as_float(w[r][j].y << 16); v[j][3] = __uint_as_float(w[r][j].y & 0xffff0000u);
                s += (v[j][0] * v[j][0] + v[j][1] * v[j][1]) + (v[j][2] * v[j][2] + v[j][3] * v[j][3]); }
            const float rs = 1.0f / sqrtf(wave_sum(s) * (1.f / DM) + NORM_EPS);
            GAS f32x4* o = (GAS f32x4*)(F.out + (size_t)(m4 * 4 + r) * DM) + lane;
#pragma unroll
            for (int j = 0; j < 4; ++j) __builtin_nontemporal_store(v[j] * rs * gv[j], o + 64 * j); }
    }
}
typedef pg8::Unit Unit;
typedef const f32x4 (&AccRef)[2][2][4][2];
#define EPI_ROW(u, ai, m) ((u).pm * 256 + (ai) * 128 + wr * 64 + (m) * 16 + fr)
#define EPI_GRP(u, bj) (((u).pn * 256 + (bj) * 128 + wc * 32) >> 5)
typedef GAS bf16 gbf16; typedef GAS float gf32; typedef const GAS float cgf32; typedef const GAS bf16 cgbf16;
__device__ __forceinline__ void st_bf4(gbf16* p, f32x4 v) { *(GAS v2u*)p = pk4(v); }
__device__ __forceinline__ void st_bf8(gbf16* p, f32x4 a, f32x4 b) { v4u w; w.x = pk2(a[0], a[1]); w.y = pk2(a[2], a[3]); w.z = pk2(b[0], b[1]); w.w = pk2(b[2], b[3]); *(GAS v4u*)p = w; }
__device__ __forceinline__ f32x4 ld_bf4(cgbf16* p) { const v2u w = *(const GAS v2u*)p; f32x4 r; r[0] = __uint_as_float(w.x << 16); r[1] = __uint_as_float(w.x & 0xffff0000u); r[2] = __uint_as_float(w.y << 16); r[3] = __uint_as_float(w.y & 0xffff0000u); return r; }
__device__ __forceinline__ f32x4 bflo(v4u w) { f32x4 r; r[0] = __uint_as_float(w.x << 16); r[1] = __uint_as_float(w.x & 0xffff0000u); r[2] = __uint_as_float(w.y << 16); r[3] = __uint_as_float(w.y & 0xffff0000u); return r; }
__device__ __forceinline__ f32x4 bfhi(v4u w) { f32x4 r; r[0] = __uint_as_float(w.z << 16); r[1] = __uint_as_float(w.z & 0xffff0000u); r[2] = __uint_as_float(w.w << 16); r[3] = __uint_as_float(w.w & 0xffff0000u); return r; }
#define EPI_LOAD_ROWS(arr, ptr, scale) float arr[2][4]; _Pragma("unroll") for (int ai = 0; ai < 2; ++ai) _Pragma("unroll") for (int m = 0; m < 4; ++m) arr[ai][m] = (ptr)[EPI_ROW(u, ai, m)] * (scale)
#define EPI_RSTD_ROWS(arr, ptr, STRIDE, OFF, N4, INVN, scale) float arr[2][4]; { f32x4 t_[2][4]; \
    _Pragma("unroll") for (int ai = 0; ai < 2; ++ai) _Pragma("unroll") for (int m = 0; m < 4; ++m) t_[ai][m] = (fq < (N4)) ? *(const GAS f32x4*)((ptr) + (size_t)EPI_ROW(u, ai, m) * (STRIDE) + (OFF) + 4 * fq) : (f32x4){0.f, 0.f, 0.f, 0.f}; \
    _Pragma("unroll") for (int ai = 0; ai < 2; ++ai) _Pragma("unroll") for (int m = 0; m < 4; ++m) { float s_ = (t_[ai][m][0] + t_[ai][m][1]) + (t_[ai][m][2] + t_[ai][m][3]); \
        s_ += __shfl_xor(s_, 16); s_ += __shfl_xor(s_, 32); arr[ai][m] = (scale) / sqrtf(s_ * (INVN) + NORM_EPS); } }

struct EpiIn {
    cgf32* rsa; gf32* gssq; gbf16 *naqkv, *cq, *ckv, *kr, *swq, *swk, *swv; cgf32 *c16, *s16, *c32, *s32; unsigned* krmax;
    __device__ __forceinline__ void operator()(AccRef acc, const Unit& u, int, int wr, int wc, int fr, int fq) const {
        EPI_RSTD_ROWS(rs, rsa, 16, 0, 4, 1.f / DM, 1.f);
#pragma unroll
        for (int bj = 0; bj < 2; ++bj) { const int g = EPI_GRP(u, bj);
            if (g >= 61) continue;
            float kmx = 0.f;
#pragma unroll
            for (int ai = 0; ai < 2; ++ai)
#pragma unroll
                for (int m = 0; m < 4; ++m) { const int row = EPI_ROW(u, ai, m); const int spos = row & (SEQ - 1);
                    const f32x4 v0 = acc[ai][bj][m][0] * rs[ai][m], v1 = acc[ai][bj][m][1] * rs[ai][m];
                    if (g < 24) { const float sc = (g < 8) ? C2_NA : 1.f; st_bf8(naqkv + (size_t)row * 768 + g * 32 + 8 * fq, v0 * sc, v1 * sc); }
                    else if (g < 44) { st_bf8((g < 36) ? cq + (size_t)row * 384 + (g - 24) * 32 + 8 * fq : ckv + (size_t)row * 256 + (g - 36) * 32 + 8 * fq, v0, v1);
                        float ss = ((v0[0] * v0[0] + v0[1] * v0[1]) + (v0[2] * v0[2] + v0[3] * v0[3])) + ((v1[0] * v1[0] + v1[1] * v1[1]) + (v1[2] * v1[2] + v1[3] * v1[3]));
                        ss += __shfl_xor(ss, 16); ss += __shfl_xor(ss, 32); if (fq == 0) gssq[(size_t)row * 20 + (g - 24)] = ss; }
                    else if (g == 44) { const f32x4 c = *(const GAS f32x4*)(c16 + spos * 16 + 4 * fq), sn = *(const GAS f32x4*)(s16 + spos * 16 + 4 * fq);
                        gbf16* d = kr + (size_t)row * 32 + 4 * fq; st_bf4(d, v0 * c - v1 * sn); st_bf4(d + 16, v1 * c + v0 * sn);
                        float ss = ((v0[0] * v0[0] + v0[1] * v0[1]) + (v0[2] * v0[2] + v0[3] * v0[3])) + ((v1[0] * v1[0] + v1[1] * v1[1]) + (v1[2] * v1[2] + v1[3] * v1[3]));
                        ss += __shfl_xor(ss, 16); ss += __shfl_xor(ss, 32); kmx = fmaxf(kmx, ss); }
                    else if (g < 57) { const bool isq = g < 53; const int gg = isq ? g - 45 : g - 53, head = gg >> 1, i0 = 16 * (gg & 1) + 4 * fq;
                        const f32x4 c = *(const GAS f32x4*)(c32 + spos * 32 + i0), sn = *(const GAS f32x4*)(s32 + spos * 32 + i0); const float sc = isq ? C2_SW : 1.f;
                        gbf16* d = (isq ? swq + (size_t)row * 256 : swk + (size_t)row * 128) + head * 64 + i0; st_bf4(d, (v0 * c - v1 * sn) * sc); st_bf4(d + 32, (v1 * c + v0 * sn) * sc); }
                    else st_bf8(swv + (size_t)row * 128 + (g - 57) * 32 + 8 * fq, v0, v1);
                }
            if (g == 44) { kmx = fmaxf(kmx, __shfl_xor(kmx, 1)); kmx = fmaxf(kmx, __shfl_xor(kmx, 2)); kmx = fmaxf(kmx, __shfl_xor(kmx, 4)); kmx = fmaxf(kmx, __shfl_xor(kmx, 8));
                if (fr == 0 && fq == 0) atomicMax(krmax + ((u.pm * 256) >> 12), __float_as_uint(kmx)); }
        }
    }
};
struct EpiQup {
    cgf32* rscq; gbf16* qm; cgf32 *c16, *s16;
    __device__ __forceinline__ void operator()(AccRef acc, const Unit& u, int, int wr, int wc, int fr, int fq) const {
        EPI_RSTD_ROWS(rs, rscq, 20, 0, 3, 1.f / 384.f, C2_MLA);
#pragma unroll
        for (int bj = 0; bj < 2; ++bj) { const int g = EPI_GRP(u, bj); const bool rope = (g % 3) == 2;
#pragma unroll
            for (int ai = 0; ai < 2; ++ai)
#pragma unroll
                for (int m = 0; m < 4; ++m) { const int row = EPI_ROW(u, ai, m); const f32x4 v0 = acc[ai][bj][m][0] * rs[ai][m], v1 = acc[ai][bj][m][1] * rs[ai][m];
                    if (rope) { const int sq = row & (SEQ - 1); const f32x4 c = *(const GAS f32x4*)(c16 + sq * 16 + 4 * fq), sn = *(const GAS f32x4*)(s16 + sq * 16 + 4 * fq);
                        gbf16* d = qm + (size_t)row * 768 + g * 32 + 4 * fq; st_bf4(d, v0 * c - v1 * sn); st_bf4(d + 16, v1 * c + v0 * sn); }
                    else st_bf8(qm + (size_t)row * 768 + g * 32 + 8 * fq, v0, v1); } }
    }
};
struct EpiKVup {
    cgf32* rsckv; gbf16 *kn, *vm; unsigned* kmax;
    __device__ __forceinline__ void operator()(AccRef acc, const Unit& u, int, int wr, int wc, int fr, int fq) const {
        EPI_RSTD_ROWS(rs, rsckv, 20, 12, 2, 1.f / 256.f, 1.f);
#pragma unroll
        for (int bj = 0; bj < 2; ++bj) { const int g = EPI_GRP(u, bj), h = g >> 2, part = g & 3; gbf16* base = ((part < 2) ? kn : vm) + h * 64 + (part & 1) * 32 + 8 * fq; float mx = 0.f;
#pragma unroll
            for (int ai = 0; ai < 2; ++ai)
#pragma unroll
                for (int m = 0; m < 4; ++m) { const f32x4 v0 = acc[ai][bj][m][0] * rs[ai][m], v1 = acc[ai][bj][m][1] * rs[ai][m]; st_bf8(base + (size_t)EPI_ROW(u, ai, m) * 512, v0, v1);
                    if (part < 2) { float ss = ((v0[0] * v0[0] + v0[1] * v0[1]) + (v0[2] * v0[2] + v0[3] * v0[3])) + ((v1[0] * v1[0] + v1[1] * v1[1]) + (v1[2] * v1[2] + v1[3] * v1[3]));
                        ss += __shfl_xor(ss, 16); ss += __shfl_xor(ss, 32); mx = fmaxf(mx, ss); } }
            if (part < 2) { mx = fmaxf(mx, __shfl_xor(mx, 1)); mx = fmaxf(mx, __shfl_xor(mx, 2)); mx = fmaxf(mx, __shfl_xor(mx, 4)); mx = fmaxf(mx, __shfl_xor(mx, 8));
                if (fr == 0 && fq == 0) atomicMax(kmax + (((u.pm * 256) >> 12) * 8 + h) * 2 + part, __float_as_uint(mx)); } }
    }
};
struct EpiBf {
    gbf16* o; int ldc;
    __device__ __forceinline__ void operator()(AccRef acc, const Unit& u, int, int wr, int wc, int fr, int fq) const {
#pragma unroll
        for (int bj = 0; bj < 2; ++bj) { gbf16* base = o + EPI_GRP(u, bj) * 32 + 8 * fq;
#pragma unroll
            for (int ai = 0; ai < 2; ++ai)
#pragma unroll
                for (int m = 0; m < 4; ++m) st_bf8(base + (size_t)EPI_ROW(u, ai, m) * ldc, acc[ai][bj][m][0], acc[ai][bj][m][1]); }
    }
};
struct EpiRes {
    gbf16* hb;
    __device__ __forceinline__ void operator()(AccRef acc, const Unit& u, int, int wr, int wc, int fr, int fq) const {
#pragma unroll
        for (int ai = 0; ai < 2; ++ai) { v4u hv[4][2];
#pragma unroll
            for (int m = 0; m < 4; ++m)
#pragma unroll
                for (int bj = 0; bj < 2; ++bj) hv[m][bj] = *(const GAS v4u*)(hb + (size_t)EPI_ROW(u, ai, m) * DM + EPI_GRP(u, bj) * 32 + 8 * fq);
#pragma unroll
            for (int m = 0; m < 4; ++m)
#pragma unroll
                for (int bj = 0; bj < 2; ++bj) st_bf8(hb + (size_t)EPI_ROW(u, ai, m) * DM + EPI_GRP(u, bj) * 32 + 8 * fq, bflo(hv[m][bj]) + acc[ai][bj][m][0], bfhi(hv[m][bj]) + acc[ai][bj][m][1]);
            asm volatile("" ::: "memory"); }
    }
};
struct EpiSwiglu {
    cgf32* srs; gbf16* act;
    __device__ __forceinline__ void operator()(AccRef acc, const Unit& u, int, int wr, int wc, int fr, int fq) const {
        EPI_LOAD_ROWS(rs, srs, 1.f);
#pragma unroll
        for (int ai = 0; ai < 2; ++ai)
#pragma unroll
            for (int m = 0; m < 4; ++m) { const int row = EPI_ROW(u, ai, m);
#pragma unroll
                for (int bj = 0; bj < 2; ++bj) { const f32x4 a = acc[ai][bj][m][0] * rs[ai][m], up = acc[ai][bj][m][1] * rs[ai][m]; f32x4 r;
#pragma unroll
                    for (int e = 0; e < 4; ++e) r[e] = a[e] * __builtin_amdgcn_rcpf(1.f + __builtin_amdgcn_exp2f(-a[e] * LOG2E)) * up[e];
                    st_bf4(act + (size_t)row * EFF + EPI_GRP(u, bj) * 16 + 4 * fq, r); } }
    }
};
struct EpiDown {
    cgf32* sg; gbf16* y;
    __device__ __forceinline__ void operator()(AccRef acc, const Unit& u, int, int wr, int wc, int fr, int fq) const {
        EPI_LOAD_ROWS(gw, sg, 1.f);
#pragma unroll
        for (int bj = 0; bj < 2; ++bj) { gbf16* base = y + EPI_GRP(u, bj) * 32 + 8 * fq;
#pragma unroll
            for (int ai = 0; ai < 2; ++ai)
#pragma unroll
                for (int m = 0; m < 4; ++m) st_bf8(base + (size_t)EPI_ROW(u, ai, m) * DM, acc[ai][bj][m][0] * gw[ai][m], acc[ai][bj][m][1] * gw[ai][m]); }
    }
};
struct EpiPle {
    cgf32* rsp; cgbf16* pp; cgbf16* hb; gbf16* hbo; gf32* pssq;
    __device__ __forceinline__ void operator()(AccRef acc, const Unit& u, int, int wr, int wc, int fr, int fq) const {
        EPI_LOAD_ROWS(rs, rsp, 1.f);
#pragma unroll
        for (int ai = 0; ai < 2; ++ai) { v4u hv[4][2], pv[4][2];
#pragma unroll
            for (int m = 0; m < 4; ++m)
#pragma unroll
                for (int bj = 0; bj < 2; ++bj) { const size_t off = (size_t)EPI_ROW(u, ai, m) * DM + EPI_GRP(u, bj) * 32 + 8 * fq; hv[m][bj] = *(const GAS v4u*)(hb + off); pv[m][bj] = __builtin_nontemporal_load((const GAS v4u*)(pp + off)); }
#pragma unroll
            for (int m = 0; m < 4; ++m) { float ss = 0.f; const int row = EPI_ROW(u, ai, m);
#pragma unroll
                for (int bj = 0; bj < 2; ++bj) { const f32x4 a0 = acc[ai][bj][m][0] * rs[ai][m], a1 = acc[ai][bj][m][1] * rs[ai][m]; const f32x4 h0 = bflo(hv[m][bj]), h1 = bfhi(hv[m][bj]), p0 = bflo(pv[m][bj]), p1 = bfhi(pv[m][bj]); f32x4 r0, r1;
#pragma unroll
                    for (int e = 0; e < 4; ++e) { r0[e] = h0[e] + __builtin_amdgcn_rcpf(1.f + __builtin_amdgcn_exp2f(-a0[e] * LOG2E)) * p0[e]; r1[e] = h1[e] + __builtin_amdgcn_rcpf(1.f + __builtin_amdgcn_exp2f(-a1[e] * LOG2E)) * p1[e]; }
                    st_bf8(hbo + (size_t)row * DM + EPI_GRP(u, bj) * 32 + 8 * fq, r0, r1);
                    ss += ((r0[0] * r0[0] + r0[1] * r0[1]) + (r0[2] * r0[2] + r0[3] * r0[3])) + ((r1[0] * r1[0] + r1[1] * r1[1]) + (r1[2] * r1[2] + r1[3] * r1[3])); }
                ss += __shfl_xor(ss, 16); ss += __shfl_xor(ss, 32);
                if (fq == 0) pssq[(size_t)row * 16 + u.pn * 4 + wc] = ss; }
            asm volatile("" ::: "memory"); }
    }
};

__device__ __forceinline__ void router_pass(Frame& F, const Args& a, int l) {
    LAUNDER_LANES();
    typedef short bf16x8_t __attribute__((ext_vector_type(8)));
    constexpr int WST = 2064;
    LAS char* WB = (LAS char*)(F.lds + RING_OFF);
    LAS float* sc = (LAS float*)(F.lds + RING_OFF + 32 * WST) + wave * 16;
    const GAS char* wsrc = (const GAS char*)(F.ws + WS_MISC + MO_WR) + (size_t)l * 32 * DM * 2;
    for (int c = tid; c < 32 * 128; c += 512) { const int r = c >> 7, ch = c & 127; *(LAS v4u*)(WB + r * WST + ch * 16) = *(const GAS v4u*)(wsrc + (size_t)r * 2048 + ch * 16); }
    __syncthreads();
    gf32* aff = (gf32*)MISCP(float, MO_AFF); gf32* rsf = (gf32*)MISCP(float, MO_RSF);
    const int gw = F.vcu * NWAVES + wave, NGW = F.G * NWAVES, fr = lane & 15, fq = lane >> 4;
    for (int grp = gw; grp < TOK / 16; grp += NGW) {
        const int row0 = grp * 16;
        const GAS char* ap = (const GAS char*)F.hb + ((size_t)(row0 + fr) * DM + fq * 8) * 2;
        const LAS char* bp = WB + fr * WST + fq * 16;
        f32x4 ah = {0.f, 0.f, 0.f, 0.f}, al = {0.f, 0.f, 0.f, 0.f}, as = {0.f, 0.f, 0.f, 0.f};
#pragma unroll 8
        for (int ks = 0; ks < 32; ++ks) { const bf16x8_t av = *(const GAS bf16x8_t*)(ap + ks * 64);
            const bf16x8_t bh = *(const LAS bf16x8_t*)(bp + ks * 64), bl = *(const LAS bf16x8_t*)(bp + 16 * WST + ks * 64);
            ah = __builtin_amdgcn_mfma_f32_16x16x32_bf16(av, bh, ah, 0, 0, 0); al = __builtin_amdgcn_mfma_f32_16x16x32_bf16(av, bl, al, 0, 0, 0);
            as = __builtin_amdgcn_mfma_f32_16x16x32_bf16(av, av, as, 0, 0, 0); }
        { const float d = (fr & 3) == 0 ? as[0] : (fr & 3) == 1 ? as[1] : (fr & 3) == 2 ? as[2] : as[3]; if ((fr >> 2) == fq) sc[fr] = d; }
        LDS_WAIT();
        const f32x4 ssq = *(const LAS f32x4*)(sc + 4 * fq);
#pragma unroll
        for (int r = 0; r < 4; ++r) { const float rs = 1.0f / sqrtf(ssq[r] * (1.f / DM) + NORM_EPS); const float lg = (ah[r] + al[r]) * rs;
            float mx = lg; mx = fmaxf(mx, __shfl_xor(mx, 1)); mx = fmaxf(mx, __shfl_xor(mx, 2)); mx = fmaxf(mx, __shfl_xor(mx, 4)); mx = fmaxf(mx, __shfl_xor(mx, 8));
            const float ex = __expf(lg - mx); float sm = ex; sm += __shfl_xor(sm, 1); sm += __shfl_xor(sm, 2); sm += __shfl_xor(sm, 4); sm += __shfl_xor(sm, 8);
            const int m = row0 + 4 * fq + r;
            aff[((size_t)(m >> 12) * NEXP + fr) * SEQ + (m & (SEQ - 1))] = ex / sm;
            if (fr == 0) rsf[m] = rs; }
        LDS_WAIT(); asm volatile("" ::: "memory");
    }
}
__device__ __forceinline__ unsigned block_excl_scan(unsigned v, LAS unsigned* wsum, int lane, int wave) {
    unsigned s = v;
#pragma unroll
    for (int d = 1; d < 64; d <<= 1) { const unsigned t = __shfl_up(s, d); if (lane >= d) s += t; }
    if (lane == 63) wsum[wave] = s;
    __syncthreads();
    unsigned base = 0;
    for (int w = 0; w < wave; ++w) base += wsum[w];
    __syncthreads();
    return base + s - v;
}
__device__ __forceinline__ void topk_block(Frame& F, int be) {
    LAUNDER_LANES();
    LAS unsigned* hist = (LAS unsigned*)(F.lds + RING_OFF); LAS unsigned* ctl = hist + 256; LAS unsigned* wsum = hist + 272;
    const float* aff = MISCP(float, MO_AFF) + (size_t)be * SEQ; const float* rsf = MISCP(float, MO_RSF);
    unsigned* sidx = MISCP(unsigned, MO_SIDX) + be * CAP; float* sg = MISCP(float, MO_SG) + be * CAP; float* srs = MISCP(float, MO_SRS) + be * CAP; int* inv = MISCP(int, MO_INV);
    const int b = be >> 4, e = be & 15;
    unsigned key[8];
    { const v4u k0 = *(const GAS v4u*)(aff + tid * 8), k1 = *(const GAS v4u*)(aff + tid * 8 + 4); key[0] = k0.x; key[1] = k0.y; key[2] = k0.z; key[3] = k0.w; key[4] = k1.x; key[5] = k1.y; key[6] = k1.z; key[7] = k1.w; }
    unsigned prefix = 0, need = CAP;
#pragma unroll
    for (int pass = 0; pass < 4; ++pass) { const int shift = 24 - 8 * pass;
        if (tid < 256) hist[tid] = 0u;
        __syncthreads();
#pragma unroll
        for (int i = 0; i < 8; ++i) { const bool match = (pass == 0) ? true : ((key[i] >> ((shift + 8) & 31)) == prefix); if (match) (void)__hip_atomic_fetch_add(&hist[(key[i] >> shift) & 255u], 1u, __ATOMIC_RELAXED, __HIP_MEMORY_SCOPE_WORKGROUP); }
        __syncthreads();
        if (wave == 0) { const unsigned h0 = hist[255 - 4 * lane], h1 = hist[254 - 4 * lane], h2 = hist[253 - 4 * lane], h3 = hist[252 - 4 * lane]; const unsigned c = h0 + h1 + h2 + h3; unsigned s = c;
#pragma unroll
            for (int d = 1; d < 64; d <<= 1) { const unsigned t = __shfl_up(s, d); if (lane >= d) s += t; }
            const unsigned excl = s - c;
            if (excl < need && need <= s) { const unsigned r = need - excl; unsigned bin, above;
                if (r <= h0) { bin = 255 - 4 * lane; above = 0; } else if (r <= h0 + h1) { bin = 254 - 4 * lane; above = h0; } else if (r <= h0 + h1 + h2) { bin = 253 - 4 * lane; above = h0 + h1; } else { bin = 252 - 4 * lane; above = h0 + h1 + h2; }
                ctl[0] = (prefix << 8) | bin; ctl[1] = r - above; } }
        __syncthreads();
        prefix = ctl[0]; need = ctl[1];
    }
    const unsigned T = prefix;
    unsigned cgt = 0, ceq = 0;
#pragma unroll
    for (int i = 0; i < 8; ++i) { cgt += key[i] > T ? 1u : 0u; ceq += key[i] == T ? 1u : 0u; }
    const unsigned eqb = block_excl_scan(ceq, wsum, lane, wave);
    const unsigned take = (eqb >= need) ? 0u : ((need - eqb) < ceq ? (need - eqb) : ceq);
    unsigned pos = block_excl_scan(cgt + take, wsum, lane, wave);
    unsigned eqr = 0;
#pragma unroll
    for (int i = 0; i < 8; ++i) { const int s = tid * 8 + i; bool sel = key[i] > T; if (key[i] == T) { sel = eqr < take; ++eqr; }
        const int grow = b * SEQ + s;
        if (sel) { sidx[pos] = (unsigned)grow; sg[pos] = __uint_as_float(key[i]); srs[pos] = rsf[grow]; inv[(size_t)grow * NEXP + e] = (int)pos; ++pos; }
        else inv[(size_t)grow * NEXP + e] = -1; }
    __syncthreads();
}
__device__ __forceinline__ void combine_pass(Frame& F) {
    LAUNDER_LANES();
    const GAS int* inv = (const GAS int*)MISCP(int, MO_INV); cgbf16* Y = (cgbf16*)(F.ws + WS_BIG + BO_Y); gbf16* hb = (gbf16*)F.hb; gf32* rsp = (gf32*)MISCP(float, MO_RSP);
    const bool loc = (F.G == 256); const int NGW = loc ? 256 : F.G * NWAVES, gw = loc ? (F.vcu >> 5) * SEQ + (F.vcu & 31) * NWAVES + wave : F.vcu * NWAVES + wave, mend = loc ? ((F.vcu >> 5) + 1) * SEQ : TOK;
    v2u hn[4]; int ivn = -1;
    if (gw < mend) { const GAS v2u* hr = (const GAS v2u*)(hb + (size_t)gw * DM) + lane;
#pragma unroll
        for (int j = 0; j < 4; ++j) hn[j] = hr[64 * j];
        ivn = (lane < 16) ? inv[(size_t)gw * NEXP + lane] : -1; }
    for (int m = gw; m < mend; m += NGW) {
        f32x4 v[4]; const int ivl = ivn;
#pragma unroll
        for (int j = 0; j < 4; ++j) { v[j][0] = __uint_as_float(hn[j].x << 16); v[j][1] = __uint_as_float(hn[j].x & 0xffff0000u); v[j][2] = __uint_as_float(hn[j].y << 16); v[j][3] = __uint_as_float(hn[j].y & 0xffff0000u); }
        const int mn = m + NGW;
        if (mn < mend) { const GAS v2u* hr = (const GAS v2u*)(hb + (size_t)mn * DM) + lane;
#pragma unroll
            for (int j = 0; j < 4; ++j) hn[j] = hr[64 * j];
            ivn = (lane < 16) ? inv[(size_t)mn * NEXP + lane] : -1; }
        unsigned mk = (unsigned)__ballot(ivl >= 0) & 0xffffu;
        cgbf16* ybase = Y + (size_t)(m >> 12) * NEXP * CAP * DM + 4 * lane;
        while (mk) {
            v2u y[4][4]; bool has[4];
#pragma unroll
            for (int g = 0; g < 4; ++g) { has[g] = mk != 0u; const int e = has[g] ? (__builtin_ctz(mk)) : 0; if (has[g]) mk &= mk - 1u;
                const int pos = __builtin_amdgcn_readlane(ivl, e);
                if (has[g]) { const GAS v2u* yr = (const GAS v2u*)(ybase + ((size_t)e * CAP + pos) * DM);
#pragma unroll
                    for (int j = 0; j < 4; ++j) y[g][j] = __builtin_nontemporal_load(yr + 64 * j); } }
#pragma unroll
            for (int g = 0; g < 4; ++g) if (has[g]) {
#pragma unroll
                for (int j = 0; j < 4; ++j) { v[j][0] += __uint_as_float(y[g][j].x << 16); v[j][1] += __uint_as_float(y[g][j].x & 0xffff0000u); v[j][2] += __uint_as_float(y[g][j].y << 16); v[j][3] += __uint_as_float(y[g][j].y & 0xffff0000u); } }
        }
        gbf16* ho = hb + (size_t)m * DM + 4 * lane; float s = 0.f;
#pragma unroll
        for (int j = 0; j < 4; ++j) { st_bf4(ho + 256 * j, v[j]); s += (v[j][0] * v[j][0] + v[j][1] * v[j][1]) + (v[j][2] * v[j][2] + v[j][3] * v[j][3]); }
        const float rs = 1.0f / sqrtf(wave_sum(s) * (1.f / DM) + NORM_EPS);
        if (lane == 0) rsp[m] = rs;
    }
}

__device__ __forceinline__ void attention_phase(Frame& F, const Args& a, int l) {
    const GAS bf16* big = (const GAS bf16*)(F.ws + WS_BIG); GAS bf16* ocat = (GAS bf16*)(F.ws + WS_OCAT);
    const GAS bf16* naqkv = (const GAS bf16*)((const GAS char*)big + BO_NAQKV); const GAS bf16* krp = (const GAS bf16*)((const GAS char*)big + BO_KR);
    const GAS bf16* swq = (const GAS bf16*)((const GAS char*)big + BO_SWQ); const GAS bf16* swk = (const GAS bf16*)((const GAS char*)big + BO_SWK); const GAS bf16* swv = (const GAS bf16*)((const GAS char*)big + BO_SWV);
    const GAS bf16* qm = (const GAS bf16*)((const GAS char*)big + BO_QM); const GAS bf16* kn = (const GAS bf16*)((const GAS char*)big + BO_KN); const GAS bf16* vm = (const GAS bf16*)((const GAS char*)big + BO_VM);
    LAS char* lds = (LAS char*)(F.lds + RING_OFF);
    DUP(15) PH(15) for (int i = 0; i < 2 * 256; i += 1) {
        int uidx;
        if (F.G == 256) { if (i >= 2) break; const int x = F.vcu >> 5, v = F.vcu & 31; uidx = ((x * 8 + 4 * i + (v >> 3)) << 3) | (v & 7); }
        else { uidx = F.vcu + i * F.G; if (uidx >= 512) break; }
        const int bh = uidx >> 3, qb = uidx & 7, b = bh >> 3, h = bh & 7; const size_t r0 = (size_t)b * SEQ;
        att::AttnIO io; io.q = qm + (r0 + qb * 512) * 768 + h * 96; io.ldq = 768; io.k = kn + r0 * 512 + h * 64; io.ldk = 512; io.k2 = krp + r0 * 32; io.ldk2 = 32;
        io.v = vm + r0 * 512 + h * 64; io.ldv = 512; io.o = ocat + (r0 + qb * 512) * DM + 256 + h * 64; io.ldo = DM;
        const unsigned* km = (const unsigned*)(F.ws + WS_CTL) + CW_KMAX; const float km2 = __uint_as_float(__hip_atomic_load(km + bh * 2, __ATOMIC_RELAXED, __HIP_MEMORY_SCOPE_AGENT)) + __uint_as_float(__hip_atomic_load(km + bh * 2 + 1, __ATOMIC_RELAXED, __HIP_MEMORY_SCOPE_AGENT)) + __uint_as_float(__hip_atomic_load(km + 128 + b, __ATOMIC_RELAXED, __HIP_MEMORY_SCOPE_AGENT));
        int role; if (att::mla_block_fixed<2>(io, km2, lds, role)) att::attn_unit16<4>(io, role, lds);
        else { att::attn_unit<0, false>(io, 0, 0.f, nullptr, lds); io.q += (size_t)256 * io.ldq; io.o += (size_t)256 * io.ldo; att::attn_unit<0, false>(io, 0, 0.f, nullptr, lds); }
    }
    DUP(16) PH(16) for (int uq = F.vcu; uq < 512; uq += F.G) { const int uidx = (F.G == 256) ? ((F.vcu >> 5) << 6) | ((uq >> 8) << 5) | (F.vcu & 31) : uq;
        const int r4 = uidx & 15, h = (uidx >> 4) & 3, b = uidx >> 6; const size_t r0 = (size_t)b * SEQ;
        att::AttnIO io; io.q = naqkv + (r0 + r4 * 256) * 768 + h * 64; io.ldq = 768; io.k = naqkv + r0 * 768 + 256 + h * 64; io.ldk = 768; io.k2 = nullptr; io.ldk2 = 0;
        io.v = naqkv + r0 * 768 + 512 + h * 64; io.ldv = 768; io.o = ocat + (r0 + r4 * 256) * DM + h * 64; io.ldo = DM;
        att::attn_unit<1>(io, r4, 0.f, (const GAS float*)(a.in[I_NA_RPB] + ((size_t)l * 4 + h) * 465), lds);
    }
    DUP(17) PH(17) { int tid3_ = threadIdx.x; asm volatile("" : "+v"(tid3_)); const int wv = __builtin_amdgcn_readfirstlane(tid3_ >> 6);
      __syncthreads();
      for (int wt = F.vcu * 8 + wv; wt < 2048; wt += F.G * 8) {
#pragma unroll 1
        for (int k2 = 0; k2 < 2; ++k2) { const int tsk = wt * 2 + k2, jb = tsk & 127, h = (tsk >> 7) & 3, b = tsk >> 9; const size_t r0 = (size_t)b * SEQ;
          att::swa_wave_task(swq + r0 * 256 + h * 64, swk + r0 * 128 + (h >> 1) * 64, swv + r0 * 128 + (h >> 1) * 64, ocat + r0 * DM + 768 + h * 64, jb * 32,
                             a.in[I_SWA_SINK][l * 4 + h] * LOG2E, lds + wv * att::SWW_LDS); } }
      __syncthreads(); }
}

__global__ void __launch_bounds__(NWAVES * 64, 2) enc_fwd(Args args) {
    extern __shared__ __attribute__((aligned(16))) unsigned char lds[];
    Frame F;
    F.lds = (LAS unsigned char*)lds;
    F.MISC = (volatile LAS unsigned*)(F.lds + MISC_OFF);
    F.G = gridDim.x; { const int bx = blockIdx.x; F.vcu = (F.G % 8 == 0) ? (bx % 8) * (F.G / 8) + bx / 8 : bx; }
    F.ws = args.ws; F.out = args.out;
    for (int u = threadIdx.x; u < (GTAB_OFF - LDSCTL_OFF) / 4; u += NWAVES * 64) ((LAS unsigned*)(F.lds + LDSCTL_OFF))[u] = 0u;
    __syncthreads();
    XcdBarrier bar = xcd_barrier_post((unsigned*)(F.ws + WS_CTL) + CW_BAR, F.MISC + 8);
#define GRID_BAR() do { { unsigned x_ = bar.x; asm volatile("" : "+s"(x_)); bar.x = x_; } xcd_barrier(bar); unsigned char* ws_ = args.ws; asm volatile("" : "+s"(ws_)); F.ws = ws_; bar.bar = (unsigned*)(ws_ + WS_CTL) + CW_BAR; Wl = lcur ? (bf16*)((char*)F.out + ((size_t)64 << 20)) : WSP(bf16, WS_W); hb = hb_in_out ? (bf16*)F.out : WSP(bf16, WS_HB); F.hb = hb; big = F.ws + WS_BIG; } while (0)
    int lcur = 0;
    bool hb_in_out = false;
    bf16* Wl = WSP(bf16, WS_W); bf16* hb = WSP(bf16, WS_HB); unsigned char* big = F.ws + WS_BIG; F.hb = hb;
    const int bx = (int)blockIdx.x;

    DUP(0) PH(0) { convert_layer_weights(F, args, 0, true, WSP(bf16, WS_W));
    rope_tables(F, args);
    router_weights(F, args);
    x_to_hb(F, args);
    convert_p(F, args, 0, WSP(bf16, WS_PB));
    if (DEPTH > 1) { convert_layer_weights(F, args, 1, false, (bf16*)((char*)F.out + ((size_t)64 << 20))); convert_p(F, args, 1, (bf16*)(F.ws + WS_END)); } }
    static_assert(DEPTH <= 2, "weight regions");
    GRID_BAR();
    int cid = bx; bool xl_ok = false;
    { if (threadIdx.x == 0) { unsigned* bw = (unsigned*)(F.ws + WS_CTL) + CW_BAR; unsigned n32 = 0, sum = 0;
          for (unsigned j = 0; j < 16; ++j) { const unsigned c = xb_ld(&bw[XB_XCNT(j)]); sum += c; n32 += (c == 32u) ? 1u : 0u; }
          F.MISC[8 + 3] = (n32 == 8u && sum == 256u && F.G == 256) ? 1u : 0u; }
      __syncthreads();
      xl_ok = F.MISC[8 + 3] != 0u; const int rank = (int)F.MISC[8 + 2], xcc = (int)bar.x;
      if (xl_ok) { cid = __builtin_amdgcn_readfirstlane(rank * 8 + xcc); F.vcu = __builtin_amdgcn_readfirstlane(xcc * 32 + rank); } }
#define LAYER_BAR() GRID_BAR()

    int done_layers = 0;
#pragma unroll 1
    for (int l = 0; l < DEPTH; ++l) {
        if (STOP_AFTER <= 10 * l) break;
        lcur = l; Wl = lcur ? (bf16*)((char*)F.out + ((size_t)64 << 20)) : WSP(bf16, WS_W);
        DUP(1) PH(1) { pg8::ProbPlain g{hb, (const bf16*)((char*)Wl + WO_IN), DM}; pg8::StaticOrder S; S.init(TOK, IN_WP, F.G, cid);
          EpiIn E{(cgf32*)MISCP(float, MO_PSSQ), (gf32*)MISCP(float, MO_GSSQ), (gbf16*)(big + BO_NAQKV), (gbf16*)(big + BO_CQ), (gbf16*)(big + BO_CKV), (gbf16*)(big + BO_KR), (gbf16*)(big + BO_SWQ), (gbf16*)(big + BO_SWK), (gbf16*)(big + BO_SWV),
                  (cgf32*)MISCP(float, MO_COS16), (cgf32*)MISCP(float, MO_SIN16), (cgf32*)MISCP(float, MO_COS32), (cgf32*)MISCP(float, MO_SIN32), (unsigned*)(F.ws + WS_CTL) + CW_KRMAX};
          pg8::gemm_phase<pg8::ProbPlain, EpiIn, pg8::StaticOrder, true>(F.lds + RING_OFF, g, S, E); }
        GRID_BAR();
        const bool p2split = (F.G == 256);
        DUP(2) PH(2) if (!p2split || cid < 128) { pg8::ProbPlain g{(const bf16*)(big + BO_CQ), (const bf16*)((char*)Wl + WO_QUP), 384}; pg8::StaticOrder S; S.init(TOK, 768, p2split ? 128 : F.G, cid);
          EpiQup E{(cgf32*)MISCP(float, MO_GSSQ), (gbf16*)(big + BO_QM), (cgf32*)MISCP(float, MO_COS16), (cgf32*)MISCP(float, MO_SIN16)};
          pg8::gemm_phase<pg8::ProbPlain, EpiQup, pg8::StaticOrder, true>(F.lds + RING_OFF, g, S, E); }
        DUP(2) PH(3) if (!p2split || cid >= 128) { pg8::ProbPlain g{(const bf16*)(big + BO_CKV), (const bf16*)((char*)Wl + WO_KVUP), 256}; pg8::StaticOrder S; S.init(TOK, 1024, p2split ? 128 : F.G, p2split ? cid - 128 : cid);
          EpiKVup E{(cgf32*)MISCP(float, MO_GSSQ), (gbf16*)(big + BO_KN), (gbf16*)(big + BO_VM), (unsigned*)(F.ws + WS_CTL) + CW_KMAX};
          pg8::gemm_phase<pg8::ProbPlain, EpiKVup, pg8::StaticOrder, true>(F.lds + RING_OFF, g, S, E); }
        GRID_BAR();
        DUP(4) PH(4) attention_phase(F, args, l);
        GRID_BAR();
        PH(5) { pg8::ProbPlain g{WSP(bf16, WS_OCAT), (const bf16*)((char*)Wl + WO_OUT), DM}; pg8::StaticOrder S; S.init(TOK, DM, F.G, cid);
          EpiRes E{(gbf16*)hb};
          pg8::gemm_phase<pg8::ProbPlain, EpiRes, pg8::StaticOrder, true>(F.lds + RING_OFF, g, S, E); }
        GRID_BAR();
        done_layers = l + 1;
        if (STOP_AFTER <= 10 * l + 1) break;
        DUP(6) PH(6) router_pass(F, args, l);
        GRID_BAR();
        DUP(7) PH(7) { if (F.G == 256) { if (cid < 128) topk_block(F, (cid & 7) * NEXP + (cid >> 3)); }
                       else for (int be = bx; be < BATCH * NEXP; be += F.G) topk_block(F, be); }
        DUP(8) PH(8) { pg8::ProbPlain g{lcur ? (const bf16*)(F.ws + WS_END) : WSP(bf16, WS_PB), (const bf16*)((char*)Wl + WO_PP), PLE}; pg8::StaticOrder S; S.init(TOK, DM, (F.G == 256) ? (cid < 128 ? 512 : 128) : F.G, cid);
          EpiBf E{(gbf16*)WSP(bf16, WS_PPO), DM};
          pg8::gemm_phase<pg8::ProbPlain, EpiBf, pg8::StaticOrder, true>(F.lds + RING_OFF, g, S, E); }
        GRID_BAR();
        DUP(9) PH(9) { pg8::ExpertOrder S; S.init(NSLOT, DM, F.G, cid);
          LAS unsigned* gtab = (LAS unsigned*)(F.lds + GTAB_OFF); const unsigned* sidx = MISCP(unsigned, MO_SIDX);
          { LAUNDER_LANES(); Unit u; for (int i = 0; i < 8; ++i) if (S.next(i, u) && tid < 256) gtab[i * 256 + tid] = sidx[u.pm * 256 + tid]; }
          __syncthreads();
          pg8::ProbGather g{hb, (const bf16*)((char*)Wl + WO_GU), DM, (size_t)DM * DM, gtab};
          EpiSwiglu E{(cgf32*)MISCP(float, MO_SRS), (gbf16*)(big + BO_ACT)};
          pg8::gemm_phase<pg8::ProbGather, EpiSwiglu, pg8::ExpertOrder, true>(F.lds + RING_OFF, g, S, E); }
        GRID_BAR();
        DUP(10) PH(10) { pg8::ProbExpert g{(const bf16*)(big + BO_ACT), (const bf16*)((char*)Wl + WO_DOWN), EFF, (size_t)DM * EFF}; pg8::ExpertOrder S; S.init(NSLOT, DM, F.G, cid);
          EpiDown E{(cgf32*)MISCP(float, MO_SG), (gbf16*)(big + BO_Y)};
          pg8::gemm_phase<pg8::ProbExpert, EpiDown, pg8::ExpertOrder, true>(F.lds + RING_OFF, g, S, E); }
        GRID_BAR();
        PH(11) combine_pass(F);
        if (STOP_AFTER <= 10 * l + 2) { GRID_BAR(); break; }
        GRID_BAR();
        DUP(13) PH(13) { pg8::ProbPlain g{hb, WSP(bf16, WS_WPG) + (size_t)l * DM * DM, DM}; pg8::StaticOrder S; S.init(TOK, DM, F.G, cid);
          EpiPle E{(cgf32*)MISCP(float, MO_RSP), (cgbf16*)WSP(bf16, WS_PPO), (cgbf16*)hb, (gbf16*)(hb_in_out ? WSP(bf16, WS_HB) : (bf16*)F.out), (gf32*)MISCP(float, MO_PSSQ)};
          pg8::gemm_phase<pg8::ProbPlain, EpiPle, pg8::StaticOrder, true>(F.lds + RING_OFF, g, S, E); }
        hb_in_out = !hb_in_out;
        GRID_BAR();
    }
    DUP(14) PH(14) final_norm(F, args);
    if (bx == 0 && threadIdx.x == 0) { unsigned* b = (unsigned*)(F.ws + WS_CTL) + CW_BAR; if (xb_ld(&b[XB_TMO]) != 0u) { const float q = __builtin_nanf(""); F.out[0] = q; } }
#undef GRID_BAR
}

extern "C" void kernel_launch(void* const* d_in, const int* in_sizes, int n_in, void* d_out, int out_size, void* d_ws, size_t ws_size, hipStream_t stream) {
    static int grid = 0;
    if (grid == 0) {
        if (n_in != 20 || in_sizes[0] != TOK * DM || out_size != TOK * DM || ws_size < WS_END + (size_t)TOK * PLE * 2) {
            fprintf(stderr, "kernel_launch: unexpected shapes: n_in %d in0 %d out %d ws %zu (need %zu)\n", n_in, n_in > 0 ? in_sizes[0] : -1, out_size, ws_size, (size_t)WS_END); grid = -1; return; }
        int dev = 0, cus = 0, per_cu = 0;
        if (hipGetDevice(&dev) != hipSuccess || hipDeviceGetAttribute(&cus, hipDeviceAttributeMultiprocessorCount, dev) != hipSuccess) { grid = -1; return; }
        if (hipFuncSetAttribute((const void*)enc_fwd, hipFuncAttributeMaxDynamicSharedMemorySize, LDS_BYTES) != hipSuccess) { fprintf(stderr, "kernel_launch: hipFuncSetAttribute failed\n"); grid = -1; return; }
        if (hipOccupancyMaxActiveBlocksPerMultiprocessor(&per_cu, (const void*)enc_fwd, NWAVES * 64, LDS_BYTES) != hipSuccess || per_cu < 1) {
            fprintf(stderr, "kernel_launch: occupancy query reports %d workgroups per CU\n", per_cu); (void)hipGetLastError(); grid = -1; return; }
        if (cus < 128) { fprintf(stderr, "kernel_launch: needs >= 128 CUs\n"); grid = -1; return; }
        grid = cus;
    }
    if (grid < 0) return;
    if (hipMemsetAsync((char*)d_ws + WS_CTL, 0, CTL_ZERO_BYTES, stream) != hipSuccess) { fprintf(stderr, "kernel_launch: memset failed\n"); return; }
    Args a{};
    for (int i = 0; i < 20; ++i) a.in[i] = (const float*)d_in[i];
    a.out = (float*)d_out; a.ws = (unsigned char*)d_ws;
    for (int i = 0; i < 16; ++i) a.inv16[i] = 1.0 / pow(10000.0, (double)(2 * i) / 32.0);
    for (int i = 0; i < 32; ++i) a.inv32[i] = 1.0 / pow(10000.0, (double)(2 * i) / 64.0);
    void* kargs[] = {&a};
    const hipError_t le = hipLaunchCooperativeKernel((const void*)enc_fwd, dim3(grid), dim3(NWAVES * 64), kargs, LDS_BYTES, stream);
    if (le != hipSuccess) fprintf(stderr, "kernel_launch: launch failed: %s (grid %d)\n", hipGetErrorName(le), grid);
}
```

```cpp
#include <hip/hip_runtime.h>
#include <hip/hip_bf16.h>
#include <cstdio>
#include <cstdint>
#include <cmath>

#ifndef STOP_AFTER
#define STOP_AFTER 99
#endif

namespace pg8 {
#define PG8_LAS __attribute__((address_space(3)))
typedef unsigned short bf16_t;
typedef short bf16x8 __attribute__((ext_vector_type(8)));
typedef float f32x4 __attribute__((ext_vector_type(4)));
typedef unsigned u32x4 __attribute__((ext_vector_type(4)));
typedef unsigned u32x2 __attribute__((ext_vector_type(2)));
constexpr int BM = 256, BK = 64, HALF = 128, HTB = HALF * BK * 2  , STAGE_BYTES = 8 * HTB, NXCD = 8, WGM = 8;

__host__ __device__ __forceinline__ int lds_byte(int r, int c) { const int st = (r >> 4) * 2 + (c >> 5), rr = r & 15, cc = c & 31, ob = rr * 64 + cc * 2; return st * 1024 + (ob ^ (((ob >> 9) & 1) << 5)); }
__host__ __device__ __forceinline__ int perm32(int rho) { const int n = rho >> 4, i = rho & 15; return 8 * (i >> 2) + 4 * n + (i & 3); }
__host__ __device__ __forceinline__ void stage_rc(int b, int& R, int& C) { const int st = b / 1024, sb = b % 1024, swz = sb ^ (((sb >> 9) & 1) << 5); R = (st >> 1) * 16 + swz / 64; C = (st & 1) * 32 + (swz % 64) / 2; }

struct Unit { int pm, pn; };

struct StaticOrder {
    int nM, nN, nwg, G, c;
    __host__ __device__ __forceinline__ void init(int M, int N, int G_, int c_) { nM = M / BM; nN = N / BM; nwg = nM * nN; G = G_; c = c_; }
    __host__ __device__ __forceinline__ bool next(int i, Unit& u) const {
        const long L = (long)i * G + c; if (L >= nwg) return false;
        int wgid = (int)L; { const int q = nwg / NXCD, r = nwg % NXCD, xcd = wgid % NXCD, off = wgid / NXCD; wgid = (xcd < r ? xcd * (q + 1) : r * (q + 1) + (xcd - r) * q) + off; }
        const int nig = WGM * nN, gid = wgid / nig, fm = gid * WGM, gsz = (nM - fm) < WGM ? (nM - fm) : WGM;
        u.pm = fm + ((wgid % nig) % gsz); u.pn = (wgid % nig) / gsz; return true;
    }
};

struct ExpertOrder : StaticOrder {
    __host__ __device__ __forceinline__ bool next(int i, Unit& u) const { if (!StaticOrder::next(i, u)) return false; const int q = u.pm; u.pm = ((((q >> 1) & 7) * 16 + (q >> 4)) << 1) | (q & 1); return true; }
};

struct ProbPlain {
    static constexpr bool GATHER = false;
    const bf16_t* A; const bf16_t* Bt; int K;
    __device__ __forceinline__ const char* a_tile(const Unit& u) const { return (const char*)A + (size_t)u.pm * BM * K * 2; }
    __device__ __forceinline__ const char* a_base() const { return (const char*)A; }
    __device__ __forceinline__ unsigned a_off(int, const Unit& u, int r, int C) const { return (unsigned)(((u.pm * BM + r) * K + C) * 2); }
    __device__ __forceinline__ const char* b_tile(const Unit& u) const { return (const char*)Bt + (size_t)u.pn * BM * K * 2; }
};
struct ProbExpert {
    static constexpr bool GATHER = false;
    const bf16_t* A; const bf16_t* Bt; int K; size_t estride;
    __device__ __forceinline__ const char* a_tile(const Unit& u) const { return (const char*)A + (size_t)u.pm * BM * K * 2; }
    __device__ __forceinline__ const char* a_base() const { return (const char*)A; }
    __device__ __forceinline__ unsigned a_off(int, const Unit& u, int r, int C) const { return (unsigned)(((u.pm * BM + r) * K + C) * 2); }
    __device__ __forceinline__ const char* b_tile(const Unit& u) const { return (const char*)Bt + ((size_t)((u.pm >> 1) & 15) * estride + (size_t)u.pn * BM * K) * 2; }
};
struct ProbGather {
    static constexpr bool GATHER = true;
    const bf16_t* A; const bf16_t* Bt; int K; size_t estride; const PG8_LAS unsigned* gtab;
    __device__ __forceinline__ const char* a_tile(const Unit&) const { return (const char*)A; }
    __device__ __forceinline__ const char* a_base() const { return (const char*)A; }
    __device__ __forceinline__ unsigned a_off(int ui, const Unit&, int r, int C) const { return (unsigned)((gtab[ui * BM + r] * (unsigned)K + (unsigned)C) * 2u); }
    __device__ __forceinline__ const char* b_tile(const Unit& u) const { return (const char*)Bt + ((size_t)((u.pm >> 1) & 15) * estride + (size_t)u.pn * BM * K) * 2; }
};

template <class Prob, class Epi, class Sched, bool ALIGN_EPI>
__device__ __forceinline__ void gemm_phase(PG8_LAS unsigned char* lds, const Prob& g, const Sched& S, const Epi& E) {
    int tid_ = threadIdx.x; asm volatile("" : "+v"(tid_));
    const int tid = tid_, wid = __builtin_amdgcn_readfirstlane(tid >> 6), lane = tid & 63, wr = wid >> 2, wc = wid & 3, fr = lane & 15, fq = lane >> 4;
    const int K = g.K, nt = K / BK;
    int RA[2], CA[2]; unsigned voffB[2], voffA[2];
#pragma unroll
    for (int i = 0; i < 2; ++i) { int R, C; stage_rc(tid * 16 + i * 8192, R, C); RA[i] = R; CA[i] = C; voffA[i] = (unsigned)(R * K + C) * 2u; voffB[i] = (unsigned)(((R & ~31) + perm32(R & 31)) * K + C) * 2u; }
    constexpr bool GATHER = Prob::GATHER;
    const size_t kstep = (size_t)(BK * 2);
    const size_t hstep = (size_t)HALF * K * 2;
    const unsigned ldsw = (unsigned)wid * 1024u;
    const int aoff = lds_byte(wr * 64 + fr, fq * 8), boff = lds_byte(wc * 32 + fr, fq * 8);
#define PG8_SA(b, h) (((b) * 2 + (h)) * HTB)
#define PG8_SB(b, h) ((4 + (b) * 2 + (h)) * HTB)
#define PG8_STAGE_B(bufoff, gbase) do { _Pragma("unroll") for (int _i = 0; _i < 2; ++_i) \
        __builtin_amdgcn_global_load_lds((const unsigned*)((const char*)(gbase) + voffB[_i]), (PG8_LAS unsigned*)(lds + (bufoff) + ldsw + _i * 8192), 16, 0, 0); } while (0)
#define PG8_STAGE_A(bufoff, PT, kb, OFF, h) do { _Pragma("unroll") for (int _i = 0; _i < 2; ++_i) { \
        if constexpr (GATHER) __builtin_amdgcn_global_load_lds((const unsigned*)(Ab + (size_t)(kb) + (size_t)(OFF)[h][_i]), (PG8_LAS unsigned*)(lds + (bufoff) + ldsw + _i * 8192), 16, 0, 0); \
        else __builtin_amdgcn_global_load_lds((const unsigned*)((PT) + (size_t)(kb) + (size_t)(h) * hstep + voffA[_i]), (PG8_LAS unsigned*)(lds + (bufoff) + ldsw + _i * 8192), 16, 0, 0); } } while (0)
#define PG8_LDA(dst, b, h) do { _Pragma("unroll") for (int m = 0; m < 4; ++m) _Pragma("unroll") for (int k = 0; k < 2; ++k) dst[m][k] = *(const PG8_LAS bf16x8*)(lds + PG8_SA(b, h) + aoff + m * 2048 + k * 1024); } while (0)
#define PG8_LDB(dst, b, h) do { _Pragma("unroll") for (int n = 0; n < 2; ++n) _Pragma("unroll") for (int k = 0; k < 2; ++k) dst[n][k] = *(const PG8_LAS bf16x8*)(lds + PG8_SB(b, h) + boff + n * 2048 + k * 1024); } while (0)
#define PG8_MMA(ai, bj, At, Bt) do { __builtin_amdgcn_s_setprio(1); _Pragma("unroll") for (int m = 0; m < 4; ++m) _Pragma("unroll") for (int n = 0; n < 2; ++n) _Pragma("unroll") for (int k = 0; k < 2; ++k) \
        acc[ai][bj][m][n] = __builtin_amdgcn_mfma_f32_16x16x32_bf16(Bt[n][k], At[m][k], acc[ai][bj][m][n], 0, 0, 0); __builtin_amdgcn_s_setprio(0); } while (0)
#define PG8_WAIT_V(n) asm volatile("s_waitcnt vmcnt(" #n ")" ::: "memory")
#define PG8_WAIT_L(n) asm volatile("s_waitcnt lgkmcnt(" #n ")" ::: "memory")
#define PG8_BAR __builtin_amdgcn_s_barrier()
#define PG8_SCHED __builtin_amdgcn_sched_barrier(0)
    Unit cur, nxt; int ui = 0;
    if (!S.next(0, cur)) return;
    f32x4 acc[2][2][4][2];
#pragma unroll
    for (int a = 0; a < 2; ++a)
#pragma unroll
        for (int b = 0; b < 2; ++b)
#pragma unroll
            for (int m = 0; m < 4; ++m)
#pragma unroll
                for (int n = 0; n < 2; ++n) acc[a][b][m][n] = (f32x4){0.f, 0.f, 0.f, 0.f};
    bf16x8 At[4][2], B0[2][2], B1[2][2];
    unsigned aC[2][2], aN[2][2];
    if constexpr (GATHER) {
#pragma unroll
    for (int h = 0; h < 2; ++h)
#pragma unroll
        for (int i = 0; i < 2; ++i) aC[h][i] = g.a_off(0, cur, h * HALF + RA[i], CA[i]);
    }
    const char* const Ab = g.a_base(); const char* cB = g.b_tile(cur); const char* cA = g.a_tile(cur);
    PG8_STAGE_B(PG8_SB(0, 0), cB); PG8_STAGE_B(PG8_SB(0, 1), cB + hstep); PG8_STAGE_A(PG8_SA(0, 0), cA, 0, aC, 0); PG8_STAGE_A(PG8_SA(0, 1), cA, 0, aC, 1);
    if (wr == 1) PG8_BAR;
    PG8_WAIT_V(2); PG8_BAR;
    PG8_STAGE_B(PG8_SB(1, 0), cB + kstep); PG8_STAGE_A(PG8_SA(1, 0), cA, kstep, aC, 0); PG8_STAGE_B(PG8_SB(1, 1), cB + hstep + kstep);
    PG8_WAIT_V(6); PG8_BAR;
    for (;;) {
        const bool has_next = S.next(ui + 1, nxt);
        const char* nB = cB; const char* nA = cA;
        if (has_next) {
            if constexpr (GATHER) {
#pragma unroll
            for (int h = 0; h < 2; ++h)
#pragma unroll
                for (int i = 0; i < 2; ++i) aN[h][i] = g.a_off(ui + 1, nxt, h * HALF + RA[i], CA[i]);
            }
            nB = g.b_tile(nxt); nA = g.a_tile(nxt);
        } else {
            if constexpr (GATHER) {
#pragma unroll
            for (int h = 0; h < 2; ++h)
#pragma unroll
                for (int i = 0; i < 2; ++i) aN[h][i] = aC[h][i];
            }
        }
        for (int t = 0; t < nt; t += 2) {
            const bool last = (t == nt - 2);
            const size_t k1 = (size_t)(t + 1) * kstep;
            const size_t k2 = last ? (size_t)0 : (size_t)(t + 2) * kstep, k3 = k2 + kstep;
            const char* b2 = last ? nB : cB + (size_t)(t + 2) * kstep; const char* b3 = b2 + kstep;
            const char* a2p = last ? nA : cA;
            unsigned a2[2][2];
            if constexpr (GATHER) {
#pragma unroll
            for (int h = 0; h < 2; ++h)
#pragma unroll
                for (int i = 0; i < 2; ++i) a2[h][i] = last ? aN[h][i] : aC[h][i];
            }
            PG8_LDB(B0, 0, 0); PG8_LDB(B1, 0, 1); PG8_SCHED; PG8_LDA(At, 0, 0); PG8_STAGE_A(PG8_SA(1, 1), cA, k1, aC, 1);
            PG8_WAIT_V(8); PG8_WAIT_L(0); PG8_BAR; PG8_MMA(0, 0, At, B0); PG8_MMA(0, 1, At, B1); PG8_BAR; PG8_SCHED;
            PG8_LDA(At, 0, 1); PG8_STAGE_B(PG8_SB(0, 0), b2); PG8_STAGE_B(PG8_SB(0, 1), b2 + hstep); PG8_STAGE_A(PG8_SA(0, 0), a2p, k2, a2, 0);
            PG8_WAIT_V(8); PG8_WAIT_L(0); PG8_BAR; PG8_MMA(1, 0, At, B0); PG8_MMA(1, 1, At, B1); PG8_BAR; PG8_SCHED;
            PG8_LDB(B0, 1, 0); PG8_LDB(B1, 1, 1); PG8_SCHED; PG8_LDA(At, 1, 0); PG8_STAGE_A(PG8_SA(0, 1), a2p, k2, a2, 1);
            PG8_WAIT_V(8); PG8_WAIT_L(0); PG8_BAR; PG8_MMA(0, 0, At, B0); PG8_MMA(0, 1, At, B1); PG8_BAR; PG8_SCHED;
            PG8_LDA(At, 1, 1); PG8_STAGE_B(PG8_SB(1, 0), b3); PG8_STAGE_B(PG8_SB(1, 1), b3 + hstep); PG8_STAGE_A(PG8_SA(1, 0), a2p, k3, a2, 0);
            PG8_WAIT_V(8); PG8_WAIT_L(0); PG8_BAR; PG8_MMA(1, 0, At, B0); PG8_MMA(1, 1, At, B1); PG8_BAR; PG8_SCHED;
        }
        if constexpr (ALIGN_EPI) { if (wr == 0) PG8_BAR; }
        E(acc, cur, ui, wr, wc, fr, fq);
        if (!has_next) break;
#pragma unroll
        for (int a = 0; a < 2; ++a)
#pragma unroll
            for (int b = 0; b < 2; ++b)
#pragma unroll
                for (int m = 0; m < 4; ++m)
#pragma unroll
                    for (int n = 0; n < 2; ++n) acc[a][b][m][n] = (f32x4){0.f, 0.f, 0.f, 0.f};
        cur = nxt; cB = nB; cA = nA; ++ui;
        if constexpr (GATHER) {
#pragma unroll
        for (int h = 0; h < 2; ++h)
#pragma unroll
            for (int i = 0; i < 2; ++i) aC[h][i] = aN[h][i];
        }
        if constexpr (ALIGN_EPI) { if (wr == 1) PG8_BAR; }
    }
    PG8_WAIT_V(0);
    if constexpr (!ALIGN_EPI) { if (wr == 0) PG8_BAR; }
    PG8_BAR;
#undef PG8_SA
#undef PG8_SB
#undef PG8_STAGE_A
#undef PG8_STAGE_B
#undef PG8_LDA
#undef PG8_LDB
#undef PG8_MMA
#undef PG8_WAIT_V
#undef PG8_WAIT_L
#undef PG8_BAR
#undef PG8_SCHED
}
}
namespace att {
#define ATT_LAS __attribute__((address_space(3)))
#define ATT_GAS __attribute__((address_space(1)))
typedef unsigned short bf16;
using bf16x8 = __attribute__((ext_vector_type(8))) short;
using s16x4  = __attribute__((ext_vector_type(4))) short;
using f32x16 = __attribute__((ext_vector_type(16))) float;
using u32x4  = __attribute__((ext_vector_type(4))) unsigned;
constexpr int NW = 8, QBLK = 32, KVBLK = 64;
constexpr float THR = 8.f;
constexpr int SHM_V = 8192, KBUF = 13312, OFF_K = 3 * SHM_V, OFF_WS = OFF_K + 3 * KBUF, OFF_BT = OFF_WS + NW * 64 * 4, OFF_OST = OFF_BT + 8192, LDS_BYTES = OFF_OST + NW * 4608;
#define SBAR() __builtin_amdgcn_sched_barrier(0)
__device__ __forceinline__ int crow(int r, int hi) { return (r & 3) + 8 * (r >> 2) + 4 * hi; }
__device__ __forceinline__ unsigned cvtpk(float lo, float hi) { unsigned r; asm volatile("v_cvt_pk_bf16_f32 %0, %1, %2" : "=v"(r) : "v"(lo), "v"(hi)); return r; }
__device__ __forceinline__ int clampi(int v, int lo, int hi) { return v < lo ? lo : (v > hi ? hi : v); }

template <bool TWO>
__device__ __forceinline__ void partialSM(f32x16& p0, f32x16& p1, float& m_reg, f32x16& negm, f32x16& negm2, float& alpha, bool& have_ref) {
  float pmax = fmaxf(fmaxf(p0[0], p0[1]), p1[0]);
#pragma unroll
  for (int r = 2; r < 16; r += 2) pmax = fmaxf(fmaxf(pmax, p0[r]), p0[r + 1]);
#pragma unroll
  for (int r = 1; r < 15; r += 2) pmax = fmaxf(fmaxf(pmax, p1[r]), p1[r + 1]);
  pmax = fmaxf(pmax, p1[15]);
  { auto rr = __builtin_amdgcn_permlane32_swap(__float_as_uint(pmax), __float_as_uint(pmax), false, false);
    pmax = fmaxf(__uint_as_float(rr[0]), __uint_as_float(rr[1])); }
  alpha = 1.f;
  if (__builtin_expect(!have_ref || !__all(pmax <= THR), 0)) { const float dl = have_ref ? fmaxf(pmax, 0.f) : pmax; have_ref = true; m_reg += dl; alpha = __builtin_amdgcn_exp2f(-dl);
#pragma unroll
    for (int r = 0; r < 16; ++r) { p0[r] -= dl; p1[r] -= dl; }
#pragma unroll
    for (int r = 0; r < 16; ++r) negm[r] -= dl;
    asm volatile("" : "+v"(negm));
    if constexpr (TWO) {
#pragma unroll
      for (int r = 0; r < 16; ++r) negm2[r] -= dl;
      asm volatile("" : "+v"(negm2)); } }
#pragma unroll
  for (int r = 0; r < 16; ++r) p0[r] = __builtin_amdgcn_exp2f(p0[r]);
}
__device__ __forceinline__ float psm_max(const f32x16& p0, const f32x16& p1) {
  float pmax = fmaxf(fmaxf(p0[0], p0[1]), p1[0]);
#pragma unroll
  for (int r = 2; r < 16; r += 2) pmax = fmaxf(fmaxf(pmax, p0[r]), p0[r + 1]);
#pragma unroll
  for (int r = 1; r < 15; r += 2) pmax = fmaxf(fmaxf(pmax, p1[r]), p1[r + 1]);
  pmax = fmaxf(pmax, p1[15]);
  auto rr = __builtin_amdgcn_permlane32_swap(__float_as_uint(pmax), __float_as_uint(pmax), false, false);
  return fmaxf(__uint_as_float(rr[0]), __uint_as_float(rr[1]));
}
__device__ __forceinline__ void psm_decide(f32x16& p0, f32x16& p1, float pmax, float& m_reg, f32x16& negm, float& alpha, bool& have_ref) {
  alpha = 1.f;
  if (__builtin_expect(!have_ref || !__all(pmax <= THR), 0)) { const float dl = have_ref ? fmaxf(pmax, 0.f) : pmax; have_ref = true; m_reg += dl; alpha = __builtin_amdgcn_exp2f(-dl);
#pragma unroll
    for (int r = 0; r < 16; ++r) { p0[r] -= dl; p1[r] -= dl; }
#pragma unroll
    for (int r = 0; r < 16; ++r) negm[r] -= dl;
    asm volatile("" : "+v"(negm)); }
}
__device__ __forceinline__ void psm_exp(f32x16& p0) {
#pragma unroll
  for (int r = 0; r < 16; ++r) p0[r] = __builtin_amdgcn_exp2f(p0[r]);
}
__device__ __forceinline__ void finishSM(f32x16& p0, f32x16& p1, float alpha, float& l_reg, bf16x8& pa0, bf16x8& pa1, bf16x8& pa2, bf16x8& pa3) {
#pragma unroll
  for (int r = 0; r < 16; ++r) p1[r] = __builtin_amdgcn_exp2f(p1[r]);
  float ps;
  { typedef float f8 __attribute__((ext_vector_type(8))); typedef float f4 __attribute__((ext_vector_type(4))); typedef float f2 __attribute__((ext_vector_type(2)));
    const f32x16 t16 = p0 + p1; const f8 t8 = t16.lo + t16.hi; const f4 t4 = t8.lo + t8.hi; const f2 t2 = t4.lo + t4.hi; ps = t2.x + t2.y; }
  { auto rr = __builtin_amdgcn_permlane32_swap(__float_as_uint(ps), __float_as_uint(ps), false, false);
    ps = __uint_as_float(rr[0]) + __uint_as_float(rr[1]); }
  l_reg = l_reg * alpha + ps;
#define PK4(P, BASE, OUT) do { unsigned a0 = cvtpk(P[BASE + 0], P[BASE + 1]), a1 = cvtpk(P[BASE + 2], P[BASE + 3]);   \
    unsigned b0 = cvtpk(P[BASE + 4], P[BASE + 5]), b1 = cvtpk(P[BASE + 6], P[BASE + 7]);                              \
    auto r0 = __builtin_amdgcn_permlane32_swap(a0, b0, false, false); auto r1 = __builtin_amdgcn_permlane32_swap(a1, b1, false, false); \
    u32x4 w = {r0[0], r1[0], r0[1], r1[1]}; OUT = __builtin_bit_cast(bf16x8, w); } while (0)
  PK4(p0, 0, pa0); PK4(p0, 8, pa1); PK4(p1, 0, pa2); PK4(p1, 8, pa3);
#undef PK4
}
template <int DQK, int H> __device__ __forceinline__ void kload(bf16x8* kf, const ATT_LAS char* Ks, int r32, int hi) {
  constexpr int KST = DQK * 2 + 16, NH = DQK / 32;
#pragma unroll
  for (int i = 0; i < NH; ++i) { const int d0 = H * NH + i; const int cb = (d0 * 16 + hi * 8) * 2;
    kf[2 * i] = *(const ATT_LAS bf16x8*)(Ks + r32 * KST + cb);
    kf[2 * i + 1] = *(const ATT_LAS bf16x8*)(Ks + (32 + r32) * KST + cb); }
}
template <int DQK, int H> __device__ __forceinline__ void qk_mma(f32x16& p0, f32x16& p1, const bf16x8* kf, const bf16x8* qr, const f32x16& negm, const f32x16& negm2) {
  constexpr int NH = DQK / 32;
  if (H == 0) { p0 = negm; p1 = negm2; }
#pragma unroll
  for (int i = 0; i < NH; ++i) { const int d0 = H * NH + i;
    p0 = __builtin_amdgcn_mfma_f32_32x32x16_bf16(kf[2 * i], qr[d0], p0, 0, 0, 0);
    p1 = __builtin_amdgcn_mfma_f32_32x32x16_bf16(kf[2 * i + 1], qr[d0], p1, 0, 0, 0); }
}
__device__ __forceinline__ int v_st(int k, int c) { const int kk = (k & ~0xC) | ((k & 4) << 1) | ((k & 8) >> 1); return ((kk >> 3) * 2 + (c >> 5)) * 512 + ((kk & 7) * 32 + (c & 31)) * 2; }
__device__ __forceinline__ int v_rd_base(int lane) { return ((lane & 3) << 3) | (((lane >> 2) & 3) << 6) | (((lane >> 4) & 1) << 5) | (((lane >> 5) & 1) << 8); }
constexpr int v_rd_off(int d0, int ks, int half) { return d0 * 512 + ks * 2048 + half * 1024; }
typedef short v4i16_t __attribute__((ext_vector_type(4)));
__device__ __forceinline__ s16x4 vtr(const ATT_LAS char* p) { return __builtin_bit_cast(s16x4, __builtin_amdgcn_ds_read_tr16_b64_v4i16((ATT_LAS v4i16_t*)p)); }
__device__ __forceinline__ void vload(s16x4* vf, const ATT_LAS char* vp) {
#pragma unroll
  for (int d0 = 0; d0 < 2; ++d0)
#pragma unroll
    for (int ks = 0; ks < 4; ++ks) { vf[d0 * 8 + ks * 2] = vtr(vp + v_rd_off(d0, ks, 0)); vf[d0 * 8 + ks * 2 + 1] = vtr(vp + v_rd_off(d0, ks, 1)); }
}
template <int D0> __device__ __forceinline__ void pv_mma1(f32x16& od, const s16x4* vf, bf16x8 pa0, bf16x8 pa1, bf16x8 pa2, bf16x8 pa3) {
#define PKV(i) (bf16x8){vf[i][0], vf[i][1], vf[i][2], vf[i][3], vf[(i) + 1][0], vf[(i) + 1][1], vf[(i) + 1][2], vf[(i) + 1][3]}
  od = __builtin_amdgcn_mfma_f32_32x32x16_bf16(pa0, PKV(D0 * 8 + 0), od, 0, 0, 0);
  od = __builtin_amdgcn_mfma_f32_32x32x16_bf16(pa1, PKV(D0 * 8 + 2), od, 0, 0, 0);
  od = __builtin_amdgcn_mfma_f32_32x32x16_bf16(pa2, PKV(D0 * 8 + 4), od, 0, 0, 0);
  od = __builtin_amdgcn_mfma_f32_32x32x16_bf16(pa3, PKV(D0 * 8 + 6), od, 0, 0, 0);
#undef PKV
}
__device__ __forceinline__ void pv_mma(f32x16* o, const s16x4* vf, bf16x8 pa0, bf16x8 pa1, bf16x8 pa2, bf16x8 pa3) {
#define PKV(i) (bf16x8){vf[i][0], vf[i][1], vf[i][2], vf[i][3], vf[(i) + 1][0], vf[(i) + 1][1], vf[(i) + 1][2], vf[(i) + 1][3]}
#pragma unroll
  for (int d0 = 0; d0 < 2; ++d0) {
    o[d0] = __builtin_amdgcn_mfma_f32_32x32x16_bf16(pa0, PKV(d0 * 8 + 0), o[d0], 0, 0, 0);
    o[d0] = __builtin_amdgcn_mfma_f32_32x32x16_bf16(pa1, PKV(d0 * 8 + 2), o[d0], 0, 0, 0);
    o[d0] = __builtin_amdgcn_mfma_f32_32x32x16_bf16(pa2, PKV(d0 * 8 + 4), o[d0], 0, 0, 0);
    o[d0] = __builtin_amdgcn_mfma_f32_32x32x16_bf16(pa3, PKV(d0 * 8 + 6), o[d0], 0, 0, 0); }
#undef PKV
}

struct AttnIO { const ATT_GAS bf16* q; const ATT_GAS bf16* k; const ATT_GAS bf16* k2; const ATT_GAS bf16* v; ATT_GAS bf16* o; int ldq, ldk, ldk2, ldv, ldo; };

__device__ __forceinline__ bool mla_fixed_ref(const AttnIO io, float km2, float& mrow) {
  int tid_ = threadIdx.x; asm volatile("" : "+v"(tid_));
  const int wid = __builtin_amdgcn_readfirstlane(tid_ >> 6), lane = tid_ & 63, r32 = lane & 31, hi = lane >> 5;
  const ATT_GAS bf16* Qw = io.q + (size_t)(wid * QBLK + r32) * io.ldq + hi * 8; float q2 = 0.f;
#pragma unroll
  for (int d0 = 0; d0 < 6; ++d0) { const bf16x8 v = *(const ATT_GAS bf16x8*)(Qw + d0 * 16);
#pragma unroll
    for (int e = 0; e < 8; ++e) { const float x = __uint_as_float((unsigned)(unsigned short)v[e] << 16); q2 += x * x; } }
  { auto rr = __builtin_amdgcn_permlane32_swap(__float_as_uint(q2), __float_as_uint(q2), false, false); q2 = __uint_as_float(rr[0]) + __uint_as_float(rr[1]); }
  mrow = sqrtf(q2 * km2) * 1.02f;
  return __all(mrow <= 64.f);
}
template <int MODE, bool FIXED = false>
__device__ __forceinline__ void attn_unit(const AttnIO io, const int par, const float sinkl2, const ATT_GAS float* rpb_h, ATT_LAS char* lds) {
  constexpr int DQK = (MODE == 0) ? 96 : 64, ND0 = DQK / 16, KST = DQK * 2 + 16;
  int tid_ = threadIdx.x; asm volatile("" : "+v"(tid_));
  const int tid = tid_, wid = __builtin_amdgcn_readfirstlane(tid >> 6), lane = tid & 63, r32 = lane & 31, hi = lane >> 5;
  ATT_LAS char* V_lds = lds; ATT_LAS char* K_lds = lds + OFF_K;
  ATT_LAS float* ws = (ATT_LAS float*)(lds + OFF_WS) + wid * 64; ATT_LAS float* li_l = ws; ATT_LAS float* al_l = ws + 32;
  ATT_LAS float* btab = (ATT_LAS float*)(lds + OFF_BT);
  int NT, t0, r0w = 0, rq = 0;
  if constexpr (MODE == 0) { NT = 64; t0 = 0; }
  else if constexpr (MODE == 1) { const int rq0 = 4 * par; const int klo = clampi(rq0 - 4, 0, 56), khi = clampi(rq0 - 1, 0, 56) + 7; NT = (khi - klo + 2) & ~1; t0 = klo;
    rq = rq0 + (wid >> 1); r0w = clampi(rq - 4, 0, 56);
    for (int i = tid; i < 15 * 128; i += 512) { const int dc = (i & 127) - 63; btab[i] = (dc >= -15 && dc <= 15) ? rpb_h[(i >> 7) * 31 + dc + 15] * 1.4426950408889634f : 0.f; } }
  else { NT = 8; t0 = 4 * par - 2; }
#define ACTIVE(j) ((MODE == 0) ? true : (MODE == 1) ? (((t0 + (j)) >= r0w) && ((t0 + (j)) < r0w + 8)) : \
                   (((t0 + (j)) >= 0) && ((t0 + (j)) <= 63) && (64 * (j) + 63 >= 32 * wid) && (64 * (j) <= 32 * wid + 287)))
  float m_reg = (MODE == 2) ? sinkl2 : 0.f, l_reg = (MODE == 2) ? 1.f : 0.f; f32x16 o[2] = {}; bf16x8 qr[ND0];
  { const ATT_GAS bf16* Qw = io.q + (size_t)(wid * QBLK + r32) * io.ldq + hi * 8;
#pragma unroll
    for (int d0 = 0; d0 < ND0; ++d0) qr[d0] = *(const ATT_GAS bf16x8*)(Qw + d0 * 16); }
  constexpr bool fixed = FIXED;
  if constexpr (FIXED) m_reg = sinkl2;
  f32x16 negm;
#pragma unroll
  for (int r = 0; r < 16; ++r) negm[r] = -m_reg;
  f32x16 negm2v;
  if constexpr (MODE == 1) { const int qc_ = 32 * (wid & 1) + r32; const int c0_ = clampi(qc_ - 8, 0, 48);
#pragma unroll
    for (int r = 0; r < 16; ++r) { const int ka_ = crow(r, hi), kb_ = ka_ + 32; negm2v[r] = ((kb_ >= c0_) && (kb_ < c0_ + 16)) ? 0.f : -1e30f; negm[r] = ((ka_ >= c0_) && (ka_ < c0_ + 16)) ? 0.f : -1e30f; }
    asm volatile("" : "+v"(negm2v)); }
  asm volatile("" : "+v"(negm));
#define NEGM2 (*((MODE == 1) ? &negm2v : &negm))
  const int sr = tid >> 3, sc = (tid & 7) * 8, vst0 = v_st(sr, sc), kst0 = sr * KST + sc * 2;
  const int sr2 = (tid & 255) >> 2, sc2 = (tid & 3) * 8, kst2 = sr2 * KST + (64 + sc2) * 2;
  const ATT_LAS char* vb0 = V_lds + v_rd_base(lane);
  bf16x8 st_v, st_k, st_k2;
#define TOK(j) (64 * clampi(t0 + (j), 0, 63))
#define SLOAD(j) do { const int tk_ = TOK(j); st_v = *(const ATT_GAS bf16x8*)(io.v + (size_t)(tk_ + sr) * io.ldv + sc); \
    st_k = *(const ATT_GAS bf16x8*)(io.k + (size_t)(tk_ + sr) * io.ldk + sc); \
    if constexpr (MODE == 0) { if (wid < 4) st_k2 = *(const ATT_GAS bf16x8*)(io.k2 + (size_t)(tk_ + sr2) * io.ldk2 + sc2); } } while (0)
#define SWRITE(b) do { *(ATT_LAS bf16x8*)(V_lds + (b) * SHM_V + vst0) = st_v; *(ATT_LAS bf16x8*)(K_lds + (b) * KBUF + kst0) = st_k; \
    if constexpr (MODE == 0) { if (wid < 4) *(ATT_LAS bf16x8*)(K_lds + (b) * KBUF + kst2) = st_k2; } } while (0)
#define RESC(a) do { if (__any((a) < 1.f)) { if (hi == 0) al_l[r32] = (a); asm volatile("s_waitcnt lgkmcnt(0)" ::: "memory"); \
    _Pragma("unroll") for (int d = 0; d < 2; ++d) _Pragma("unroll") for (int r = 0; r < 16; ++r) o[d][r] *= al_l[crow(r, hi)]; } } while (0)
#define MASK(P0, P1, j) do { \
    if constexpr (MODE == 1) { const ATT_LAS float* bt_ = btab + ((t0 + (j)) - rq + 7) * 128 + (4 * hi - (32 * (wid & 1) + r32) + 63); \
      _Pragma("unroll") for (int r = 0; r < 16; ++r) { P0[r] += bt_[(r & 3) + 8 * (r >> 2)]; P1[r] += bt_[(r & 3) + 8 * (r >> 2) + 32]; } } \
    else if constexpr (MODE == 2) { if (!((64 * (j) - 32 * wid - 31 >= 0) && (64 * (j) - 32 * wid <= 193))) { const int rel_ = 64 * (j) - 128 - 32 * wid - r32; \
      _Pragma("unroll") for (int r = 0; r < 16; ++r) { const int da_ = rel_ + crow(r, hi), db_ = da_ + 32; \
        P0[r] = (da_ >= -128 && da_ <= 128) ? P0[r] : -1e30f; P1[r] = (db_ >= -128 && db_ <= 128) ? P1[r] : -1e30f; } } } } while (0)
  f32x16 pA0, pA1, pB0, pB1; float alA = 1.f, alB = 1.f; bf16x8 pa0, pa1, pa2, pa3;
  bool actA = false, actB = false, have_ref = (MODE == 2) || fixed;
  int bc = 0, bp = 2, bn = 1;
#define ROT() do { const int t_ = bp; bp = bc; bc = bn; bn = t_; } while (0)
#define QKALL(P0, P1, Kp) do { bf16x8 kf0_[ND0], kf1_[ND0]; kload<DQK, 0>(kf0_, Kp, r32, hi); kload<DQK, 1>(kf1_, Kp, r32, hi); SBAR(); \
      qk_mma<DQK, 0>(P0, P1, kf0_, qr, negm, NEGM2); qk_mma<DQK, 1>(P0, P1, kf1_, qr, negm, NEGM2); } while (0)
#define SGB(mask, n) __builtin_amdgcn_sched_group_barrier(mask, n, 0)
#define STEP(PX0, PX1, alX, actX, PY0, PY1, alY, actY, j) do { \
    if ((j) + 1 < NT) SWRITE(bn); \
    if ((j) + 2 < NT) SLOAD((j) + 2); \
    actX = ACTIVE(j); \
    const ATT_LAS char* Kc_ = K_lds + bc * KBUF; const ATT_LAS char* vp_ = vb0 + bp * SHM_V; \
    SBAR(); \
    if constexpr (MODE == 0) { \
        \
      { bf16x8 kf0_[ND0], kf1_[ND0]; kload<DQK, 0>(kf0_, Kc_, r32, hi); kload<DQK, 1>(kf1_, Kc_, r32, hi); \
        qk_mma<DQK, 0>(PX0, PX1, kf0_, qr, negm, negm); qk_mma<DQK, 1>(PX0, PX1, kf1_, qr, negm, negm); \
        finishSM(PY0, PY1, alY, l_reg, pa0, pa1, pa2, pa3); \
        SGB(0x100, 12); \
        _Pragma("unroll") for (int g_ = 0; g_ < 12; ++g_) { SGB(0x008, 1); SGB(0x402, 6); } } \
      SBAR(); \
      { s16x4 vf_[16]; vload(vf_, vp_); \
        pv_mma1<0>(o[0], vf_, pa0, pa1, pa2, pa3); \
        const float pm_ = psm_max(PX0, PX1); \
        SGB(0x100, 16); \
        _Pragma("unroll") for (int g_ = 0; g_ < 4; ++g_) { SGB(0x008, 1); SGB(0x402, 10); } \
        SBAR(); \
        psm_decide(PX0, PX1, pm_, m_reg, negm, alX, have_ref); \
        SBAR(); \
        pv_mma1<1>(o[1], vf_, pa0, pa1, pa2, pa3); \
        psm_exp(PX0); \
        _Pragma("unroll") for (int g_ = 0; g_ < 4; ++g_) { SGB(0x008, 1); SGB(0x402, 4); } } \
      SBAR(); \
      RESC(alX); \
    } else { \
      if (actX) { QKALL(PX0, PX1, Kc_); MASK(PX0, PX1, j); } SBAR(); \
      if (actY) { s16x4 vf_[16]; vload(vf_, vp_); SBAR(); finishSM(PY0, PY1, alY, l_reg, pa0, pa1, pa2, pa3); SBAR(); pv_mma(o, vf_, pa0, pa1, pa2, pa3); } SBAR(); \
      if (actX) { partialSM<MODE == 1>(PX0, PX1, m_reg, negm, NEGM2, alX, have_ref); RESC(alX); } \
    } \
    ROT(); \
    __syncthreads(); } while (0)
#define STEPF(PX0, PX1, PY0, PY1, j) do { \
    if ((j) + 1 < NT) SWRITE(bn); \
    if ((j) + 2 < NT) SLOAD((j) + 2); \
    const ATT_LAS char* Kc_ = K_lds + bc * KBUF; const ATT_LAS char* vp_ = vb0 + bp * SHM_V; \
    SBAR(); \
    { bf16x8 kf0_[ND0], kf1_[ND0]; kload<DQK, 0>(kf0_, Kc_, r32, hi); kload<DQK, 1>(kf1_, Kc_, r32, hi); \
      qk_mma<DQK, 0>(PX0, PX1, kf0_, qr, negm, negm); qk_mma<DQK, 1>(PX0, PX1, kf1_, qr, negm, negm); \
      finishSM(PY0, PY1, 1.f, l_reg, pa0, pa1, pa2, pa3); \
      SGB(0x100, 12); \
      _Pragma("unroll") for (int g_ = 0; g_ < 12; ++g_) { SGB(0x008, 1); SGB(0x402, 6); } } \
    SBAR(); \
    { s16x4 vf_[16]; vload(vf_, vp_); \
      pv_mma(o, vf_, pa0, pa1, pa2, pa3); \
      psm_exp(PX0); \
      SGB(0x100, 16); \
      _Pragma("unroll") for (int g_ = 0; g_ < 8; ++g_) { SGB(0x008, 1); SGB(0x402, 2); } } \
    SBAR(); \
    ROT(); \
    __syncthreads(); } while (0)
  SLOAD(0); SWRITE(0); SLOAD(1); __syncthreads();
  actA = ACTIVE(0);
  SWRITE(1); if (2 < NT) SLOAD(2);
  if (actA) { QKALL(pA0, pA1, K_lds); MASK(pA0, pA1, 0); if (MODE == 0 && fixed) psm_exp(pA0); else partialSM<MODE == 1>(pA0, pA1, m_reg, negm, NEGM2, alA, have_ref); }
  ROT(); __syncthreads();
  if constexpr (MODE == 0 && FIXED) {
    actB = true;
    for (int j = 1; j + 1 < NT; j += 2) {
      STEPF(pB0, pB1, pA0, pA1, j);
      STEPF(pA0, pA1, pB0, pB1, j + 1);
    }
    STEPF(pB0, pB1, pA0, pA1, NT - 1);
  } else {
  for (int j = 1; j + 1 < NT; j += 2) {
    STEP(pB0, pB1, alB, actB, pA0, pA1, alA, actA, j);
    STEP(pA0, pA1, alA, actA, pB0, pB1, alB, actB, j + 1);
  }
  STEP(pB0, pB1, alB, actB, pA0, pA1, alA, actA, NT - 1);
  }
  if (actB) { s16x4 vf_[16]; vload(vf_, vb0 + bp * SHM_V); finishSM(pB0, pB1, alB, l_reg, pa0, pa1, pa2, pa3); SBAR(); pv_mma(o, vf_, pa0, pa1, pa2, pa3); }
#undef STEP
#undef STEPF
#undef SGB
#undef QKALL
#undef NEGM2
#undef ROT
  if (hi == 0) li_l[r32] = l_reg; asm volatile("s_waitcnt lgkmcnt(0)" ::: "memory");
  float rli[16];
#pragma unroll
  for (int r = 0; r < 16; ++r) rli[r] = __builtin_amdgcn_rcpf(li_l[crow(r, hi)]);
  ATT_GAS bf16* Ow = io.o + (size_t)(wid * QBLK) * io.ldo;
  { ATT_LAS char* stg = lds + OFF_OST + wid * 4608;
#pragma unroll
    for (int r = 0; r < 16; ++r) { const int orow = crow(r, hi);
#pragma unroll
      for (int d0 = 0; d0 < 2; ++d0) { const float val = o[d0][r] * rli[r]; *(ATT_LAS bf16*)(stg + orow * 144 + (d0 * 32 + r32) * 2) = (bf16)(cvtpk(val, val) & 0xffffu); } }
    asm volatile("s_waitcnt lgkmcnt(0)" ::: "memory");
#pragma unroll
    for (int i = 0; i < 4; ++i) { const int row = i * 8 + (lane >> 3), ch = lane & 7; const u32x4 v = *(const ATT_LAS u32x4*)(stg + row * 144 + ch * 16); *(ATT_GAS u32x4*)(Ow + (size_t)row * io.ldo + ch * 8) = v; } }
  __syncthreads();
#undef ACTIVE
#undef TOK
#undef SLOAD
#undef SWRITE
#undef RESC
#undef MASK
}

constexpr int K16B = 12288, V16B = 10240, V16ST = 160, OFF16_V = 3 * K16B, OFF16_WS = OFF16_V + 3 * V16B, OFF16_OST = OFF16_WS + NW * 256, OFF_FLAG = 122880;
static_assert(OFF16_OST + NW * 4608 <= OFF_FLAG && LDS_BYTES <= OFF_FLAG, "attention LDS map");
__device__ __forceinline__ int fkey(int k) { return (4 - ((k >> 2) & 3)) & 3; }
template <int NQB>
__device__ __forceinline__ void attn_unit16(const AttnIO io, const int role, ATT_LAS char* lds) {
  typedef float f32x4 __attribute__((ext_vector_type(4)));
  int tid_ = threadIdx.x; asm volatile("" : "+v"(tid_));
  const int tid = tid_, wid = __builtin_amdgcn_readfirstlane(tid >> 6), lane = tid & 63, c = lane & 15, g = lane >> 4;
  ATT_LAS char* K_lds = lds; ATT_LAS char* V_lds = lds + OFF16_V;
  ATT_LAS float* li_l = (ATT_LAS float*)(lds + OFF16_WS) + wid * 64;
  constexpr int NT = 64, WQ = 16 * NQB;
  bf16x8 qf[NQB][3];
  { const ATT_GAS bf16* Qw = io.q + (size_t)(wid * WQ + c) * io.ldq + g * 8;
#pragma unroll
    for (int qb = 0; qb < NQB; ++qb)
#pragma unroll
      for (int ks = 0; ks < 3; ++ks) qf[qb][ks] = *(const ATT_GAS bf16x8*)(Qw + (size_t)(16 * qb) * io.ldq + ks * 32); }
  const int gch = (lane & 3) ^ ((4 - g) & 3);
  const unsigned koff = (unsigned)((16 * (wid & 3) + (lane >> 2)) * io.ldk + 32 * (wid >> 2) + 8 * gch) * 2u;
  const unsigned k2off = (unsigned)((16 * (wid & 3) + (lane >> 2)) * io.ldk2 + 8 * gch) * 2u;
  const int vsA = 64 * ((wid + 4) & 7) + lane, vsB = 64 * ((wid < 4 ? wid : wid + 4) + (wid < 4 ? 4 : 0)) + lane;
  const unsigned voffA = (unsigned)((vsA / 10) * io.ldv + 8 * ((vsA % 10) > 7 ? 7 : (vsA % 10))) * 2u, voffB = (unsigned)((vsB / 10) * io.ldv + 8 * ((vsB % 10) > 7 ? 7 : (vsB % 10))) * 2u;
  const ATT_LAS char* kb0 = K_lds + c * 64 + ((g ^ fkey(c)) * 16);
  const ATT_LAS char* vb0 = V_lds + (4 * g + ((lane >> 2) & 3)) * V16ST + (lane & 3) * 8;
#define DMA16(src, dst) do { const ATT_GAS char* s_ = (const ATT_GAS char*)(src); const unsigned d_ = (unsigned)__builtin_amdgcn_readfirstlane((int)(unsigned)(size_t)(dst)); \
    asm volatile("s_mov_b32 m0, %1\n\ts_nop 0\n\tglobal_load_lds_dwordx4 %0, off" :: "v"(s_), "s"(d_) : "memory", "m0"); } while (0)
#define STAGEK(j, b) do { DMA16((const ATT_GAS char*)(io.k + (size_t)(64 * (j)) * io.ldk) + koff, K_lds + (b) * K16B + wid * 1024); \
    if (wid < 4) DMA16((const ATT_GAS char*)(io.k2 + (size_t)(64 * (j)) * io.ldk2) + k2off, K_lds + (b) * K16B + (8 + wid) * 1024); } while (0)
#define STAGEV(j, b) do { DMA16((const ATT_GAS char*)(io.v + (size_t)(64 * (j)) * io.ldv) + voffA, V_lds + (b) * V16B + ((wid + 4) & 7) * 1024); \
    if (wid == 4 || wid == 5) DMA16((const ATT_GAS char*)(io.v + (size_t)(64 * (j)) * io.ldv) + voffB, V_lds + (b) * V16B + (wid + 4) * 1024); } while (0)
#define BAR16() do { asm volatile("s_waitcnt lgkmcnt(0)" ::: "memory"); __builtin_amdgcn_s_barrier(); asm volatile("" ::: "memory"); } while (0)
#define BAR16V() do { asm volatile("s_waitcnt vmcnt(0) lgkmcnt(0)" ::: "memory"); __builtin_amdgcn_s_barrier(); asm volatile("" ::: "memory"); } while (0)
#define KREAD(KF, Kc, ks, kp) do { _Pragma("unroll") for (int kb_ = 0; kb_ < 2; ++kb_) KF[kb_] = *(const ATT_LAS bf16x8*)((Kc) + (ks) * 4096 + (2 * (kp) + kb_) * 1024); } while (0)
#define VREAD(VF, Vc, s, dp) do { _Pragma("unroll") for (int db_ = 0; db_ < 2; ++db_) { const s16x4 lo_ = vtr((Vc) + (s) * 32 * V16ST + (2 * (dp) + db_) * 32), hi_ = vtr((Vc) + ((s) * 32 + 16) * V16ST + (2 * (dp) + db_) * 32); \
      VF[db_] = (bf16x8){lo_[0], lo_[1], lo_[2], lo_[3], hi_[0], hi_[1], hi_[2], hi_[3]}; } } while (0)
#define QKMMA(KF, ks, kp) do { _Pragma("unroll") for (int kb_ = 0; kb_ < 2; ++kb_) _Pragma("unroll") for (int qb_ = 0; qb_ < NQB; ++qb_) \
      S[2 * (kp) + kb_][qb_] = __builtin_amdgcn_mfma_f32_16x16x32_bf16(KF[kb_], qf[qb_][ks], ((ks) == 0) ? (f32x4){0.f, 0.f, 0.f, 0.f} : S[2 * (kp) + kb_][qb_], 0, 0, 0); } while (0)
#define PVMMA(VF, s, dp) do { _Pragma("unroll") for (int db_ = 0; db_ < 2; ++db_) _Pragma("unroll") for (int qb_ = 0; qb_ < NQB; ++qb_) \
      o[qb_][2 * (dp) + db_] = __builtin_amdgcn_mfma_f32_16x16x32_bf16(pa[qb_][s], VF[db_], o[qb_][2 * (dp) + db_], 0, 0, 0); } while (0)
#define QKALL16(Kc, KFA, KFB) do { KREAD(KFB, Kc, 1, 0); QKMMA(KFA, 0, 0); SBAR(); KREAD(KFA, Kc, 2, 0); QKMMA(KFB, 1, 0); SBAR(); KREAD(KFB, Kc, 0, 1); QKMMA(KFA, 2, 0); SBAR(); \
      KREAD(KFA, Kc, 1, 1); QKMMA(KFB, 0, 1); SBAR(); KREAD(KFB, Kc, 2, 1); QKMMA(KFA, 1, 1); SBAR(); QKMMA(KFB, 2, 1); } while (0)
  f32x4 o[NQB][4];
#pragma unroll
  for (int qb = 0; qb < NQB; ++qb)
#pragma unroll
    for (int db = 0; db < 4; ++db) o[qb][db] = (f32x4){0.f, 0.f, 0.f, 0.f};
  f32x4 lacc[NQB];
#pragma unroll
  for (int qb = 0; qb < NQB; ++qb) lacc[qb] = (f32x4){0.f, 0.f, 0.f, 0.f};
  bf16x8 ones8; { const u32x4 w1 = {0x3F803F80u, 0x3F803F80u, 0x3F803F80u, 0x3F803F80u}; ones8 = __builtin_bit_cast(bf16x8, w1); asm volatile("" : "+v"(ones8)); }
  f32x4 S[4][NQB];
  STAGEK(0, 0); STAGEV(0, 0); STAGEK(1, 1);
  asm volatile("s_waitcnt vmcnt(0)" ::: "memory"); __syncthreads();
  { bf16x8 kfA[2], kfB[2]; KREAD(kfA, kb0, 0, 0); QKALL16(kb0, kfA, kfB); }
  if (role) BAR16();
  int i0 = 0, i1 = 1, i2 = 2;
  for (int t = 0; t < NT; ++t) {
    if (t + 2 < NT) STAGEK(t + 2, i2);
    if (t + 1 < NT) STAGEV(t + 1, i1);
    const ATT_LAS char* Vc = vb0 + i0 * V16B; const ATT_LAS char* Kc = kb0 + i1 * K16B;
    bf16x8 vfA[2], vfB[2];
    bf16x8 pa[NQB][2];
#pragma unroll
    for (int qb = 0; qb < NQB; ++qb) {
#pragma unroll
      for (int kb = 0; kb < 4; ++kb)
#pragma unroll
        for (int r = 0; r < 4; ++r) S[kb][qb][r] = __builtin_amdgcn_exp2f(S[kb][qb][r]);
#pragma unroll
      for (int s = 0; s < 2; ++s) { const u32x4 w = {cvtpk(S[2 * s][qb][0], S[2 * s][qb][1]), cvtpk(S[2 * s][qb][2], S[2 * s][qb][3]),
                                                     cvtpk(S[2 * s + 1][qb][0], S[2 * s + 1][qb][1]), cvtpk(S[2 * s + 1][qb][2], S[2 * s + 1][qb][3])};
        pa[qb][s] = __builtin_bit_cast(bf16x8, w); }
      SBAR();
      if (qb == NQB / 2 - 1) { VREAD(vfA, Vc, 0, 0); SBAR(); } }
    BAR16V();
    { bf16x8 fC[2];
#define ONES16() do { _Pragma("unroll") for (int s_ = 0; s_ < 2; ++s_) _Pragma("unroll") for (int qb_ = 0; qb_ < NQB; ++qb_) lacc[qb_] = __builtin_amdgcn_mfma_f32_16x16x32_bf16(pa[qb_][s_], ones8, lacc[qb_], 0, 0, 0); } while (0)
      const bool nx = (t + 1 < NT);
      VREAD(vfB, Vc, 0, 1); VREAD(fC, Vc, 1, 0); SBAR();
      PVMMA(vfA, 0, 0); SBAR(); VREAD(vfA, Vc, 1, 1); SBAR();
      PVMMA(vfB, 0, 1); SBAR(); if (nx) KREAD(vfB, Kc, 0, 0); SBAR();
      PVMMA(fC, 1, 0); SBAR(); if (nx) KREAD(fC, Kc, 1, 0); SBAR();
      PVMMA(vfA, 1, 1); SBAR(); if (nx) KREAD(vfA, Kc, 2, 0); SBAR();
      ONES16(); SBAR();
      if (nx) {
        QKMMA(vfB, 0, 0); SBAR(); KREAD(vfB, Kc, 0, 1); SBAR();
        QKMMA(fC, 1, 0); SBAR(); KREAD(fC, Kc, 1, 1); SBAR();
        QKMMA(vfA, 2, 0); SBAR(); KREAD(vfA, Kc, 2, 1); SBAR();
        QKMMA(vfB, 0, 1); SBAR(); QKMMA(fC, 1, 1); SBAR(); QKMMA(vfA, 2, 1); }
#undef ONES16
    }
    BAR16();
    { const int t_ = i0; i0 = i1; i1 = i2; i2 = t_; }
  }
  if (!role) BAR16();
#undef STAGEK
#undef STAGEV
#undef DMA16
#undef KREAD
#undef VREAD
#undef QKMMA
#undef PVMMA
#undef QKALL16
  ATT_GAS bf16* Ow = io.o + (size_t)(wid * WQ) * io.ldo;
  { ATT_LAS char* stg = lds + OFF16_OST + wid * 4608;
#pragma unroll
    for (int hp = 0; hp < NQB / 2; ++hp) {
#pragma unroll
      for (int q2 = 0; q2 < 2; ++q2)
#pragma unroll
        for (int r = 0; r < 4; ++r) { const int qb = 2 * hp + q2, orow = 16 * q2 + 4 * g + r; const float rl = __builtin_amdgcn_rcpf(lacc[qb][r]);
#pragma unroll
          for (int db = 0; db < 4; ++db) { const float val = o[qb][db][r] * rl; *(ATT_LAS bf16*)(stg + orow * 144 + (db * 16 + c) * 2) = (bf16)(cvtpk(val, val) & 0xffffu); } }
      asm volatile("s_waitcnt lgkmcnt(0)" ::: "memory");
#pragma unroll
      for (int i = 0; i < 4; ++i) { const int row = i * 8 + (lane >> 3), ch = lane & 7; const u32x4 v = *(const ATT_LAS u32x4*)(stg + row * 144 + ch * 16); *(ATT_GAS u32x4*)(Ow + (size_t)(32 * hp + row) * io.ldo + ch * 8) = v; }
      asm volatile("s_waitcnt lgkmcnt(0)" ::: "memory"); } }
#undef BAR16
#undef BAR16V
  __syncthreads();
}
constexpr int SWW_LDS = 10240 + 256;
__device__ __forceinline__ void swa_wave_task(const ATT_GAS bf16* qp, const ATT_GAS bf16* kp, const ATT_GAS bf16* vp, ATT_GAS bf16* op, const int q0, const float sinkl2, ATT_LAS char* wl) {
  typedef float f32x4 __attribute__((ext_vector_type(4)));
  int tid_ = threadIdx.x; asm volatile("" : "+v"(tid_));
  const int lane = tid_ & 63, c = lane & 15, g = lane >> 4;
  ATT_LAS float* al = (ATT_LAS float*)(wl + 10240);
  bf16x8 qf[2][2];
#pragma unroll
  for (int qb = 0; qb < 2; ++qb)
#pragma unroll
    for (int ks = 0; ks < 2; ++ks) qf[qb][ks] = *(const ATT_GAS bf16x8*)(qp + (size_t)(q0 + 16 * qb + c) * 256 + 32 * ks + 8 * g);
  f32x4 o[2][4], lacc[2], negm[2]; float m[2];
#pragma unroll
  for (int qb = 0; qb < 2; ++qb) { m[qb] = sinkl2; negm[qb] = (f32x4){-sinkl2, -sinkl2, -sinkl2, -sinkl2}; lacc[qb] = (f32x4){1.f, 1.f, 1.f, 1.f};
#pragma unroll
    for (int db = 0; db < 4; ++db) o[qb][db] = (f32x4){0.f, 0.f, 0.f, 0.f}; }
  bf16x8 ones8; { const u32x4 w1 = {0x3F803F80u, 0x3F803F80u, 0x3F803F80u, 0x3F803F80u}; ones8 = __builtin_bit_cast(bf16x8, w1); }
  const int jt = q0 >> 6, tlo = (jt - 2 < 0) ? 0 : jt - 2, thi = (jt + 2 > 63) ? 63 : jt + 2;
  const ATT_GAS bf16* kl = kp + (size_t)c * 128 + 8 * g;
  const ATT_GAS bf16* vl = vp + (size_t)(lane >> 3) * 128 + (lane & 7) * 8;
  ATT_LAS char* vw = wl + (lane >> 3) * V16ST + (lane & 7) * 16;
  const ATT_LAS char* vb0 = wl + (4 * g + ((lane >> 2) & 3)) * V16ST + (lane & 3) * 8;
  bf16x8 kf[4][2], vs[8];
#define SW_KLOAD(t) do { _Pragma("unroll") for (int kb_ = 0; kb_ < 4; ++kb_) _Pragma("unroll") for (int ks_ = 0; ks_ < 2; ++ks_) \
    kf[kb_][ks_] = *(const ATT_GAS bf16x8*)(kl + (size_t)(64 * (t) + 16 * kb_) * 128 + 32 * ks_); } while (0)
#define SW_VLOAD(t) do { _Pragma("unroll") for (int i_ = 0; i_ < 8; ++i_) vs[i_] = *(const ATT_GAS bf16x8*)(vl + (size_t)(64 * (t) + 8 * i_) * 128); } while (0)
  SW_KLOAD(tlo); SW_VLOAD(tlo);
  for (int t = tlo; t <= thi; ++t) {
    f32x4 S[4][2];
#pragma unroll
    for (int kb = 0; kb < 4; ++kb)
#pragma unroll
      for (int qb = 0; qb < 2; ++qb) { S[kb][qb] = __builtin_amdgcn_mfma_f32_16x16x32_bf16(kf[kb][0], qf[qb][0], negm[qb], 0, 0, 0);
        S[kb][qb] = __builtin_amdgcn_mfma_f32_16x16x32_bf16(kf[kb][1], qf[qb][1], S[kb][qb], 0, 0, 0); }
    if (t < thi) SW_KLOAD(t + 1);
    if (t == jt - 2 || t == jt + 2) {
      const int d0 = 64 * t + 4 * g - q0 - c;
#pragma unroll
      for (int kb = 0; kb < 4; ++kb)
#pragma unroll
        for (int qb = 0; qb < 2; ++qb)
#pragma unroll
          for (int r = 0; r < 4; ++r) { const int d = d0 + 16 * kb + r - 16 * qb; S[kb][qb][r] = (d >= -128 && d <= 128) ? S[kb][qb][r] : -1e30f; } }
    float pm[2];
#pragma unroll
    for (int qb = 0; qb < 2; ++qb) { float a = fmaxf(fmaxf(S[0][qb][0], S[0][qb][1]), S[0][qb][2]);
#pragma unroll
      for (int kb = 0; kb < 4; ++kb) { if (kb) a = fmaxf(fmaxf(a, S[kb][qb][0]), S[kb][qb][1]); a = fmaxf(fmaxf(a, S[kb][qb][kb ? 2 : 3]), S[kb][qb][3]); }
      pm[qb] = a; }
    if (__builtin_expect(__any(fmaxf(pm[0], pm[1]) > THR), 0)) {
#pragma unroll
      for (int qb = 0; qb < 2; ++qb) { float pmx = fmaxf(pm[qb], __shfl_xor(pm[qb], 16)); pmx = fmaxf(pmx, __shfl_xor(pmx, 32));
        const float dl = fmaxf(pmx, 0.f); m[qb] += dl; negm[qb] -= dl;
#pragma unroll
        for (int kb = 0; kb < 4; ++kb) S[kb][qb] -= dl;
        if (g == 0) al[16 * qb + c] = __builtin_amdgcn_exp2f(-dl); }
      asm volatile("s_waitcnt lgkmcnt(0)" ::: "memory");
#pragma unroll
      for (int qb = 0; qb < 2; ++qb)
#pragma unroll
        for (int r = 0; r < 4; ++r) { const float a = al[16 * qb + 4 * g + r]; lacc[qb][r] *= a;
#pragma unroll
          for (int db = 0; db < 4; ++db) o[qb][db][r] *= a; } }
    bf16x8 pa[2][2];
#pragma unroll
    for (int qb = 0; qb < 2; ++qb) {
#pragma unroll
      for (int kb = 0; kb < 4; ++kb)
#pragma unroll
        for (int r = 0; r < 4; ++r) S[kb][qb][r] = __builtin_amdgcn_exp2f(S[kb][qb][r]);
#pragma unroll
      for (int s2 = 0; s2 < 2; ++s2) { const u32x4 w = {cvtpk(S[2 * s2][qb][0], S[2 * s2][qb][1]), cvtpk(S[2 * s2][qb][2], S[2 * s2][qb][3]),
                                                       cvtpk(S[2 * s2 + 1][qb][0], S[2 * s2 + 1][qb][1]), cvtpk(S[2 * s2 + 1][qb][2], S[2 * s2 + 1][qb][3])};
        pa[qb][s2] = __builtin_bit_cast(bf16x8, w); } }
#pragma unroll
    for (int i = 0; i < 8; ++i) *(ATT_LAS bf16x8*)(vw + 8 * i * V16ST) = vs[i];
    if (t < thi) SW_VLOAD(t + 1);
#pragma unroll
    for (int s2 = 0; s2 < 2; ++s2) { bf16x8 vf[4];
#pragma unroll
      for (int db = 0; db < 4; ++db) { const s16x4 lo = vtr(vb0 + s2 * 32 * V16ST + db * 32), hi = vtr(vb0 + (s2 * 32 + 16) * V16ST + db * 32);
        vf[db] = (bf16x8){lo[0], lo[1], lo[2], lo[3], hi[0], hi[1], hi[2], hi[3]}; }
#pragma unroll
      for (int db = 0; db < 4; ++db)
#pragma unroll
        for (int qb = 0; qb < 2; ++qb) o[qb][db] = __builtin_amdgcn_mfma_f32_16x16x32_bf16(pa[qb][s2], vf[db], o[qb][db], 0, 0, 0);
#pragma unroll
      for (int qb = 0; qb < 2; ++qb) lacc[qb] = __builtin_amdgcn_mfma_f32_16x16x32_bf16(pa[qb][s2], ones8, lacc[qb], 0, 0, 0); }
  }
#undef SW_KLOAD
#undef SW_VLOAD
#pragma unroll
  for (int qb = 0; qb < 2; ++qb)
#pragma unroll
    for (int r = 0; r < 4; ++r) { const int orow = 16 * qb + 4 * g + r; const float rl = __builtin_amdgcn_rcpf(lacc[qb][r]);
#pragma unroll
      for (int db = 0; db < 4; ++db) { const float val = o[qb][db][r] * rl; *(ATT_LAS bf16*)(wl + orow * 144 + (db * 16 + c) * 2) = (bf16)(cvtpk(val, val) & 0xffffu); } }
  asm volatile("s_waitcnt lgkmcnt(0)" ::: "memory");
#pragma unroll
  for (int i = 0; i < 4; ++i) { const int row = i * 8 + (lane >> 3), ch = lane & 7; const u32x4 v = *(const ATT_LAS u32x4*)(wl + row * 144 + ch * 16); *(ATT_GAS u32x4*)(op + (size_t)(q0 + row) * 1024 + ch * 8) = v; }
  asm volatile("s_waitcnt lgkmcnt(0)" ::: "memory");
}
constexpr int SW_NB = 5, SWK_B = 8192, SWV_B = 10240, SW_OFFV = SW_NB * SWK_B, SW_OFFAL = SW_OFFV + SW_NB * SWV_B, SW_OFFO = 0;
static_assert(SW_OFFAL + NW * 256 <= 131072 && NW * 9216 <= SW_OFFAL, "SWA LDS map");
__device__ __forceinline__ void swa_unit(const ATT_GAS bf16* qp, const ATT_GAS bf16* kp, const ATT_GAS bf16* vp, ATT_GAS bf16* op, const int u0, const float sinkl2, ATT_LAS char* lds) {
  typedef float f32x4 __attribute__((ext_vector_type(4)));
  int tid_ = threadIdx.x; asm volatile("" : "+v"(tid_));
  const int tid = tid_, wid = __builtin_amdgcn_readfirstlane(tid >> 6), lane = tid & 63, c = lane & 15, g = lane >> 4;
  ATT_LAS char* K_lds = lds; ATT_LAS char* V_lds = lds + SW_OFFV;
  ATT_LAS float* al = (ATT_LAS float*)(lds + SW_OFFAL) + wid * 64;
  const int q0 = 64 * (u0 + wid);
  bf16x8 qf[4][2];
#pragma unroll
  for (int qb = 0; qb < 4; ++qb)
#pragma unroll
    for (int ks = 0; ks < 2; ++ks) qf[qb][ks] = *(const ATT_GAS bf16x8*)(qp + (size_t)(q0 + 16 * qb + c) * 256 + 32 * ks + 8 * g);
  f32x4 o[4][4], lacc[4], negm[4];
#pragma unroll
  for (int qb = 0; qb < 4; ++qb) { negm[qb] = (f32x4){-sinkl2, -sinkl2, -sinkl2, -sinkl2}; lacc[qb] = (f32x4){1.f, 1.f, 1.f, 1.f};
#pragma unroll
    for (int db = 0; db < 4; ++db) o[qb][db] = (f32x4){0.f, 0.f, 0.f, 0.f}; }
  bf16x8 ones8; { const u32x4 w1 = {0x3F803F80u, 0x3F803F80u, 0x3F803F80u, 0x3F803F80u}; ones8 = __builtin_bit_cast(bf16x8, w1); asm volatile("" : "+v"(ones8)); }
  const int gch = (lane & 3) ^ ((4 - g) & 3);
  const unsigned koff = (unsigned)((16 * (wid & 3) + (lane >> 2)) * 128 + 32 * (wid >> 2) + 8 * gch) * 2u;
  const int vsA = 64 * wid + lane, vsB = 64 * (8 + (wid & 1)) + lane;
  const unsigned voffA = (unsigned)((vsA / 10) * 128 + 8 * ((vsA % 10) > 7 ? 7 : (vsA % 10))) * 2u, voffB = (unsigned)((vsB / 10) * 128 + 8 * ((vsB % 10) > 7 ? 7 : (vsB % 10))) * 2u;
#define SW_DMA(src, dst) do { const ATT_GAS char* s_ = (const ATT_GAS char*)(src); const unsigned d_ = (unsigned)__builtin_amdgcn_readfirstlane((int)(unsigned)(size_t)(dst)); \
    asm volatile("s_mov_b32 m0, %1\n\ts_nop 0\n\tglobal_load_lds_dwordx4 %0, off" :: "v"(s_), "s"(d_) : "memory", "m0"); } while (0)
#define SW_STAGE(T, b) do { SW_DMA((const ATT_GAS char*)(kp + (size_t)(64 * (T)) * 128) + koff, K_lds + (b) * SWK_B + wid * 1024); \
    SW_DMA((const ATT_GAS char*)(vp + (size_t)(64 * (T)) * 128) + voffA, V_lds + (b) * SWV_B + wid * 1024); \
    if (wid < 2) SW_DMA((const ATT_GAS char*)(vp + (size_t)(64 * (T)) * 128) + voffB, V_lds + (b) * SWV_B + (8 + wid) * 1024); } while (0)
  const ATT_LAS char* kb0 = K_lds + c * 64 + ((g ^ fkey(c)) * 16);
  const ATT_LAS char* vb0 = V_lds + (4 * g + ((lane >> 2) & 3)) * V16ST + (lane & 3) * 8;
  const int Tlo = (u0 - 2 < 0) ? 0 : u0 - 2, Thi = (u0 + 9 > 63) ? 63 : u0 + 9;
  SW_STAGE(Tlo, 0); if (Tlo + 1 <= Thi) SW_STAGE(Tlo + 1, 1);
  asm volatile("s_waitcnt vmcnt(0)" ::: "memory");
  if (Tlo + 2 <= Thi) SW_STAGE(Tlo + 2, 2); if (Tlo + 3 <= Thi) SW_STAGE(Tlo + 3, 3);
  __syncthreads();
  int b0 = 0, b4 = 4;
  for (int T = Tlo; T <= Thi; ++T) {
    if (T + 4 <= Thi) SW_STAGE(T + 4, b4);
    const int dT = T - (u0 + wid);
    if (dT >= -2 && dT <= 2) {
      const ATT_LAS char* Kc = kb0 + b0 * SWK_B; const ATT_LAS char* Vc = vb0 + b0 * SWV_B;
      f32x4 S[4][4];
      { bf16x8 kf[4][2];
#pragma unroll
        for (int ks = 0; ks < 2; ++ks)
#pragma unroll
          for (int kb = 0; kb < 4; ++kb) kf[kb][ks] = *(const ATT_LAS bf16x8*)(Kc + ks * 4096 + kb * 1024);
#pragma unroll
        for (int ks = 0; ks < 2; ++ks)
#pragma unroll
          for (int kb = 0; kb < 4; ++kb)
#pragma unroll
            for (int qb = 0; qb < 4; ++qb) S[kb][qb] = __builtin_amdgcn_mfma_f32_16x16x32_bf16(kf[kb][ks], qf[qb][ks], ks == 0 ? negm[qb] : S[kb][qb], 0, 0, 0); }
      if (dT == -2 || dT == 2) {
        const int d0 = 64 * T + 4 * g - q0 - c;
#pragma unroll
        for (int kb = 0; kb < 4; ++kb)
#pragma unroll
          for (int qb = 0; qb < 4; ++qb)
#pragma unroll
            for (int r = 0; r < 4; ++r) { const int d = d0 + 16 * kb + r - 16 * qb; S[kb][qb][r] = (d >= -128 && d <= 128) ? S[kb][qb][r] : -1e30f; } }
      float pm[4];
#pragma unroll
      for (int qb = 0; qb < 4; ++qb) { float a = fmaxf(fmaxf(S[0][qb][0], S[0][qb][1]), S[0][qb][2]);
#pragma unroll
        for (int kb = 0; kb < 4; ++kb) { if (kb) a = fmaxf(fmaxf(a, S[kb][qb][0]), S[kb][qb][1]); a = fmaxf(fmaxf(a, S[kb][qb][kb ? 2 : 3]), S[kb][qb][3]); }
        pm[qb] = a; }
      if (__builtin_expect(__any(fmaxf(fmaxf(pm[0], pm[1]), fmaxf(pm[2], pm[3])) > THR), 0)) {
#pragma unroll
        for (int qb = 0; qb < 4; ++qb) { float pmx = fmaxf(pm[qb], __shfl_xor(pm[qb], 16)); pmx = fmaxf(pmx, __shfl_xor(pmx, 32));
          const float dl = fmaxf(pmx, 0.f); negm[qb] -= dl;
#pragma unroll
          for (int kb = 0; kb < 4; ++kb) S[kb][qb] -= dl;
          if (g == 0) al[16 * qb + c] = __builtin_amdgcn_exp2f(-dl); }
        asm volatile("s_waitcnt lgkmcnt(0)" ::: "memory");
#pragma unroll
        for (int qb = 0; qb < 4; ++qb)
#pragma unroll
          for (int r = 0; r < 4; ++r) { const float a = al[16 * qb + 4 * g + r]; lacc[qb][r] *= a;
#pragma unroll
            for (int db = 0; db < 4; ++db) o[qb][db][r] *= a; } }
      bf16x8 pa[4][2];
#pragma unroll
      for (int qb = 0; qb < 4; ++qb) {
#pragma unroll
        for (int kb = 0; kb < 4; ++kb)
#pragma unroll
          for (int r = 0; r < 4; ++r) S[kb][qb][r] = __builtin_amdgcn_exp2f(S[kb][qb][r]);
#pragma unroll
        for (int s2 = 0; s2 < 2; ++s2) { const u32x4 w = {cvtpk(S[2 * s2][qb][0], S[2 * s2][qb][1]), cvtpk(S[2 * s2][qb][2], S[2 * s2][qb][3]),
                                                         cvtpk(S[2 * s2 + 1][qb][0], S[2 * s2 + 1][qb][1]), cvtpk(S[2 * s2 + 1][qb][2], S[2 * s2 + 1][qb][3])};
          pa[qb][s2] = __builtin_bit_cast(bf16x8, w); }
        SBAR(); }
#pragma unroll
      for (int s2 = 0; s2 < 2; ++s2) { bf16x8 vf[4];
#pragma unroll
        for (int db = 0; db < 4; ++db) { const s16x4 lo = vtr(Vc + s2 * 32 * V16ST + db * 32), hi = vtr(Vc + (s2 * 32 + 16) * V16ST + db * 32);
          vf[db] = (bf16x8){lo[0], lo[1], lo[2], lo[3], hi[0], hi[1], hi[2], hi[3]}; }
#pragma unroll
        for (int db = 0; db < 4; ++db)
#pragma unroll
          for (int qb = 0; qb < 4; ++qb) o[qb][db] = __builtin_amdgcn_mfma_f32_16x16x32_bf16(pa[qb][s2], vf[db], o[qb][db], 0, 0, 0);
#pragma unroll
        for (int qb = 0; qb < 4; ++qb) lacc[qb] = __builtin_amdgcn_mfma_f32_16x16x32_bf16(pa[qb][s2], ones8, lacc[qb], 0, 0, 0); }
    }
    if (T + 4 <= Thi) { if (wid < 2) asm volatile("s_waitcnt vmcnt(9) lgkmcnt(0)" ::: "memory"); else asm volatile("s_waitcnt vmcnt(6) lgkmcnt(0)" ::: "memory"); }
    else asm volatile("s_waitcnt vmcnt(0) lgkmcnt(0)" ::: "memory");
    __builtin_amdgcn_s_barrier(); asm volatile("" ::: "memory");
    { const int t_ = b0; b0 = (b0 == SW_NB - 1) ? 0 : b0 + 1; b4 = t_; }
  }
#undef SW_DMA
#undef SW_STAGE
  { ATT_LAS char* stg = lds + SW_OFFO + wid * 9216;
#pragma unroll
    for (int qb = 0; qb < 4; ++qb)
#pragma unroll
      for (int r = 0; r < 4; ++r) { const int orow = 16 * qb + 4 * g + r; const float rl = __builtin_amdgcn_rcpf(lacc[qb][r]);
#pragma unroll
        for (int db = 0; db < 4; ++db) { const float val = o[qb][db][r] * rl; *(ATT_LAS bf16*)(stg + orow * 144 + (db * 16 + c) * 2) = (bf16)(cvtpk(val, val) & 0xffffu); } }
    asm volatile("s_waitcnt lgkmcnt(0)" ::: "memory");
#pragma unroll
    for (int i = 0; i < 8; ++i) { const int row = i * 8 + (lane >> 3), ch = lane & 7; const u32x4 v = *(const ATT_LAS u32x4*)(stg + row * 144 + ch * 16); *(ATT_GAS u32x4*)(op + (size_t)(q0 + row) * 1024 + ch * 8) = v; } }
  __syncthreads();
}
template <int NH>
__device__ __forceinline__ bool mla_block_fixed(AttnIO io, float km2, ATT_LAS char* lds, int& role) {
  float mrow; bool okw = mla_fixed_ref(io, km2, mrow);
  if constexpr (NH == 2) { io.q += (size_t)256 * io.ldq; okw = mla_fixed_ref(io, km2, mrow) && okw; }
  int tid_ = threadIdx.x; asm volatile("" : "+v"(tid_));
  const int wid = __builtin_amdgcn_readfirstlane(tid_ >> 6);
  const int simd = (int)__builtin_amdgcn_s_getreg((1 << 11) | (4 << 6) | 4);
  ATT_LAS int* fl = (ATT_LAS int*)(lds + OFF_FLAG);
  if ((tid_ & 63) == 0) fl[wid] = (okw ? 1 : 0) | (simd << 1);
  __syncthreads();
  int all = 1, rank = 0;
#pragma unroll
  for (int w = 0; w < 8; ++w) { const int f = __builtin_amdgcn_readfirstlane(fl[w]); all &= f; rank += (w < wid && (f >> 1) == simd) ? 1 : 0; }
  role = rank & 1;
  return (all & 1) != 0;
}
#undef SBAR
}
#ifndef PHMASK
#define PHMASK 0xffffffffu
#endif
#define PH(k) if (PHMASK & (1u << (k)))
#ifndef DUPMASK
#define DUPMASK 0u
#endif
#define DUP(k) for (int rep_ = 0; rep_ < (int)((DUPMASK >> (k)) & 1u) + 1; ++rep_)
constexpr int NWAVES = 8;
constexpr int DM = 1024, BATCH = 8, SEQ = 4096, TOK = BATCH * SEQ, DEPTH = 2;
constexpr int IN_W = 1952, IN_WP = 2048, NEXP = 16, EFF = 512, CAP = 512, PLE = 256;
constexpr int NSLOT = BATCH * NEXP * CAP;
constexpr float NORM_EPS = 1e-6f, LOG2E = 1.4426950408889634f;
constexpr float C2_NA = 0.125f * LOG2E, C2_SW = 0.125f * LOG2E, C2_MLA = 0.10206207261596575f * LOG2E;

constexpr size_t MiB = 1u << 20;
constexpr size_t WS_CTL = 0, CTL_ZERO_BYTES = 64 * 1024;
constexpr size_t WS_MISC = 1 * MiB;
constexpr size_t MO_COS16 = 0, MO_SIN16 = 256 * 1024, MO_COS32 = 512 * 1024, MO_SIN32 = 1024 * 1024;
constexpr size_t MO_PSSQ = 1536 * 1024;
constexpr size_t MO_GSSQ = MO_PSSQ + 2 * MiB;
constexpr size_t MO_RSF = MO_GSSQ + 2560 * 1024;
constexpr size_t MO_RSP = MO_RSF + 128 * 1024;
constexpr size_t MO_AFF = MO_RSP + 128 * 1024;
constexpr size_t MO_SIDX = MO_AFF + 2 * MiB;
constexpr size_t MO_SG = MO_SIDX + 256 * 1024;
constexpr size_t MO_SRS = MO_SG + 256 * 1024;
constexpr size_t MO_INV = MO_SRS + 256 * 1024;
constexpr size_t MO_RSA = MO_INV + 2 * MiB, MO_RSCQ = MO_RSA + 128 * 1024, MO_RSCKV = MO_RSCQ + 128 * 1024;
constexpr size_t MO_WR = MO_RSCKV + 128 * 1024;
static_assert(MO_WR + 128 * 1024 <= 16 * MiB, "misc map");
constexpr size_t WS_WPG = 17 * MiB;
constexpr size_t WS_W = 21 * MiB;
constexpr size_t WO_IN = 0, WO_QUP = 4 * MiB, WO_KVUP = 5 * MiB, WO_OUT = 6 * MiB, WO_PP = 8 * MiB, WO_GU = 9 * MiB, WO_DOWN = 41 * MiB;
constexpr size_t WS_HB = 79 * MiB, WS_PB = 143 * MiB, WS_OCAT = 159 * MiB, WS_PPO = WS_OCAT, WS_BIG = 223 * MiB, WS_END = 457 * MiB;
constexpr size_t BO_NAQKV = 0, BO_CQ = 48 * MiB, BO_CKV = 72 * MiB, BO_KR = 88 * MiB, BO_SWQ = 90 * MiB, BO_SWK = 106 * MiB, BO_SWV = 114 * MiB,
                 BO_QM = 122 * MiB, BO_KN = 170 * MiB, BO_VM = 202 * MiB, BO_ACT = 0, BO_Y = 64 * MiB;
constexpr size_t SLAB_B = 234 * MiB / 8;
#define BOX(BO, SZ_MIB) (F.xl ? (size_t)F.xb * (SLAB_B - (size_t)(SZ_MIB) * MiB / 8) + (size_t)(BO) / 8 : (size_t)(BO))
constexpr int CW_BAR = 4096;
static_assert((CW_BAR + 3456) * 4 <= 32768, "barrier words");
constexpr int CW_XL = 12544;
constexpr int CW_KMAX = 8192, CW_KRMAX = CW_KMAX + 128;

constexpr int RING_OFF = 0, RING_BYTES = 131072;
constexpr int LDSCTL_OFF = RING_BYTES, MISC_OFF = LDSCTL_OFF + 320, GTAB_OFF = RING_BYTES + 1024;
constexpr int LDS_BYTES = 147456;
static_assert(GTAB_OFF + 8192 <= LDS_BYTES && MISC_OFF + 128 <= GTAB_OFF, "LDS map");

#define GAS __attribute__((address_space(1)))
#define LAS __attribute__((address_space(3)))
typedef unsigned short bf16;
typedef unsigned v4u __attribute__((ext_vector_type(4)));
typedef unsigned v2u __attribute__((ext_vector_type(2)));
typedef int v4i __attribute__((ext_vector_type(4)));
typedef float f32x4 __attribute__((ext_vector_type(4)));
typedef float f32x2 __attribute__((ext_vector_type(2)));
typedef __bf16 bf16x2_t __attribute__((ext_vector_type(2)));
#define LDS_WAIT() asm volatile("s_waitcnt lgkmcnt(0)" ::: "memory")
#define VM_WAIT() asm volatile("s_waitcnt vmcnt(0)" ::: "memory")
__device__ __forceinline__ unsigned pk2(float lo, float hi) { f32x2 v = {lo, hi}; bf16x2_t b = __builtin_convertvector(v, bf16x2_t); return __builtin_bit_cast(unsigned, b); }
__device__ __forceinline__ v2u pk4(f32x4 v) { v2u r; r.x = pk2(v[0], v[1]); r.y = pk2(v[2], v[3]); return r; }
__device__ __forceinline__ float bf2f(unsigned short b) { return __uint_as_float((unsigned)b << 16); }
__device__ __forceinline__ float wave_sum(float v) {
#pragma unroll
    for (int o = 1; o < 64; o <<= 1) v += __shfl_xor(v, o);
    return v;
}

#define XB_TMO      128
#define XB_XCNT(j)  (256  + 64 * (j))
#define XB_XSUB(j)  (1280 + 64 * (j))
#define XB_XGEN(j)  (2304 + 64 * (j))
#define XB_TOP      3328
#define XB_TOPGEN   3392
#define XCD_BAR_WORDS 3456
#define XB_SPIN_CAP (1u << 22)
__device__ __forceinline__ unsigned xb_ld(unsigned* p)              { return __hip_atomic_load(p, __ATOMIC_RELAXED, __HIP_MEMORY_SCOPE_AGENT); }
__device__ __forceinline__ unsigned xb_add(unsigned* p, unsigned v) { return __hip_atomic_fetch_add(p, v, __ATOMIC_RELAXED, __HIP_MEMORY_SCOPE_AGENT); }
__device__ __forceinline__ unsigned xb_xcc_id() { return (unsigned)__builtin_amdgcn_s_getreg((3 << 11) | 20) & 0xFu; }
#define XB_SPIN(cond, bar) do { unsigned _sp = 0; while (cond) { __builtin_amdgcn_s_sleep(1); \
    if ((++_sp & 255u) == 0u) { if (xb_ld(&(bar)[XB_TMO])) break; if (_sp > XB_SPIN_CAP) { atomicAdd(&(bar)[XB_TMO], 1u); break; } } } } while (0)
struct XcdBarrier { unsigned* bar; unsigned x; volatile LAS unsigned* st; };
__device__ __forceinline__ XcdBarrier xcd_barrier_post(unsigned* bar, volatile LAS unsigned* st) {
    XcdBarrier b; b.bar = bar; b.x = xb_xcc_id(); b.st = st;
    if (threadIdx.x == 0) st[2] = xb_add(&bar[XB_XCNT(b.x)], 1u);
    return b;
}
__device__ __forceinline__ void xcd_barrier_complete(unsigned* bar, unsigned x, unsigned& nloc, unsigned& nx) {
    const unsigned G = gridDim.x * gridDim.y * gridDim.z;
    unsigned sum, cnt, mine, sp = 0u;
    for (;;) {
        sum = 0u; cnt = 0u; mine = 0u;
#pragma unroll
        for (unsigned j = 0; j < 16; ++j) { const unsigned c = xb_ld(&bar[XB_XCNT(j)]); sum += c; cnt += (c > 0u) ? 1u : 0u; mine = (j == x) ? c : mine; }
        if (sum == G) break;
        __builtin_amdgcn_s_sleep(1);
        if ((++sp & 255u) == 0u) { if (xb_ld(&bar[XB_TMO])) break; if (sp > XB_SPIN_CAP) { atomicAdd(&bar[XB_TMO], 1u); break; } }
    }
    nloc = mine > 0u ? mine : 1u; nx = cnt > 0u ? cnt : 1u;
}
__device__ __forceinline__ void xcd_local_barrier(unsigned* cnt, unsigned n, unsigned* bar) {
    asm volatile("s_waitcnt vmcnt(0)" ::: "memory");
    __syncthreads();
    if (threadIdx.x == 0) {
        const unsigned old = xb_add(cnt, 1u); const unsigned target = (old / n + 1u) * n;
        XB_SPIN(xb_ld(cnt) < target, bar);
        asm volatile("buffer_inv sc0\n\ts_waitcnt vmcnt(0)" ::: "memory");
    }
    __syncthreads();
}
__device__ __forceinline__ void xcd_barrier(const XcdBarrier& b, const bool flush = true) {
    asm volatile("s_waitcnt vmcnt(0)" ::: "memory");
    __syncthreads();
    if (threadIdx.x == 0) {
        unsigned* bar = b.bar;
        __builtin_amdgcn_s_waitcnt(0);
        unsigned nloc = b.st[0], nx = b.st[1];
        if (nloc == 0u) { xcd_barrier_complete(bar, b.x, nloc, nx); b.st[0] = nloc; b.st[1] = nx; }
        const unsigned old = xb_add(&bar[XB_XSUB(b.x)], 1u);
        const unsigned gen = old / nloc;
        if (old + 1u == (gen + 1u) * nloc) {
            if (flush) __builtin_amdgcn_fence(__ATOMIC_RELEASE, "agent");
            asm volatile("s_waitcnt vmcnt(0)" ::: "memory");
            const unsigned og = xb_add(&bar[XB_TOP], 1u);
            const unsigned tg = og / nx;
            if (og + 1u == (tg + 1u) * nx) xb_add(&bar[XB_TOPGEN], 1u);
            else XB_SPIN(xb_ld(&bar[XB_TOPGEN]) == tg, bar);
            if (flush) __builtin_amdgcn_fence(__ATOMIC_ACQUIRE, "agent"); else asm volatile("buffer_inv sc0" ::: "memory");
            xb_add(&bar[XB_XGEN(b.x)], 1u);
            asm volatile("s_waitcnt vmcnt(0)" ::: "memory");
        } else {
            XB_SPIN(xb_ld(&bar[XB_XGEN(b.x)]) == gen, bar);
            asm volatile("buffer_inv sc0\n\ts_waitcnt vmcnt(0)" ::: "memory");
        }
    }
    __syncthreads();
}

struct Args { const float* in[20]; float* out; unsigned char* ws; double inv16[16]; double inv32[32]; };
enum { I_X = 0, I_P, I_ATTN_NORM, I_W_IN, I_NA_RPB, I_MLA_Q_NORM, I_MLA_W_Q_UP, I_MLA_KV_NORM, I_MLA_W_KV_UP, I_SWA_SINK, I_W_OUT, I_FFN_NORM, I_W_ROUTER,
       I_W_GATE, I_W_UP, I_W_DOWN, I_PLE_NORM, I_W_PLE_GATE, I_W_PLE_PROJ, I_FINAL_NORM };

struct Frame {
    LAS unsigned char* lds;
    volatile LAS unsigned* MISC;
    int vcu, G;
    unsigned char* ws;
    float* out;
    bf16* hb;
    int xl, xb;
};
#define LAUNDER_LANES() int tid_ = threadIdx.x; asm volatile("" : "+v"(tid_)); const int tid = tid_, lane = tid & 63, wave = __builtin_amdgcn_readfirstlane(tid >> 6); (void)tid; (void)lane; (void)wave
#define WSP(T, off) ((T*)(F.ws + (off)))
#define MISCP(T, off) ((T*)(F.ws + WS_MISC + (off)))

template <class Src>
__device__ __forceinline__ void transpose_item(const Src& src, int K, bf16* WT, LAS float* scr, int item, int nblk, int lane) {
    const int kb = item / nblk, nb = item % nblk, k0 = 64 * kb, n0 = 32 * nb;
    float tv_[32];
#pragma unroll
    for (int i = 0; i < 32; ++i) tv_[i] = src(k0 + 2 * i + (lane >> 5), n0 + (lane & 31));
#pragma unroll
    for (int i = 0; i < 32; ++i) { const int kk = 2 * i + (lane >> 5); scr[kk * 33 + (lane & 31)] = tv_[i]; }
    LDS_WAIT(); asm volatile("" ::: "memory");
    const int c = lane & 7;
    f32x4 ga = {1.f, 1.f, 1.f, 1.f}, gb = {1.f, 1.f, 1.f, 1.f};
    { const float* gp_ = src.gp(); if (gp_) { ga = *(const GAS f32x4*)(gp_ + k0 + 8 * c); gb = *(const GAS f32x4*)(gp_ + k0 + 8 * c + 4); } }
#pragma unroll
    for (int j = 0; j < 4; ++j) { const int n = (lane >> 3) + 8 * j; const LAS float* s = scr + (8 * c) * 33 + n;
        v4u o; o.x = pk2(s[0 * 33] * ga[0], s[1 * 33] * ga[1]); o.y = pk2(s[2 * 33] * ga[2], s[3 * 33] * ga[3]); o.z = pk2(s[4 * 33] * gb[0], s[5 * 33] * gb[1]); o.w = pk2(s[6 * 33] * gb[2], s[7 * 33] * gb[3]);
        *(GAS v4u*)(WT + (size_t)(n0 + n) * K + k0 + 8 * c) = o; }
    LDS_WAIT(); asm volatile("" ::: "memory");
}
__device__ __forceinline__ int pair16(int p) { return 16 * ((p >> 2) & 1) + 4 * (p >> 3) + (p & 3); }
struct SrcPlain { const float* W; int N; const float* g;
    __device__ __forceinline__ float operator()(int k, int n) const { return __builtin_nontemporal_load((const GAS float*)(W + (size_t)k * N + n)); }
    __device__ __forceinline__ const float* gp() const { return g; } };
struct SrcIn { const float* W; const float* g;
    __device__ __forceinline__ float operator()(int k, int n) const {
        if (n >= IN_W) return 0.f;
        int c = n;
        if (n >= 1408 && n < 1440) c = 1408 + pair16(n - 1408);
        else if (n >= 1440 && n < 1824) { const int base = (n < 1696) ? 1440 : 1696; const int p = (n - base) & 63, hb = (n - base) & ~63, sub = p >> 5, q = p & 31;
            c = base + hb + 16 * sub + 32 * ((q >> 2) & 1) + 4 * (q >> 3) + (q & 3); }
        return __builtin_nontemporal_load((const GAS float*)(W + (size_t)k * IN_W + c)); }
    __device__ __forceinline__ const float* gp() const { return g; } };
struct SrcQup { const float* W; const float* g;
    __device__ __forceinline__ float operator()(int k, int n) const { const int h = n / 96, r = n % 96; const int c = (r < 64) ? n : h * 96 + 64 + pair16(r - 64); return W[(size_t)k * 768 + c]; }
    __device__ __forceinline__ const float* gp() const { return g; } };
struct SrcGU { const float* Wg; const float* Wu; const float* g;
    __device__ __forceinline__ float operator()(int k, int n) const { const int grp = n >> 5, p = n & 31; const ptrdiff_t d = ((p >> 2) & 1) ? (Wu - Wg) : (ptrdiff_t)0; return __builtin_nontemporal_load((const GAS float*)(Wg + d + (ptrdiff_t)k * EFF + 16 * grp + 4 * (p >> 3) + (p & 3))); }
    __device__ __forceinline__ const float* gp() const { return g; } };

__device__ __forceinline__ void convert_layer_weights(Frame& F, const Args& a, int l, bool with_pg_both, bf16* Wl) {
    LAUNDER_LANES();
    LAS float* scr = (LAS float*)(F.lds + RING_OFF + wave * 16384);
    const int gw = F.vcu * NWAVES + wave, NGW = F.G * NWAVES;
    constexpr int I_IN = 16 * 64, I_QUP = 6 * 24, I_KVUP = 4 * 32, I_OUT = 16 * 32, I_PPI = 4 * 32, I_GU1 = 16 * 32, I_DN1 = 8 * 32, I_PG = 16 * 32;
    constexpr int NITEMS = I_IN + I_QUP + I_KVUP + I_OUT + I_PPI + NEXP * I_GU1 + NEXP * I_DN1;
    const int total = NITEMS + (with_pg_both ? 2 * I_PG : 0);
    for (int it = gw; it < total; it += NGW) {
        int r = it;
        if (r < I_IN) { SrcIn s{a.in[I_W_IN] + (size_t)l * DM * IN_W, a.in[I_ATTN_NORM] + l * DM}; transpose_item(s, DM, (bf16*)((char*)Wl + WO_IN), scr, r, 64, lane); continue; } r -= I_IN;
        if (r < I_QUP) { SrcQup s{a.in[I_MLA_W_Q_UP] + (size_t)l * 384 * 768, a.in[I_MLA_Q_NORM] + l * 384}; transpose_item(s, 384, (bf16*)((char*)Wl + WO_QUP), scr, r, 24, lane); continue; } r -= I_QUP;
        if (r < I_KVUP) { SrcPlain s{a.in[I_MLA_W_KV_UP] + (size_t)l * 256 * 1024, 1024, a.in[I_MLA_KV_NORM] + l * 256}; transpose_item(s, 256, (bf16*)((char*)Wl + WO_KVUP), scr, r, 32, lane); continue; } r -= I_KVUP;
        if (r < I_OUT) { SrcPlain s{a.in[I_W_OUT] + (size_t)l * DM * DM, DM, nullptr}; transpose_item(s, DM, (bf16*)((char*)Wl + WO_OUT), scr, r, 32, lane); continue; } r -= I_OUT;
        if (r < I_PPI) { SrcPlain s{a.in[I_W_PLE_PROJ] + (size_t)l * PLE * DM, DM, nullptr}; transpose_item(s, PLE, (bf16*)((char*)Wl + WO_PP), scr, r, 32, lane); continue; } r -= I_PPI;
        if (r < NEXP * I_GU1) { const int e = r / I_GU1; const size_t eo = ((size_t)l * NEXP + e) * DM * EFF;
            SrcGU s{a.in[I_W_GATE] + eo, a.in[I_W_UP] + eo, a.in[I_FFN_NORM] + l * DM}; transpose_item(s, DM, (bf16*)((char*)Wl + WO_GU) + (size_t)e * DM * DM, scr, r % I_GU1, 32, lane); continue; } r -= NEXP * I_GU1;
        if (r < NEXP * I_DN1) { const int e = r / I_DN1; SrcPlain s{a.in[I_W_DOWN] + ((size_t)l * NEXP + e) * EFF * DM, DM, nullptr};
            transpose_item(s, EFF, (bf16*)((char*)Wl + WO_DOWN) + (size_t)e * DM * EFF, scr, r % I_DN1, 32, lane); continue; } r -= NEXP * I_DN1;
        { const int ll = r / I_PG; SrcPlain s{a.in[I_W_PLE_GATE] + (size_t)ll * DM * DM, DM, a.in[I_PLE_NORM] + ll * DM}; transpose_item(s, DM, WSP(bf16, WS_WPG) + (size_t)ll * DM * DM, scr, r % I_PG, 32, lane); }
    }
}
__device__ __forceinline__ void convert_p(Frame& F, const Args& a, int l, bf16* pb) {
    LAUNDER_LANES();
    const float* p = a.in[I_P] + (size_t)l * TOK * PLE;
    const size_t n8 = (size_t)TOK * PLE / 8, gt = (size_t)F.vcu * 512 + tid, NT = (size_t)F.G * 512;
    for (size_t i = gt; i < n8; i += NT) { const f32x4 x0 = __builtin_nontemporal_load((const GAS f32x4*)(p + i * 8)), x1 = __builtin_nontemporal_load((const GAS f32x4*)(p + i * 8 + 4));
        v4u o; o.x = pk2(x0[0], x0[1]); o.y = pk2(x0[2], x0[3]); o.z = pk2(x1[0], x1[1]); o.w = pk2(x1[2], x1[3]); *(GAS v4u*)(pb + i * 8) = o; }
}
__device__ __forceinline__ void rope_tables(Frame& F, const Args& a) {
    LAUNDER_LANES();
    float* c16 = MISCP(float, MO_COS16); float* s16 = MISCP(float, MO_SIN16); float* c32 = MISCP(float, MO_COS32); float* s32 = MISCP(float, MO_SIN32);
    const int gt = F.vcu * 512 + tid, NT = F.G * 512;
    for (int i = gt; i < SEQ * 48; i += NT) {
        const int pos = i / 48, f = i % 48; const double inv = (f < 16) ? a.inv16[f] : a.inv32[f - 16];
        const double ang = (double)pos * inv; const double k = __builtin_rint(ang * 0.15915494309189535); const double rr = ang - k * 6.283185307179586476925;
        const float r = (float)rr; const float cs = __cosf(r), sn = __sinf(r);
        if (f < 16) { c16[pos * 16 + f] = cs; s16[pos * 16 + f] = sn; } else { c32[pos * 32 + f - 16] = cs; s32[pos * 32 + f - 16] = sn; }
    }
}
__device__ __forceinline__ void router_weights(Frame& F, const Args& a) {
    LAUNDER_LANES();
    bf16* wr = MISCP(bf16, MO_WR);
    const int gt = F.vcu * 512 + tid, NT = F.G * 512;
    for (int i = gt; i < DEPTH * NEXP * DM; i += NT) { const int l = i / (NEXP * DM), e = (i / DM) % NEXP, k = i % DM;
        const float w = a.in[I_W_ROUTER][((size_t)l * DM + k) * NEXP + e] * a.in[I_FFN_NORM][l * DM + k];
        const unsigned hi = pk2(w, 0.f) & 0xffffu; const float wl = w - __uint_as_float(hi << 16); const unsigned lo = pk2(wl, 0.f) & 0xffffu;
        wr[((size_t)l * 32 + e) * DM + k] = (bf16)hi; wr[((size_t)l * 32 + 16 + e) * DM + k] = (bf16)lo; }
}
__device__ __forceinline__ void x_to_hb(Frame& F, const Args& a) {
    LAUNDER_LANES();
    const float* x = a.in[I_X]; bf16* hb = WSP(bf16, WS_HB);
    const bool loc = (F.G == 256); const int NGW = loc ? 256 : F.G * NWAVES, gw = loc ? (F.vcu >> 5) * (SEQ / 4) + (F.vcu & 31) * NWAVES + wave : F.vcu * NWAVES + wave;
    for (int it = 0; it < (loc ? 4 : (TOK / 4 + NGW - 1) / NGW); ++it) { const int m4 = gw + (loc ? 3 - it : it) * NGW; if (m4 >= TOK / 4) break;
        f32x4 v[4][4];
#pragma unroll
        for (int r = 0; r < 4; ++r) { const GAS f32x4* xr = (const GAS f32x4*)(x + (size_t)(m4 * 4 + r) * DM) + lane;
#pragma unroll
            for (int j = 0; j < 4; ++j) v[r][j] = __builtin_nontemporal_load(xr + 64 * j); }
#pragma unroll
        for (int r = 0; r < 4; ++r) { const int m = m4 * 4 + r; float s = 0.f;
#pragma unroll
            for (int j = 0; j < 4; ++j) s += (v[r][j][0] * v[r][j][0] + v[r][j][1] * v[r][j][1]) + (v[r][j][2] * v[r][j][2] + v[r][j][3] * v[r][j][3]);
            s = wave_sum(s);
            GAS v2u* o8 = (GAS v2u*)(hb + (size_t)m * DM) + lane;
#pragma unroll
            for (int j = 0; j < 4; ++j) o8[64 * j] = pk4(v[r][j]);
            if (lane < 16) MISCP(float, MO_PSSQ)[(size_t)m * 16 + lane] = (lane == 0) ? s : 0.f; }
    }
}
__device__ __forceinline__ void finalize_rstd(Frame& F, int mode) {
    LAUNDER_LANES();
    const int gt = F.vcu * 512 + tid, NT = F.G * 512;
    for (int m = gt; m < TOK; m += NT) {
        if (mode == 0) { const GAS f32x4* p = (const GAS f32x4*)(MISCP(float, MO_PSSQ) + (size_t)m * 16); const f32x4 a = p[0], b = p[1], c = p[2], d = p[3];
            const float s = ((a[0] + a[1]) + (a[2] + a[3])) + ((b[0] + b[1]) + (b[2] + b[3])) + ((c[0] + c[1]) + (c[2] + c[3])) + ((d[0] + d[1]) + (d[2] + d[3]));
            MISCP(float, MO_RSA)[m] = 1.0f / sqrtf(s * (1.f / DM) + NORM_EPS); }
        else { const GAS f32x4* p = (const GAS f32x4*)(MISCP(float, MO_GSSQ) + (size_t)m * 20); const f32x4 a = p[0], b = p[1], c = p[2], d = p[3], e = p[4];
            const float sq = ((a[0] + a[1]) + (a[2] + a[3])) + ((b[0] + b[1]) + (b[2] + b[3])) + ((c[0] + c[1]) + (c[2] + c[3])), sk = ((d[0] + d[1]) + (d[2] + d[3])) + ((e[0] + e[1]) + (e[2] + e[3]));
            MISCP(float, MO_RSCQ)[m] = 1.0f / sqrtf(sq * (1.f / 384.f) + NORM_EPS); MISCP(float, MO_RSCKV)[m] = 1.0f / sqrtf(sk * (1.f / 256.f) + NORM_EPS); }
    }
}
__device__ __forceinline__ void final_norm(Frame& F, const Args& a) {
    LAUNDER_LANES();
    const float* g = a.in[I_FINAL_NORM]; f32x4 gv[4];
#pragma unroll
    for (int j = 0; j < 4; ++j) gv[j] = *((const GAS f32x4*)g + lane + 64 * j);
    const GAS unsigned short* hb = (const GAS unsigned short*)F.hb;
    const bool loc = (F.G == 256); const int NGW = loc ? 256 : F.G * NWAVES, gw = loc ? (F.vcu >> 5) * (SEQ / 4) + (F.vcu & 31) * NWAVES + wave : F.vcu * NWAVES + wave;
    for (int it = 0; it < (loc ? 4 : (TOK / 4 + NGW - 1) / NGW); ++it) { const int m4 = gw + (loc ? 3 - it : it) * NGW; if (m4 >= TOK / 4) break;
        v2u w[4][4];
#pragma unroll
        for (int r = 0; r < 4; ++r) { const GAS v2u* xr = (const GAS v2u*)(hb + (size_t)(m4 * 4 + r) * DM) + lane;
#pragma unroll
            for (int j = 0; j < 4; ++j) w[r][j] = xr[64 * j]; }
#pragma unroll
        for (int r = 0; r < 4; ++r) { f32x4 v[4]; float s = 0.f;
#pragma unroll
            for (int j = 0; j < 4; ++j) { v[j][0] = __uint_as_float(w[r][j].x << 16); v[j][1] = __uint_as_float(w[r][j].x & 0xffff0000u); v[j][2] = __uint_as_float(w[r][j].y << 16); v[j][3] = __uint_as_float(w[r][j].y & 0xffff0000u);
                s += (v[j][0] * v[j][0] + v[j][1] * v[j][1]) + (v[j][2] * v[j][2] + v[j][3] * v[j][3]); }
            const float rs = 1.0f / sqrtf(wave_sum(s) * (1.f / DM) + NORM_EPS);
            GAS f32x4* o = (GAS f32x4*)(F.out + (size_t)(m4 * 4 + r) * DM) + lane;
#pragma unroll
            for (int j = 0; j < 4; ++j) __builtin_nontemporal_store(v[j] * rs * gv[j], o + 64 * j); }
    }
}
typedef pg8::Unit Unit;
typedef const f32x4 (&AccRef)[2][2][4][2];
#define EPI_ROW(u, ai, m) ((u).pm * 256 + (ai) * 128 + wr * 64 + (m) * 16 + fr)
#define EPI_GRP(u, bj) (((u).pn * 256 + (bj) * 128 + wc * 32) >> 5)
typedef GAS bf16 gbf16; typedef GAS float gf32; typedef const GAS float cgf32; typedef const GAS bf16 cgbf16;
__device__ __forceinline__ void st_bf4(gbf16* p, f32x4 v) { *(GAS v2u*)p = pk4(v); }
__device__ __forceinline__ void st_bf8(gbf16* p, f32x4 a, f32x4 b) { v4u w; w.x = pk2(a[0], a[1]); w.y = pk2(a[2], a[3]); w.z = pk2(b[0], b[1]); w.w = pk2(b[2], b[3]); *(GAS v4u*)p = w; }
__device__ __forceinline__ f32x4 ld_bf4(cgbf16* p) { const v2u w = *(const GAS v2u*)p; f32x4 r; r[0] = __uint_as_float(w.x << 16); r[1] = __uint_as_float(w.x & 0xffff0000u); r[2] = __uint_as_float(w.y << 16); r[3] = __uint_as_float(w.y & 0xffff0000u); return r; }
__device__ __forceinline__ f32x4 bflo(v4u w) { f32x4 r; r[0] = __uint_as_float(w.x << 16); r[1] = __uint_as_float(w.x & 0xffff0000u); r[2] = __uint_as_float(w.y << 16); r[3] = __uint_as_float(w.y & 0xffff0000u); return r; }
__device__ __forceinline__ f32x4 bfhi(v4u w) { f32x4 r; r[0] = __uint_as_float(w.z << 16); r[1] = __uint_as_float(w.z & 0xffff0000u); r[2] = __uint_as_float(w.w << 16); r[3] = __uint_as_float(w.w & 0xffff0000u); return r; }
#define EPI_LOAD_ROWS(arr, ptr, scale) float arr[2][4]; _Pragma("unroll") for (int ai = 0; ai < 2; ++ai) _Pragma("unroll") for (int m = 0; m < 4; ++m) arr[ai][m] = (ptr)[EPI_ROW(u, ai, m)] * (scale)
#define EPI_RSTD_ROWS(arr, ptr, STRIDE, OFF, N4, INVN, scale) float arr[2][4]; { f32x4 t_[2][4]; \
    _Pragma("unroll") for (int ai = 0; ai < 2; ++ai) _Pragma("unroll") for (int m = 0; m < 4; ++m) t_[ai][m] = (fq < (N4)) ? *(const GAS f32x4*)((ptr) + (size_t)EPI_ROW(u, ai, m) * (STRIDE) + (OFF) + 4 * fq) : (f32x4){0.f, 0.f, 0.f, 0.f}; \
    _Pragma("unroll") for (int ai = 0; ai < 2; ++ai) _Pragma("unroll") for (int m = 0; m < 4; ++m) { float s_ = (t_[ai][m][0] + t_[ai][m][1]) + (t_[ai][m][2] + t_[ai][m][3]); \
        s_ += __shfl_xor(s_, 16); s_ += __shfl_xor(s_, 32); arr[ai][m] = (scale) / sqrtf(s_ * (INVN) + NORM_EPS); } }

struct EpiIn {
    cgf32* rsa; gf32* gssq; gbf16 *naqkv, *cq, *ckv, *kr, *swq, *swk, *swv; cgf32 *c16, *s16, *c32, *s32; unsigned* krmax;
    __device__ __forceinline__ void operator()(AccRef acc, const Unit& u, int, int wr, int wc, int fr, int fq) const {
        EPI_RSTD_ROWS(rs, rsa, 16, 0, 4, 1.f / DM, 1.f);
#pragma unroll
        for (int bj = 0; bj < 2; ++bj) { const int g = EPI_GRP(u, bj);
            if (g >= 61) continue;
            float kmx = 0.f;
#pragma unroll
            for (int ai = 0; ai < 2; ++ai)
#pragma unroll
                for (int m = 0; m < 4; ++m) { const int row = EPI_ROW(u, ai, m); const int spos = row & (SEQ - 1);
                    const f32x4 v0 = acc[ai][bj][m][0] * rs[ai][m], v1 = acc[ai][bj][m][1] * rs[ai][m];
                    if (g < 24) { const float sc = (g < 8) ? C2_NA : 1.f; st_bf8(naqkv + (size_t)row * 768 + g * 32 + 8 * fq, v0 * sc, v1 * sc); }
                    else if (g < 44) { st_bf8((g < 36) ? cq + (size_t)row * 384 + (g - 24) * 32 + 8 * fq : ckv + (size_t)row * 256 + (g - 36) * 32 + 8 * fq, v0, v1);
                        float ss = ((v0[0] * v0[0] + v0[1] * v0[1]) + (v0[2] * v0[2] + v0[3] * v0[3])) + ((v1[0] * v1[0] + v1[1] * v1[1]) + (v1[2] * v1[2] + v1[3] * v1[3]));
                        ss += __shfl_xor(ss, 16); ss += __shfl_xor(ss, 32); if (fq == 0) gssq[(size_t)row * 20 + (g - 24)] = ss; }
                    else if (g == 44) { const f32x4 c = *(const GAS f32x4*)(c16 + spos * 16 + 4 * fq), sn = *(const GAS f32x4*)(s16 + spos * 16 + 4 * fq);
                        gbf16* d = kr + (size_t)row * 32 + 4 * fq; st_bf4(d, v0 * c - v1 * sn); st_bf4(d + 16, v1 * c + v0 * sn);
                        float ss = ((v0[0] * v0[0] + v0[1] * v0[1]) + (v0[2] * v0[2] + v0[3] * v0[3])) + ((v1[0] * v1[0] + v1[1] * v1[1]) + (v1[2] * v1[2] + v1[3] * v1[3]));
                        ss += __shfl_xor(ss, 16); ss += __shfl_xor(ss, 32); kmx = fmaxf(kmx, ss); }
                    else if (g < 57) { const bool isq = g < 53; const int gg = isq ? g - 45 : g - 53, head = gg >> 1, i0 = 16 * (gg & 1) + 4 * fq;
                        const f32x4 c = *(const GAS f32x4*)(c32 + spos * 32 + i0), sn = *(const GAS f32x4*)(s32 + spos * 32 + i0); const float sc = isq ? C2_SW : 1.f;
                        gbf16* d = (isq ? swq + (size_t)row * 256 : swk + (size_t)row * 128) + head * 64 + i0; st_bf4(d, (v0 * c - v1 * sn) * sc); st_bf4(d + 32, (v1 * c + v0 * sn) * sc); }
                    else st_bf8(swv + (size_t)row * 128 + (g - 57) * 32 + 8 * fq, v0, v1);
                }
            if (g == 44) { kmx = fmaxf(kmx, __shfl_xor(kmx, 1)); kmx = fmaxf(kmx, __shfl_xor(kmx, 2)); kmx = fmaxf(kmx, __shfl_xor(kmx, 4)); kmx = fmaxf(kmx, __shfl_xor(kmx, 8));
                if (fr == 0 && fq == 0) atomicMax(krmax + ((u.pm * 256) >> 12), __float_as_uint(kmx)); }
        }
    }
};
struct EpiQup {
    cgf32* rscq; gbf16* qm; cgf32 *c16, *s16;
    __device__ __forceinline__ void operator()(AccRef acc, const Unit& u, int, int wr, int wc, int fr, int fq) const {
        EPI_RSTD_ROWS(rs, rscq, 20, 0, 3, 1.f / 384.f, C2_MLA);
#pragma unroll
        for (int bj = 0; bj < 2; ++bj) { const int g = EPI_GRP(u, bj); const bool rope = (g % 3) == 2;
#pragma unroll
            for (int ai = 0; ai < 2; ++ai)
#pragma unroll
                for (int m = 0; m < 4; ++m) { const int row = EPI_ROW(u, ai, m); const f32x4 v0 = acc[ai][bj][m][0] * rs[ai][m], v1 = acc[ai][bj][m][1] * rs[ai][m];
                    if (rope) { const int sq = row & (SEQ - 1); const f32x4 c = *(const GAS f32x4*)(c16 + sq * 16 + 4 * fq), sn = *(const GAS f32x4*)(s16 + sq * 16 + 4 * fq);
                        gbf16* d = qm + (size_t)row * 768 + g * 32 + 4 * fq; st_bf4(d, v0 * c - v1 * sn); st_bf4(d + 16, v1 * c + v0 * sn); }
                    else st_bf8(qm + (size_t)row * 768 + g * 32 + 8 * fq, v0, v1); } }
    }
};
struct EpiKVup {
    cgf32* rsckv; gbf16 *kn, *vm; unsigned* kmax;
    __device__ __forceinline__ void operator()(AccRef acc, const Unit& u, int, int wr, int wc, int fr, int fq) const {
        EPI_RSTD_ROWS(rs, rsckv, 20, 12, 2, 1.f / 256.f, 1.f);
#pragma unroll
        for (int bj = 0; bj < 2; ++bj) { const int g = EPI_GRP(u, bj), h = g >> 2, part = g & 3; gbf16* base = ((part < 2) ? kn : vm) + h * 64 + (part & 1) * 32 + 8 * fq; float mx = 0.f;
#pragma unroll
            for (int ai = 0; ai < 2; ++ai)
#pragma unroll
                for (int m = 0; m < 4; ++m) { const f32x4 v0 = acc[ai][bj][m][0] * rs[ai][m], v1 = acc[ai][bj][m][1] * rs[ai][m]; st_bf8(base + (size_t)EPI_ROW(u, ai, m) * 512, v0, v1);
                    if (part < 2) { float ss = ((v0[0] * v0[0] + v0[1] * v0[1]) + (v0[2] * v0[2] + v0[3] * v0[3])) + ((v1[0] * v1[0] + v1[1] * v1[1]) + (v1[2] * v1[2] + v1[3] * v1[3]));
                        ss += __shfl_xor(ss, 16); ss += __shfl_xor(ss, 32); mx = fmaxf(mx, ss); } }
            if (part < 2) { mx = fmaxf(mx, __shfl_xor(mx, 1)); mx = fmaxf(mx, __shfl_xor(mx, 2)); mx = fmaxf(mx, __shfl_xor(mx, 4)); mx = fmaxf(mx, __shfl_xor(mx, 8));
                if (fr == 0 && fq == 0) atomicMax(kmax + (((u.pm * 256) >> 12) * 8 + h) * 2 + part, __float_as_uint(mx)); } }
    }
};
struct EpiBf {
    gbf16* o; int ldc;
    __device__ __forceinline__ void operator()(AccRef acc, const Unit& u, int, int wr, int wc, int fr, int fq) const {
#pragma unroll
        for (int bj = 0; bj < 2; ++bj) { gbf16* base = o + EPI_GRP(u, bj) * 32 + 8 * fq;
#pragma unroll
            for (int ai = 0; ai < 2; ++ai)
#pragma unroll
                for (int m = 0; m < 4; ++m) st_bf8(base + (size_t)EPI_ROW(u, ai, m) * ldc, acc[ai][bj][m][0], acc[ai][bj][m][1]); }
    }
};
struct EpiRes {
    gbf16* hb;
    __device__ __forceinline__ void operator()(AccRef acc, const Unit& u, int, int wr, int wc, int fr, int fq) const {
#pragma unroll
        for (int ai = 0; ai < 2; ++ai) { v4u hv[4][2];
#pragma unroll
            for (int m = 0; m < 4; ++m)
#pragma unroll
                for (int bj = 0; bj < 2; ++bj) hv[m][bj] = *(const GAS v4u*)(hb + (size_t)EPI_ROW(u, ai, m) * DM + EPI_GRP(u, bj) * 32 + 8 * fq);
#pragma unroll
            for (int m = 0; m < 4; ++m)
#pragma unroll
                for (int bj = 0; bj < 2; ++bj) st_bf8(hb + (size_t)EPI_ROW(u, ai, m) * DM + EPI_GRP(u, bj) * 32 + 8 * fq, bflo(hv[m][bj]) + acc[ai][bj][m][0], bfhi(hv[m][bj]) + acc[ai][bj][m][1]);
            asm volatile("" ::: "memory"); }
    }
};
struct EpiSwiglu {
    cgf32* srs; gbf16* act;
    __device__ __forceinline__ void operator()(AccRef acc, const Unit& u, int, int wr, int wc, int fr, int fq) const {
        EPI_LOAD_ROWS(rs, srs, 1.f);
#pragma unroll
        for (int ai = 0; ai < 2; ++ai)
#pragma unroll
            for (int m = 0; m < 4; ++m) { const int row = EPI_ROW(u, ai, m);
#pragma unroll
                for (int bj = 0; bj < 2; ++bj) { const f32x4 a = acc[ai][bj][m][0] * rs[ai][m], up = acc[ai][bj][m][1] * rs[ai][m]; f32x4 r;
#pragma unroll
                    for (int e = 0; e < 4; ++e) r[e] = a[e] * __builtin_amdgcn_rcpf(1.f + __builtin_amdgcn_exp2f(-a[e] * LOG2E)) * up[e];
                    st_bf4(act + (size_t)row * EFF + EPI_GRP(u, bj) * 16 + 4 * fq, r); } }
    }
};
struct EpiDown {
    cgf32* sg; gbf16* y;
    __device__ __forceinline__ void operator()(AccRef acc, const Unit& u, int, int wr, int wc, int fr, int fq) const {
        EPI_LOAD_ROWS(gw, sg, 1.f);
#pragma unroll
        for (int bj = 0; bj < 2; ++bj) { gbf16* base = y + EPI_GRP(u, bj) * 32 + 8 * fq;
#pragma unroll
            for (int ai = 0; ai < 2; ++ai)
#pragma unroll
                for (int m = 0; m < 4; ++m) st_bf8(base + (size_t)EPI_ROW(u, ai, m) * DM, acc[ai][bj][m][0] * gw[ai][m], acc[ai][bj][m][1] * gw[ai][m]); }
    }
};
struct EpiPle {
    cgf32* rsp; cgbf16* pp; cgbf16* hb; gbf16* hbo; gf32* pssq;
    __device__ __forceinline__ void operator()(AccRef acc, const Unit& u, int, int wr, int wc, int fr, int fq) const {
        EPI_LOAD_ROWS(rs, rsp, 1.f);
#pragma unroll
        for (int ai = 0; ai < 2; ++ai) { v4u hv[4][2], pv[4][2];
#pragma unroll
            for (int m = 0; m < 4; ++m)
#pragma unroll
                for (int bj = 0; bj < 2; ++bj) { const size_t off = (size_t)EPI_ROW(u, ai, m) * DM + EPI_GRP(u, bj) * 32 + 8 * fq; hv[m][bj] = *(const GAS v4u*)(hb + off); pv[m][bj] = __builtin_nontemporal_load((const GAS v4u*)(pp + off)); }
#pragma unroll
            for (int m = 0; m < 4; ++m) { float ss = 0.f; const int row = EPI_ROW(u, ai, m);
#pragma unroll
                for (int bj = 0; bj < 2; ++bj) { const f32x4 a0 = acc[ai][bj][m][0] * rs[ai][m], a1 = acc[ai][bj][m][1] * rs[ai][m]; const f32x4 h0 = bflo(hv[m][bj]), h1 = bfhi(hv[m][bj]), p0 = bflo(pv[m][bj]), p1 = bfhi(pv[m][bj]); f32x4 r0, r1;
#pragma unroll
                    for (int e = 0; e < 4; ++e) { r0[e] = h0[e] + __builtin_amdgcn_rcpf(1.f + __builtin_amdgcn_exp2f(-a0[e] * LOG2E)) * p0[e]; r1[e] = h1[e] + __builtin_amdgcn_rcpf(1.f + __builtin_amdgcn_exp2f(-a1[e] * LOG2E)) * p1[e]; }
                    st_bf8(hbo + (size_t)row * DM + EPI_GRP(u, bj) * 32 + 8 * fq, r0, r1);
                    ss += ((r0[0] * r0[0] + r0[1] * r0[1]) + (r0[2] * r0[2] + r0[3] * r0[3])) + ((r1[0] * r1[0] + r1[1] * r1[1]) + (r1[2] * r1[2] + r1[3] * r1[3])); }
                ss += __shfl_xor(ss, 16); ss += __shfl_xor(ss, 32);
                if (fq == 0) pssq[(size_t)row * 16 + u.pn * 4 + wc] = ss; }
            asm volatile("" ::: "memory"); }
    }
};

__device__ __forceinline__ void router_pass(Frame& F, const Args& a, int l) {
    LAUNDER_LANES();
    typedef short bf16x8_t __attribute__((ext_vector_type(8)));
    constexpr int WST = 2064;
    LAS char* WB = (LAS char*)(F.lds + RING_OFF);
    LAS float* sc = (LAS float*)(F.lds + RING_OFF + 32 * WST) + wave * 16;
    const GAS char* wsrc = (const GAS char*)(F.ws + WS_MISC + MO_WR) + (size_t)l * 32 * DM * 2;
    for (int c = tid; c < 32 * 128; c += 512) { const int r = c >> 7, ch = c & 127; *(LAS v4u*)(WB + r * WST + ch * 16) = *(const GAS v4u*)(wsrc + (size_t)r * 2048 + ch * 16); }
    __syncthreads();
    gf32* aff = (gf32*)MISCP(float, MO_AFF); gf32* rsf = (gf32*)MISCP(float, MO_RSF);
    const int gw = F.vcu * NWAVES + wave, NGW = F.G * NWAVES, fr = lane & 15, fq = lane >> 4;
    for (int grp = gw; grp < TOK / 16; grp += NGW) {
        const int row0 = grp * 16;
        const GAS char* ap = (const GAS char*)F.hb + ((size_t)(row0 + fr) * DM + fq * 8) * 2;
        const LAS char* bp = WB + fr * WST + fq * 16;
        f32x4 ah = {0.f, 0.f, 0.f, 0.f}, al = {0.f, 0.f, 0.f, 0.f}, as = {0.f, 0.f, 0.f, 0.f};
#pragma unroll 8
        for (int ks = 0; ks < 32; ++ks) { const bf16x8_t av = *(const GAS bf16x8_t*)(ap + ks * 64);
            const bf16x8_t bh = *(const LAS bf16x8_t*)(bp + ks * 64), bl = *(const LAS bf16x8_t*)(bp + 16 * WST + ks * 64);
            ah = __builtin_amdgcn_mfma_f32_16x16x32_bf16(av, bh, ah, 0, 0, 0); al = __builtin_amdgcn_mfma_f32_16x16x32_bf16(av, bl, al, 0, 0, 0);
            as = __builtin_amdgcn_mfma_f32_16x16x32_bf16(av, av, as, 0, 0, 0); }
        { const float d = (fr & 3) == 0 ? as[0] : (fr & 3) == 1 ? as[1] : (fr & 3) == 2 ? as[2] : as[3]; if ((fr >> 2) == fq) sc[fr] = d; }
        LDS_WAIT();
        const f32x4 ssq = *(const LAS f32x4*)(sc + 4 * fq);
#pragma unroll
        for (int r = 0; r < 4; ++r) { const float rs = 1.0f / sqrtf(ssq[r] * (1.f / DM) + NORM_EPS); const float lg = (ah[r] + al[r]) * rs;
            float mx = lg; mx = fmaxf(mx, __shfl_xor(mx, 1)); mx = fmaxf(mx, __shfl_xor(mx, 2)); mx = fmaxf(mx, __shfl_xor(mx, 4)); mx = fmaxf(mx, __shfl_xor(mx, 8));
            const float ex = __expf(lg - mx); float sm = ex; sm += __shfl_xor(sm, 1); sm += __shfl_xor(sm, 2); sm += __shfl_xor(sm, 4); sm += __shfl_xor(sm, 8);
            const int m = row0 + 4 * fq + r;
            aff[((size_t)(m >> 12) * NEXP + fr) * SEQ + (m & (SEQ - 1))] = ex / sm;
            if (fr == 0) rsf[m] = rs; }
        LDS_WAIT(); asm volatile("" ::: "memory");
    }
}
__device__ __forceinline__ unsigned block_excl_scan(unsigned v, LAS unsigned* wsum, int lane, int wave) {
    unsigned s = v;
#pragma unroll
    for (int d = 1; d < 64; d <<= 1) { const unsigned t = __shfl_up(s, d); if (lane >= d) s += t; }
    if (lane == 63) wsum[wave] = s;
    __syncthreads();
    unsigned base = 0;
    for (int w = 0; w < wave; ++w) base += wsum[w];
    __syncthreads();
    return base + s - v;
}
__device__ __forceinline__ void topk_block(Frame& F, int be) {
    LAUNDER_LANES();
    LAS unsigned* hist = (LAS unsigned*)(F.lds + RING_OFF); LAS unsigned* ctl = hist + 256; LAS unsigned* wsum = hist + 272;
    const float* aff = MISCP(float, MO_AFF) + (size_t)be * SEQ; const float* rsf = MISCP(float, MO_RSF);
    unsigned* sidx = MISCP(unsigned, MO_SIDX) + be * CAP; float* sg = MISCP(float, MO_SG) + be * CAP; float* srs = MISCP(float, MO_SRS) + be * CAP; int* inv = MISCP(int, MO_INV);
    const int b = be >> 4, e = be & 15;
    unsigned key[8];
    { const v4u k0 = *(const GAS v4u*)(aff + tid * 8), k1 = *(const GAS v4u*)(aff + tid * 8 + 4); key[0] = k0.x; key[1] = k0.y; key[2] = k0.z; key[3] = k0.w; key[4] = k1.x; key[5] = k1.y; key[6] = k1.z; key[7] = k1.w; }
    unsigned prefix = 0, need = CAP;
#pragma unroll
    for (int pass = 0; pass < 4; ++pass) { const int shift = 24 - 8 * pass;
        if (tid < 256) hist[tid] = 0u;
        __syncthreads();
#pragma unroll
        for (int i = 0; i < 8; ++i) { const bool match = (pass == 0) ? true : ((key[i] >> ((shift + 8) & 31)) == prefix); if (match) (void)__hip_atomic_fetch_add(&hist[(key[i] >> shift) & 255u], 1u, __ATOMIC_RELAXED, __HIP_MEMORY_SCOPE_WORKGROUP); }
        __syncthreads();
        if (wave == 0) { const unsigned h0 = hist[255 - 4 * lane], h1 = hist[254 - 4 * lane], h2 = hist[253 - 4 * lane], h3 = hist[252 - 4 * lane]; const unsigned c = h0 + h1 + h2 + h3; unsigned s = c;
#pragma unroll
            for (int d = 1; d < 64; d <<= 1) { const unsigned t = __shfl_up(s, d); if (lane >= d) s += t; }
            const unsigned excl = s - c;
            if (excl < need && need <= s) { const unsigned r = need - excl; unsigned bin, above;
                if (r <= h0) { bin = 255 - 4 * lane; above = 0; } else if (r <= h0 + h1) { bin = 254 - 4 * lane; above = h0; } else if (r <= h0 + h1 + h2) { bin = 253 - 4 * lane; above = h0 + h1; } else { bin = 252 - 4 * lane; above = h0 + h1 + h2; }
                ctl[0] = (prefix << 8) | bin; ctl[1] = r - above; } }
        __syncthreads();
        prefix = ctl[0]; need = ctl[1];
    }
    const unsigned T = prefix;
    unsigned cgt = 0, ceq = 0;
#pragma unroll
    for (int i = 0; i < 8; ++i) { cgt += key[i] > T ? 1u : 0u; ceq += key[i] == T ? 1u : 0u; }
    const unsigned eqb = block_excl_scan(ceq, wsum, lane, wave);
    const unsigned take = (eqb >= need) ? 0u : ((need - eqb) < ceq ? (need - eqb) : ceq);
    unsigned pos = block_excl_scan(cgt + take, wsum, lane, wave);
    unsigned eqr = 0;
#pragma unroll
    for (int i = 0; i < 8; ++i) { const int s = tid * 8 + i; bool sel = key[i] > T; if (key[i] == T) { sel = eqr < take; ++eqr; }
        const int grow = b * SEQ + s;
        if (sel) { sidx[pos] = (unsigned)grow; sg[pos] = __uint_as_float(key[i]); srs[pos] = rsf[grow]; inv[(size_t)grow * NEXP + e] = (int)pos; ++pos; }
        else inv[(size_t)grow * NEXP + e] = -1; }
    __syncthreads();
}
__device__ __forceinline__ void combine_pass(Frame& F) {
    LAUNDER_LANES();
    const GAS int* inv = (const GAS int*)MISCP(int, MO_INV); cgbf16* Y = (cgbf16*)(F.ws + WS_BIG + BOX(BO_Y, 128)); gbf16* hb = (gbf16*)F.hb; gf32* rsp = (gf32*)MISCP(float, MO_RSP);
    const bool loc = (F.G == 256); const int NGW = loc ? 256 : F.G * NWAVES, gw = loc ? (F.vcu >> 5) * SEQ + (F.vcu & 31) * NWAVES + wave : F.vcu * NWAVES + wave, mend = loc ? ((F.vcu >> 5) + 1) * SEQ : TOK;
    v2u hn[4]; int ivn = -1;
    if (gw < mend) { const GAS v2u* hr = (const GAS v2u*)(hb + (size_t)gw * DM) + lane;
#pragma unroll
        for (int j = 0; j < 4; ++j) hn[j] = hr[64 * j];
        ivn = (lane < 16) ? inv[(size_t)gw * NEXP + lane] : -1; }
    for (int m = gw; m < mend; m += NGW) {
        f32x4 v[4]; const int ivl = ivn;
#pragma unroll
        for (int j = 0; j < 4; ++j) { v[j][0] = __uint_as_float(hn[j].x << 16); v[j][1] = __uint_as_float(hn[j].x & 0xffff0000u); v[j][2] = __uint_as_float(hn[j].y << 16); v[j][3] = __uint_as_float(hn[j].y & 0xffff0000u); }
        const int mn = m + NGW;
        if (mn < mend) { const GAS v2u* hr = (const GAS v2u*)(hb + (size_t)mn * DM) + lane;
#pragma unroll
            for (int j = 0; j < 4; ++j) hn[j] = hr[64 * j];
            ivn = (lane < 16) ? inv[(size_t)mn * NEXP + lane] : -1; }
        unsigned mk = (unsigned)__ballot(ivl >= 0) & 0xffffu;
        cgbf16* ybase = Y + (size_t)(m >> 12) * NEXP * CAP * DM + 4 * lane;
        while (mk) {
            v2u y[4][4]; bool has[4];
#pragma unroll
            for (int g = 0; g < 4; ++g) { has[g] = mk != 0u; const int e = has[g] ? (__builtin_ctz(mk)) : 0; if (has[g]) mk &= mk - 1u;
                const int pos = __builtin_amdgcn_readlane(ivl, e);
                if (has[g]) { const GAS v2u* yr = (const GAS v2u*)(ybase + ((size_t)e * CAP + pos) * DM);
#pragma unroll
                    for (int j = 0; j < 4; ++j) y[g][j] = __builtin_nontemporal_load(yr + 64 * j); } }
#pragma unroll
            for (int g = 0; g < 4; ++g) if (has[g]) {
#pragma unroll
                for (int j = 0; j < 4; ++j) { v[j][0] += __uint_as_float(y[g][j].x << 16); v[j][1] += __uint_as_float(y[g][j].x & 0xffff0000u); v[j][2] += __uint_as_float(y[g][j].y << 16); v[j][3] += __uint_as_float(y[g][j].y & 0xffff0000u); } }
        }
        gbf16* ho = hb + (size_t)m * DM + 4 * lane; float s = 0.f;
#pragma unroll
        for (int j = 0; j < 4; ++j) { st_bf4(ho + 256 * j, v[j]); s += (v[j][0] * v[j][0] + v[j][1] * v[j][1]) + (v[j][2] * v[j][2] + v[j][3] * v[j][3]); }
        const float rs = 1.0f / sqrtf(wave_sum(s) * (1.f / DM) + NORM_EPS);
        if (lane == 0) rsp[m] = rs;
    }
}

__device__ __forceinline__ void attention_phase(Frame& F, const Args& a, int l) {
    const GAS bf16* big = (const GAS bf16*)(F.ws + WS_BIG); GAS bf16* ocat = (GAS bf16*)(F.ws + WS_OCAT);
    const GAS bf16* naqkv = (const GAS bf16*)((const GAS char*)big + BOX(BO_NAQKV, 48)); const GAS bf16* krp = (const GAS bf16*)((const GAS char*)big + BOX(BO_KR, 2));
    const GAS bf16* swq = (const GAS bf16*)((const GAS char*)big + BOX(BO_SWQ, 16)); const GAS bf16* swk = (const GAS bf16*)((const GAS char*)big + BOX(BO_SWK, 8)); const GAS bf16* swv = (const GAS bf16*)((const GAS char*)big + BOX(BO_SWV, 8));
    const GAS bf16* qm = (const GAS bf16*)((const GAS char*)big + BOX(BO_QM, 48)); const GAS bf16* kn = (const GAS bf16*)((const GAS char*)big + BOX(BO_KN, 32)); const GAS bf16* vm = (const GAS bf16*)((const GAS char*)big + BOX(BO_VM, 32));
    LAS char* lds = (LAS char*)(F.lds + RING_OFF);
    DUP(15) PH(15) for (int i = 0; i < 2 * 256; i += 1) {
        int uidx;
        if (F.G == 256) { if (i >= 2) break; const int x = F.vcu >> 5, v = F.vcu & 31; uidx = ((x * 8 + 4 * i + (v >> 3)) << 3) | (v & 7); }
        else { uidx = F.vcu + i * F.G; if (uidx >= 512) break; }
        const int bh = uidx >> 3, qb = uidx & 7, b = bh >> 3, h = bh & 7; const size_t r0 = (size_t)b * SEQ;
        att::AttnIO io; io.q = qm + (r0 + qb * 512) * 768 + h * 96; io.ldq = 768; io.k = kn + r0 * 512 + h * 64; io.ldk = 512; io.k2 = krp + r0 * 32; io.ldk2 = 32;
        io.v = vm + r0 * 512 + h * 64; io.ldv = 512; io.o = ocat + (r0 + qb * 512) * DM + 256 + h * 64; io.ldo = DM;
        const unsigned* km = (const unsigned*)(F.ws + WS_CTL) + CW_KMAX; const float km2 = __uint_as_float(__hip_atomic_load(km + bh * 2, __ATOMIC_RELAXED, __HIP_MEMORY_SCOPE_AGENT)) + __uint_as_float(__hip_atomic_load(km + bh * 2 + 1, __ATOMIC_RELAXED, __HIP_MEMORY_SCOPE_AGENT)) + __uint_as_float(__hip_atomic_load(km + 128 + b, __ATOMIC_RELAXED, __HIP_MEMORY_SCOPE_AGENT));
        int role; if (att::mla_block_fixed<2>(io, km2, lds, role)) att::attn_unit16<4>(io, role, lds);
        else { att::attn_unit<0, false>(io, 0, 0.f, nullptr, lds); io.q += (size_t)256 * io.ldq; io.o += (size_t)256 * io.ldo; att::attn_unit<0, false>(io, 0, 0.f, nullptr, lds); }
    }
    DUP(16) PH(16) for (int uq = F.vcu; uq < 512; uq += F.G) { const int uidx = (F.G == 256) ? ((F.vcu >> 5) << 6) | ((uq >> 8) << 5) | (F.vcu & 31) : uq;
        const int r4 = uidx & 15, h = (uidx >> 4) & 3, b = uidx >> 6; const size_t r0 = (size_t)b * SEQ;
        att::AttnIO io; io.q = naqkv + (r0 + r4 * 256) * 768 + h * 64; io.ldq = 768; io.k = naqkv + r0 * 768 + 256 + h * 64; io.ldk = 768; io.k2 = nullptr; io.ldk2 = 0;
        io.v = naqkv + r0 * 768 + 512 + h * 64; io.ldv = 768; io.o = ocat + (r0 + r4 * 256) * DM + h * 64; io.ldo = DM;
        att::attn_unit<1>(io, r4, 0.f, (const GAS float*)(a.in[I_NA_RPB] + ((size_t)l * 4 + h) * 465), lds);
    }
    DUP(17) PH(17) { int tid3_ = threadIdx.x; asm volatile("" : "+v"(tid3_)); const int wv = __builtin_amdgcn_readfirstlane(tid3_ >> 6);
      __syncthreads();
      for (int wt = F.vcu * 8 + wv; wt < 2048; wt += F.G * 8) {
#pragma unroll 1
        for (int k2 = 0; k2 < 2; ++k2) { const int tsk = wt * 2 + k2, jb = tsk & 127, h = (tsk >> 7) & 3, b = tsk >> 9; const size_t r0 = (size_t)b * SEQ;
          att::swa_wave_task(swq + r0 * 256 + h * 64, swk + r0 * 128 + (h >> 1) * 64, swv + r0 * 128 + (h >> 1) * 64, ocat + r0 * DM + 768 + h * 64, jb * 32,
                             a.in[I_SWA_SINK][l * 4 + h] * LOG2E, lds + wv * att::SWW_LDS); } }
      __syncthreads(); }
}

__global__ void __launch_bounds__(NWAVES * 64, 2) enc_fwd(Args args) {
    extern __shared__ __attribute__((aligned(16))) unsigned char lds[];
    Frame F;
    F.lds = (LAS unsigned char*)lds;
    F.MISC = (volatile LAS unsigned*)(F.lds + MISC_OFF);
    F.G = gridDim.x; { const int bx = blockIdx.x; F.vcu = (F.G % 8 == 0) ? (bx % 8) * (F.G / 8) + bx / 8 : bx; }
    F.ws = args.ws; F.out = args.out; F.xl = 0; F.xb = 0;
    for (int u = threadIdx.x; u < (GTAB_OFF - LDSCTL_OFF) / 4; u += NWAVES * 64) ((LAS unsigned*)(F.lds + LDSCTL_OFF))[u] = 0u;
    __syncthreads();
    XcdBarrier bar = xcd_barrier_post((unsigned*)(F.ws + WS_CTL) + CW_BAR, F.MISC + 8);
#define BAR_REFRESH() do { unsigned char* ws_ = args.ws; asm volatile("" : "+s"(ws_)); F.ws = ws_; bar.bar = (unsigned*)(ws_ + WS_CTL) + CW_BAR; Wl = lcur ? (bf16*)((char*)F.out + ((size_t)64 << 20)) : WSP(bf16, WS_W); hb = hb_in_out ? (bf16*)F.out : WSP(bf16, WS_HB); F.hb = hb; big = F.ws + WS_BIG; } while (0)
#define GRID_BAR() do { { unsigned x_ = bar.x; asm volatile("" : "+s"(x_)); bar.x = x_; } xcd_barrier(bar); BAR_REFRESH(); } while (0)
#define LAYER_BAR() GRID_BAR()
    int lcur = 0;
    bool hb_in_out = false;
    bf16* Wl = WSP(bf16, WS_W); bf16* hb = WSP(bf16, WS_HB); unsigned char* big = F.ws + WS_BIG; F.hb = hb;
    const int bx = (int)blockIdx.x;

    DUP(0) PH(0) { if (DEPTH > 1) { convert_layer_weights(F, args, 1, false, (bf16*)((char*)F.out + ((size_t)64 << 20))); convert_p(F, args, 1, (bf16*)(F.ws + WS_END)); }
    rope_tables(F, args);
    router_weights(F, args);
    convert_p(F, args, 0, WSP(bf16, WS_PB));
    convert_layer_weights(F, args, 0, true, WSP(bf16, WS_W));
    x_to_hb(F, args); }
    static_assert(DEPTH <= 2, "weight regions");
    GRID_BAR();
    int cid = bx; bool xl_ok = false;
    { if (threadIdx.x == 0) { unsigned* bw = (unsigned*)(F.ws + WS_CTL) + CW_BAR; unsigned n32 = 0, sum = 0;
          for (unsigned j = 0; j < 16; ++j) { const unsigned c = xb_ld(&bw[XB_XCNT(j)]); sum += c; n32 += (c == 32u) ? 1u : 0u; }
          F.MISC[8 + 3] = (n32 == 8u && sum == 256u && F.G == 256) ? 1u : 0u; }
      __syncthreads();
      xl_ok = F.MISC[8 + 3] != 0u; const int rank = (int)F.MISC[8 + 2], xcc = (int)bar.x;
      if (xl_ok) { cid = __builtin_amdgcn_readfirstlane(rank * 8 + xcc); F.vcu = __builtin_amdgcn_readfirstlane(xcc * 32 + rank); } }

    int done_layers = 0;
#pragma unroll 1
    for (int l = 0; l < DEPTH; ++l) {
        if (STOP_AFTER <= 10 * l) break;
        lcur = l; Wl = lcur ? (bf16*)((char*)F.out + ((size_t)64 << 20)) : WSP(bf16, WS_W);
        DUP(1) PH(1) { pg8::ProbPlain g{hb, (const bf16*)((char*)Wl + WO_IN), DM}; pg8::StaticOrder S; S.init(TOK, IN_WP, F.G, cid);
          EpiIn E{(cgf32*)MISCP(float, MO_PSSQ), (gf32*)MISCP(float, MO_GSSQ), (gbf16*)(big + BOX(BO_NAQKV, 48)), (gbf16*)(big + BOX(BO_CQ, 24)), (gbf16*)(big + BOX(BO_CKV, 16)), (gbf16*)(big + BOX(BO_KR, 2)), (gbf16*)(big + BOX(BO_SWQ, 16)), (gbf16*)(big + BOX(BO_SWK, 8)), (gbf16*)(big + BOX(BO_SWV, 8)),
                  (cgf32*)MISCP(float, MO_COS16), (cgf32*)MISCP(float, MO_SIN16), (cgf32*)MISCP(float, MO_COS32), (cgf32*)MISCP(float, MO_SIN32), (unsigned*)(F.ws + WS_CTL) + CW_KRMAX};
          pg8::gemm_phase<pg8::ProbPlain, EpiIn, pg8::StaticOrder, true>(F.lds + RING_OFF, g, S, E); }
        LAYER_BAR();
        const bool p2split = (F.G == 256);
        DUP(2) PH(2) if (!p2split || cid < 128) { pg8::ProbPlain g{(const bf16*)(big + BOX(BO_CQ, 24)), (const bf16*)((char*)Wl + WO_QUP), 384}; pg8::StaticOrder S; S.init(TOK, 768, p2split ? 128 : F.G, cid);
          EpiQup E{(cgf32*)MISCP(float, MO_GSSQ), (gbf16*)(big + BOX(BO_QM, 48)), (cgf32*)MISCP(float, MO_COS16), (cgf32*)MISCP(float, MO_SIN16)};
          pg8::gemm_phase<pg8::ProbPlain, EpiQup, pg8::StaticOrder, true>(F.lds + RING_OFF, g, S, E); }
        DUP(2) PH(3) if (!p2split || cid >= 128) { pg8::ProbPlain g{(const bf16*)(big + BOX(BO_CKV, 16)), (const bf16*)((char*)Wl + WO_KVUP), 256}; pg8::StaticOrder S; S.init(TOK, 1024, p2split ? 128 : F.G, p2split ? cid - 128 : cid);
          EpiKVup E{(cgf32*)MISCP(float, MO_GSSQ), (gbf16*)(big + BOX(BO_KN, 32)), (gbf16*)(big + BOX(BO_VM, 32)), (unsigned*)(F.ws + WS_CTL) + CW_KMAX};
          pg8::gemm_phase<pg8::ProbPlain, EpiKVup, pg8::StaticOrder, true>(F.lds + RING_OFF, g, S, E); }
        LAYER_BAR();
        DUP(4) PH(4) attention_phase(F, args, l);
        LAYER_BAR();
        PH(5) { pg8::ProbPlain g{WSP(bf16, WS_OCAT), (const bf16*)((char*)Wl + WO_OUT), DM}; pg8::StaticOrder S; S.init(TOK, DM, F.G, cid);
          EpiRes E{(gbf16*)hb};
          pg8::gemm_phase<pg8::ProbPlain, EpiRes, pg8::StaticOrder, true>(F.lds + RING_OFF, g, S, E); }
        LAYER_BAR();
        done_layers = l + 1;
        if (STOP_AFTER <= 10 * l + 1) break;
        DUP(6) PH(6) router_pass(F, args, l);
        LAYER_BAR();
        DUP(7) PH(7) { if (F.G == 256) { if (cid < 128) topk_block(F, (cid & 7) * NEXP + (cid >> 3)); }
                       else for (int be = bx; be < BATCH * NEXP; be += F.G) topk_block(F, be); }
        DUP(8) PH(8) { pg8::ProbPlain g{lcur ? (const bf16*)(F.ws + WS_END) : WSP(bf16, WS_PB), (const bf16*)((char*)Wl + WO_PP), PLE}; pg8::StaticOrder S; S.init(TOK, DM, (F.G == 256) ? (cid < 128 ? 512 : 128) : F.G, cid);
          EpiBf E{(gbf16*)WSP(bf16, WS_PPO), DM};
          pg8::gemm_phase<pg8::ProbPlain, EpiBf, pg8::StaticOrder, true>(F.lds + RING_OFF, g, S, E); }
        LAYER_BAR();
        DUP(9) PH(9) { pg8::ExpertOrder S; S.init(NSLOT, DM, F.G, cid);
          LAS unsigned* gtab = (LAS unsigned*)(F.lds + GTAB_OFF); const unsigned* sidx = MISCP(unsigned, MO_SIDX);
          { LAUNDER_LANES(); Unit u; for (int i = 0; i < 8; ++i) if (S.next(i, u) && tid < 256) gtab[i * 256 + tid] = sidx[u.pm * 256 + tid]; }
          __syncthreads();
          pg8::ProbGather g{hb, (const bf16*)((char*)Wl + WO_GU), DM, (size_t)DM * DM, gtab};
          EpiSwiglu E{(cgf32*)MISCP(float, MO_SRS), (gbf16*)(big + BOX(BO_ACT, 64))};
          pg8::gemm_phase<pg8::ProbGather, EpiSwiglu, pg8::ExpertOrder, true>(F.lds + RING_OFF, g, S, E); }
        LAYER_BAR();
        DUP(10) PH(10) { pg8::ProbExpert g{(const bf16*)(big + BOX(BO_ACT, 64)), (const bf16*)((char*)Wl + WO_DOWN), EFF, (size_t)DM * EFF}; pg8::ExpertOrder S; S.init(NSLOT, DM, F.G, cid);
          EpiDown E{(cgf32*)MISCP(float, MO_SG), (gbf16*)(big + BOX(BO_Y, 128))};
          pg8::gemm_phase<pg8::ProbExpert, EpiDown, pg8::ExpertOrder, true>(F.lds + RING_OFF, g, S, E); }
        LAYER_BAR();
        PH(11) combine_pass(F);
        if (STOP_AFTER <= 10 * l + 2) { GRID_BAR(); break; }
        LAYER_BAR();
        DUP(13) PH(13) { pg8::ProbPlain g{hb, WSP(bf16, WS_WPG) + (size_t)l * DM * DM, DM}; pg8::StaticOrder S; S.init(TOK, DM, F.G, cid);
          EpiPle E{(cgf32*)MISCP(float, MO_RSP), (cgbf16*)WSP(bf16, WS_PPO), (cgbf16*)hb, (gbf16*)(hb_in_out ? WSP(bf16, WS_HB) : (bf16*)F.out), (gf32*)MISCP(float, MO_PSSQ)};
          pg8::gemm_phase<pg8::ProbPlain, EpiPle, pg8::StaticOrder, true>(F.lds + RING_OFF, g, S, E); }
        hb_in_out = !hb_in_out;
        if (l == DEPTH - 1) GRID_BAR(); else LAYER_BAR();
    }
    DUP(14) PH(14) final_norm(F, args);
    if (bx == 0 && threadIdx.x == 0) { unsigned* b = (unsigned*)(F.ws + WS_CTL) + CW_BAR; if (xb_ld(&b[XB_TMO]) != 0u) { const float q = __builtin_nanf(""); F.out[0] = q; } }
#undef GRID_BAR
}

extern "C" void kernel_launch(void* const* d_in, const int* in_sizes, int n_in, void* d_out, int out_size, void* d_ws, size_t ws_size, hipStream_t stream) {
    static int grid = 0;
    if (grid == 0) {
        if (n_in != 20 || in_sizes[0] != TOK * DM || out_size != TOK * DM || ws_size < WS_END + (size_t)TOK * PLE * 2) {
            fprintf(stderr, "kernel_launch: unexpected shapes: n_in %d in0 %d out %d ws %zu (need %zu)\n", n_in, n_in > 0 ? in_sizes[0] : -1, out_size, ws_size, (size_t)WS_END); grid = -1; return; }
        int dev = 0, cus = 0, per_cu = 0;
        if (hipGetDevice(&dev) != hipSuccess || hipDeviceGetAttribute(&cus, hipDeviceAttributeMultiprocessorCount, dev) != hipSuccess) { grid = -1; return; }
        if (hipFuncSetAttribute((const void*)enc_fwd, hipFuncAttributeMaxDynamicSharedMemorySize, LDS_BYTES) != hipSuccess) { fprintf(stderr, "kernel_launch: hipFuncSetAttribute failed\n"); grid = -1; return; }
        if (hipOccupancyMaxActiveBlocksPerMultiprocessor(&per_cu, (const void*)enc_fwd, NWAVES * 64, LDS_BYTES) != hipSuccess || per_cu < 1) {
            fprintf(stderr, "kernel_launch: occupancy query reports %d workgroups per CU\n", per_cu); (void)hipGetLastError(); grid = -1; return; }
        if (cus < 128) { fprintf(stderr, "kernel_launch: needs >= 128 CUs\n"); grid = -1; return; }
        grid = cus;
    }
    if (grid < 0) return;
    if (hipMemsetAsync((char*)d_ws + WS_CTL, 0, CTL_ZERO_BYTES, stream) != hipSuccess) { fprintf(stderr, "kernel_launch: memset failed\n"); return; }
    Args a{};
    for (int i = 0; i < 20; ++i) a.in[i] = (const float*)d_in[i];
    a.out = (float*)d_out; a.ws = (unsigned char*)d_ws;
    for (int i = 0; i < 16; ++i) a.inv16[i] = 1.0 / pow(10000.0, (double)(2 * i) / 32.0);
    for (int i = 0; i < 32; ++i) a.inv32[i] = 1.0 / pow(10000.0, (double)(2 * i) / 64.0);
    void* kargs[] = {&a};
    const hipError_t le = hipLaunchCooperativeKernel((const void*)enc_fwd, dim3(grid), dim3(NWAVES * 64), kargs, LDS_BYTES, stream);
    if (le != hipSuccess) fprintf(stderr, "kernel_launch: launch failed: %s (grid %d)\n", hipGetErrorName(le), grid);
}
```
